# Optimizing an MI355X kernel written in HIP

```python
import jax, jax.numpy as jnp
from jax import lax
import numpy as np

D_MODEL = 2048
BATCH = 4
SEQ = 8192
DEPTH = 4

N_A_LAYERS = DEPTH // 2
N_B_LAYERS = DEPTH - N_A_LAYERS
GM_WIDTH = 2 * D_MODEL
GM_GROUPS = 16
GM_GROUP_DIM = GM_WIDTH // GM_GROUPS
CHUNK = 128
N_HEADS = 16
QK_NOPE_DIM = 128
QK_ROPE_DIM = 64
V_HEAD_DIM = 128
Q_LORA_RANK = 512
KV_LORA_RANK = 512
ATTN_WIDTH = N_HEADS * V_HEAD_DIM
ROPE_THETA = 10000.0
Q_BLOCK = 128
EPS = 1e-6

kernel_name = "yoco_gmlp_mla_adaln_trunk"


def rms_norm(x, g):
    xf = x.astype(jnp.float32)
    y = xf * lax.rsqrt(jnp.mean(xf * xf, axis=-1, keepdims=True) + EPS)
    return (y * g.astype(jnp.float32)).astype(x.dtype)


def layer_norm(x, g, b):
    xf = x.astype(jnp.float32)
    mu = jnp.mean(xf, axis=-1, keepdims=True)
    xc = xf - mu
    y = xc * lax.rsqrt(jnp.mean(xc * xc, axis=-1, keepdims=True) + EPS)
    return (y * g.astype(jnp.float32) + b.astype(jnp.float32)).astype(x.dtype)


def ada_mod(c, w, b):
    return (jax.nn.silu(c) @ w + b)[:, None, :]


def rope_tables(seq_len):
    pos = jnp.arange(seq_len, dtype=jnp.float32)
    inv_freq = ROPE_THETA ** (-jnp.arange(0, QK_ROPE_DIM, 2, dtype=jnp.float32) / QK_ROPE_DIM)
    ang = pos[:, None] * inv_freq[None, :]
    return jnp.cos(ang), jnp.sin(ang)


def apply_rope(x, cos, sin):
    xf = x.astype(jnp.float32)
    x1, x2 = jnp.split(xf, 2, axis=-1)
    return jnp.concatenate([x1 * cos - x2 * sin, x2 * cos + x1 * sin], axis=-1).astype(x.dtype)


def gmlp_mixer(h, w_in, ln_g, ln_b, w_s, b_s, w_out):
    B, S, _ = h.shape
    u, v, z = jnp.split(h @ w_in, 3, axis=-1)
    u = jax.nn.gelu(u)
    v = layer_norm(jax.nn.gelu(v), ln_g, ln_b)
    causal = jnp.tril(jnp.ones((CHUNK, CHUNK), dtype=bool))
    ws = jnp.where(causal, w_s, 0.0).astype(v.dtype)
    vc = v.reshape(B, S // CHUNK, CHUNK, GM_GROUPS, GM_GROUP_DIM)
    mixed = jnp.einsum('gts,bnsgc->bntgc', ws, vc) + b_s.T[None, None, :, :, None].astype(v.dtype)
    y = u * mixed.reshape(B, S, GM_WIDTH) * jax.nn.silu(z)
    return y @ w_out


def mla_shared_kv(h, w_dkv, g_kva, w_ukv, g_kn, g_kr, cos, sin):
    B, S, _ = h.shape
    c_kv, k_r = jnp.split(h @ w_dkv, [KV_LORA_RANK], axis=-1)
    c_kv = rms_norm(c_kv, g_kva)
    kv = (c_kv @ w_ukv).reshape(B, S, N_HEADS, QK_NOPE_DIM + V_HEAD_DIM)
    k_nope, v = jnp.split(kv, [QK_NOPE_DIM], axis=-1)
    k_nope = rms_norm(k_nope, g_kn)
    k_rope = apply_rope(rms_norm(k_r, g_kr), cos, sin)
    return k_nope, k_rope, v


def causal_block_attention(q_nope, q_rope, k_nope, k_rope, v):
    B, S, H, _ = q_nope.shape
    nb = S // Q_BLOCK
    scale = (QK_NOPE_DIM + QK_ROPE_DIM) ** -0.5
    qn = q_nope.reshape(B, nb, Q_BLOCK, H, QK_NOPE_DIM).transpose(1, 0, 2, 3, 4)
    qr = q_rope.reshape(B, nb, Q_BLOCK, H, QK_ROPE_DIM).transpose(1, 0, 2, 3, 4)
    k_pos = jnp.arange(S)

    def block(args):
        qn_b, qr_b, i = args
        s = (jnp.einsum('bqhd,bkhd->bhqk', qn_b, k_nope)
             + jnp.einsum('bqhr,bkr->bhqk', qr_b, k_rope)).astype(jnp.float32) * scale
        q_pos = i * Q_BLOCK + jnp.arange(Q_BLOCK)
        s = jnp.where(k_pos[None, :] <= q_pos[:, None], s, -jnp.inf)
        p = jax.nn.softmax(s, axis=-1).astype(v.dtype)
        return jnp.einsum('bhqk,bkhd->bqhd', p, v)

    o = lax.map(block, (qn, qr, jnp.arange(nb)))
    return o.transpose(1, 0, 2, 3, 4).reshape(B, S, H, V_HEAD_DIM)


def mla_mixer(h, k_nope, k_rope, v, w_in, g_qa, w_uq, g_qn, g_qr, w_out, cos, sin):
    B, S, _ = h.shape
    c_q, z = jnp.split(h @ w_in, [Q_LORA_RANK], axis=-1)
    q = (rms_norm(c_q, g_qa) @ w_uq).reshape(B, S, N_HEADS, QK_NOPE_DIM + QK_ROPE_DIM)
    q_nope, q_rope = jnp.split(q, [QK_NOPE_DIM], axis=-1)
    q_nope = rms_norm(q_nope, g_qn)
    q_rope = apply_rope(rms_norm(q_rope, g_qr), cos[:, None, :], sin[:, None, :])
    o = causal_block_attention(q_nope, q_rope, k_nope, k_rope, v)
    y = o.reshape(B, S, ATTN_WIDTH) * jax.nn.silu(z)
    return y @ w_out


def setup_inputs(seed: int = 0) -> dict:
    key = jax.random.key(seed)
    ks = iter(jax.random.split(key, 32))
    D = D_MODEL

    def nrm(shape, std):
        return std * jax.random.normal(next(ks), shape, jnp.float32)

    return {
        "x": nrm((BATCH, SEQ, D), 1.0),
        "c": nrm((BATCH, D), 1.0),
        "ada_w": nrm((DEPTH, D, 3 * D), 0.5 * D ** -0.5),
        "ada_b": nrm((DEPTH, 3 * D), 0.02),
        "norm_g": 1.0 + nrm((DEPTH, D), 0.02),
        "a_w_in": nrm((N_A_LAYERS, D, 3 * GM_WIDTH), D ** -0.5),
        "a_ln_g": 1.0 + nrm((N_A_LAYERS, GM_WIDTH), 0.02),
        "a_ln_b": nrm((N_A_LAYERS, GM_WIDTH), 0.02),
        "a_w_s": nrm((N_A_LAYERS, GM_GROUPS, CHUNK, CHUNK), CHUNK ** -0.5),
        "a_b_s": 1.0 + nrm((N_A_LAYERS, GM_GROUPS, CHUNK), 0.1),
        "a_w_out": nrm((N_A_LAYERS, GM_WIDTH, D), GM_WIDTH ** -0.5),
        "kv_ada_w": nrm((D, 2 * D), 0.5 * D ** -0.5),
        "kv_ada_b": nrm((2 * D,), 0.02),
        "kv_norm_g": 1.0 + nrm((D,), 0.02),
        "kv_w_dkv": nrm((D, KV_LORA_RANK + QK_ROPE_DIM), D ** -0.5),
        "kv_g_kva": 1.0 + nrm((KV_LORA_RANK,), 0.02),
        "kv_w_ukv": nrm((KV_LORA_RANK, N_HEADS * (QK_NOPE_DIM + V_HEAD_DIM)), KV_LORA_RANK ** -0.5),
        "kv_g_kn": 1.0 + nrm((QK_NOPE_DIM,), 0.02),
        "kv_g_kr": 1.0 + nrm((QK_ROPE_DIM,), 0.02),
        "b_w_in": nrm((N_B_LAYERS, D, Q_LORA_RANK + ATTN_WIDTH), D ** -0.5),
        "b_g_qa": 1.0 + nrm((N_B_LAYERS, Q_LORA_RANK), 0.02),
        "b_w_uq": nrm((N_B_LAYERS, Q_LORA_RANK, N_HEADS * (QK_NOPE_DIM + QK_ROPE_DIM)), Q_LORA_RANK ** -0.5),
        "b_g_qn": 1.0 + nrm((N_B_LAYERS, QK_NOPE_DIM), 0.02),
        "b_g_qr": 1.0 + nrm((N_B_LAYERS, QK_ROPE_DIM), 0.02),
        "b_w_out": nrm((N_B_LAYERS, ATTN_WIDTH, D), ATTN_WIDTH ** -0.5),
    }


def reference(x, c, ada_w, ada_b, norm_g, a_w_in, a_ln_g, a_ln_b, a_w_s, a_b_s, a_w_out,
              kv_ada_w, kv_ada_b, kv_norm_g, kv_w_dkv, kv_g_kva, kv_w_ukv, kv_g_kn, kv_g_kr,
              b_w_in, b_g_qa, b_w_uq, b_g_qn, b_g_qr, b_w_out):
    cos, sin = rope_tables(x.shape[1])
    k_nope = k_rope = v = None
    for i in range(DEPTH):
        if i == N_A_LAYERS:
            kv_shift, kv_scale = jnp.split(ada_mod(c, kv_ada_w, kv_ada_b), 2, axis=-1)
            h_kv = rms_norm(x, kv_norm_g) * (1.0 + kv_scale) + kv_shift
            k_nope, k_rope, v = mla_shared_kv(h_kv, kv_w_dkv, kv_g_kva, kv_w_ukv, kv_g_kn, kv_g_kr, cos, sin)
        shift, scale, gate = jnp.split(ada_mod(c, ada_w[i], ada_b[i]), 3, axis=-1)
        h = rms_norm(x, norm_g[i]) * (1.0 + scale) + shift
        if i < N_A_LAYERS:
            out = gmlp_mixer(h, a_w_in[i], a_ln_g[i], a_ln_b[i], a_w_s[i], a_b_s[i], a_w_out[i])
        else:
            j = i - N_A_LAYERS
            out = mla_mixer(h, k_nope, k_rope, v, b_w_in[j], b_g_qa[j], b_w_uq[j], b_g_qn[j],
                            b_g_qr[j], b_w_out[j], cos, sin)
        x = x + gate * out
    return x
```

```cpp
#include <hip/hip_runtime.h>
#include <hip/hip_cooperative_groups.h>
#include <cstdio>
#include <cstdint>
namespace cg = cooperative_groups;

#ifndef PHSEL
#define PHSEL 0xFFFF
#endif
#ifndef MK_SINGLE
#define MK_SINGLE 1
#endif

typedef unsigned short bf16_t;
typedef short bf16x8 __attribute__((ext_vector_type(8)));
typedef float f32x2 __attribute__((ext_vector_type(2)));
typedef float f32x4 __attribute__((ext_vector_type(4)));
typedef float f32x16 __attribute__((ext_vector_type(16)));
typedef unsigned u32x4 __attribute__((ext_vector_type(4)));
typedef unsigned u32x2 __attribute__((ext_vector_type(2)));
#define LAS __attribute__((address_space(3)))

constexpr int T = 32768, DM = 2048, SEQ = 8192, NBATCH = 4;
constexpr int GMW = 4096;
constexpr float EPS = 1e-6f;
constexpr float QSCALE = 0.07216878364870322f * 1.4426950408889634f;

constexpr size_t WS_MOD = 0;
constexpr size_t WS_KVMOD = WS_MOD + 4ull * 4 * 6144 * 4;
constexpr size_t WS_COS = WS_KVMOD + 4ull * 4096 * 4;
constexpr size_t WS_SIN = WS_COS + 8192ull * 32 * 4;
constexpr size_t WS_WINA = WS_SIN + 8192ull * 32 * 4;
constexpr size_t WS_WOUTA = WS_WINA + 2ull * 12288 * 2048 * 2;
constexpr size_t WS_WDKV = WS_WOUTA + 2ull * 2048 * 4096 * 2;
constexpr size_t WS_WKN = WS_WDKV + 768ull * 2048 * 2;
constexpr size_t WS_WV = WS_WKN + 2048ull * 512 * 2;
constexpr size_t WS_WINB = WS_WV + 2048ull * 512 * 2;
constexpr size_t WS_WUQ = WS_WINB + 2ull * 2560 * 2048 * 2;
constexpr size_t WS_WOUTB = WS_WUQ + 2ull * 3072 * 512 * 2;
constexpr size_t WS_ACT = WS_WOUTB + 2ull * 2048 * 2048 * 2;
constexpr size_t WA_H = WS_ACT;
constexpr size_t WA_P = WA_H + (size_t)T * 2048 * 2;
constexpr size_t WA_GV = WA_P + (size_t)T * 4096 * 2;
constexpr size_t WA_STATS = WA_GV + (size_t)T * 4096 * 2;
constexpr size_t WA_END = WA_STATS + (size_t)T * 64 * 2 * 4;
constexpr size_t WB_H = WS_ACT;
constexpr size_t WB_HKV = WB_H + (size_t)T * 2048 * 2;
constexpr size_t WB_Q = WS_ACT;
constexpr size_t WB_CKV = WB_HKV + (size_t)T * 2048 * 2;
constexpr size_t WB_CQ = WB_CKV + (size_t)T * 512 * 2;
constexpr size_t WB_KRAW = WB_CQ + (size_t)T * 512 * 2;
constexpr size_t WB_KROPE = WB_KRAW + (size_t)T * 64 * 4;
constexpr size_t WB_SSQKV = WB_KROPE + (size_t)T * 64 * 2;
constexpr size_t WB_SSQQ = WB_SSQKV + (size_t)T * 8 * 4;
constexpr size_t WB_Z = WB_SSQQ + (size_t)T * 8 * 4;
constexpr size_t WB_KN = WB_Z + (size_t)T * 2048 * 2;
constexpr size_t WB_VT = WB_KN + (size_t)T * 2048 * 2;
constexpr size_t WB_END = WB_VT + (size_t)T * 2048 * 2;
constexpr size_t WS_NEED = WA_END > WB_END ? WA_END : WB_END;
static_assert(WS_NEED <= (1ull << 30), "workspace");

constexpr int LDS_BYTES = 131072;

__device__ __forceinline__ unsigned cvt_pk_bf16(float lo, float hi) { unsigned r; asm volatile("v_cvt_pk_bf16_f32 %0, %1, %2" : "=v"(r) : "v"(lo), "v"(hi)); return r; }
__device__ __forceinline__ float bf2f(unsigned short v) { return __uint_as_float(((unsigned)v) << 16); }
__device__ __forceinline__ float bflo(unsigned w) { return __uint_as_float(w << 16); }
__device__ __forceinline__ float bfhi(unsigned w) { return __uint_as_float(w & 0xffff0000u); }
__device__ __forceinline__ float gelu_f(float x) {
    const float u = x * (1.0f + 0.044715f * x * x);
    const float e = __builtin_amdgcn_exp2f(-2.302208198f * u);
    return x * __builtin_amdgcn_rcpf(1.0f + e);
}
__device__ __forceinline__ float silu_f(float x) { const float e = __builtin_amdgcn_exp2f(-1.4426950408889634f * x); return x * __builtin_amdgcn_rcpf(1.0f + e); }
__device__ __forceinline__ u32x4 pack8f(const float* r) { u32x4 o = {cvt_pk_bf16(r[0], r[1]), cvt_pk_bf16(r[2], r[3]), cvt_pk_bf16(r[4], r[5]), cvt_pk_bf16(r[6], r[7])}; return o; }

template <class Tp> __device__ __forceinline__ Tp* uniform_ptr(Tp* p) { const unsigned long long v = (unsigned long long)p; const unsigned lo = __builtin_amdgcn_readfirstlane((unsigned)v), hi = __builtin_amdgcn_readfirstlane((unsigned)(v >> 32)); return (Tp*)(((unsigned long long)hi << 32) | lo); }
__device__ __forceinline__ float x32_sum(float v) { auto rr = __builtin_amdgcn_permlane32_swap(__float_as_uint(v), __float_as_uint(v), false, false); return __uint_as_float(rr[0]) + __uint_as_float(rr[1]); }
__device__ __forceinline__ float x32_max(float v) { auto rr = __builtin_amdgcn_permlane32_swap(__float_as_uint(v), __float_as_uint(v), false, false); return fmaxf(__uint_as_float(rr[0]), __uint_as_float(rr[1])); }

namespace pg8 {
constexpr int BM = 256, BK = 64, HALF = 128, HTB = HALF * BK * 2, STAGE_BYTES = 8 * HTB, NXCD = 8, WGM = 8;
__host__ __device__ __forceinline__ int lds_byte(int r, int c) { const int st = (r >> 4) * 2 + (c >> 5), rr = r & 15, cc = c & 31, ob = rr * 64 + cc * 2; return st * 1024 + (ob ^ (((ob >> 9) & 1) << 5)); }
__host__ __device__ __forceinline__ void stage_rc(int b, int& R, int& C) { const int st = b / 1024, sb = b % 1024, swz = sb ^ (((sb >> 9) & 1) << 5); R = (st >> 1) * 16 + swz / 64; C = (st & 1) * 32 + (swz % 64) / 2; }
__host__ __device__ __forceinline__ int perm32(int rho) { const int n = rho >> 4, i = rho & 15; return 8 * (i >> 2) + 4 * n + (i & 3); }
struct Unit { int pm, pn; };
struct Gemm { const bf16_t* A; const bf16_t* Bt; int M, N, K; };
struct StaticOrder {
    int nM, nN, nwg, G, c;
    __host__ __device__ void init(int M, int N, int G_, int c_) { nM = M / BM; nN = N / BM; nwg = nM * nN; G = G_; c = c_; }
    __host__ __device__ bool next(int i, Unit& u) const {
        const long L = (long)i * G + c; if (L >= nwg) return false;
        int wgid = (int)L; { const int q = nwg / NXCD, r = nwg % NXCD, xcd = wgid % NXCD, off = wgid / NXCD; wgid = (xcd < r ? xcd * (q + 1) : r * (q + 1) + (xcd - r) * q) + off; }
        const int nig = WGM * nN, gid = wgid / nig, fm = gid * WGM, gsz = (nM - fm) < WGM ? (nM - fm) : WGM;
        u.pm = fm + ((wgid % nig) % gsz); u.pn = (wgid % nig) / gsz; return true;
    }
    __device__ __forceinline__ void a_ready(const Unit&) const {}
    __device__ __forceinline__ void done(const Unit&) const {}
};

template <class Epi, class Sched>
__device__ __forceinline__ void gemm_phase(const int TID, LAS unsigned char* lds, const Gemm g, const Sched& S, const Epi& E) {
    const int tid = TID, wid = __builtin_amdgcn_readfirstlane(tid >> 6), lane = tid & 63, wr = wid >> 2, wc = wid & 3, fr = lane & 15, fq = lane >> 4;
    const int K = g.K, nt = K / BK;
    unsigned voffA[2], voffB[2];
#pragma unroll
    for (int i = 0; i < 2; ++i) { int R, C; stage_rc(tid * 16 + i * 8192, R, C); const int Rb = Epi::PERM ? ((R & ~31) + perm32(R & 31)) : R;
        voffA[i] = (unsigned)(R * K + C) * 2u; voffB[i] = (unsigned)(Rb * K + C) * 2u; }
    const size_t kstep = (size_t)(BK * 2);
    const size_t hstep = (size_t)HALF * K * 2;
    const size_t tstep = 2 * hstep;
    const unsigned ldsw = (unsigned)wid * 1024u;
    const int aoff = lds_byte(wr * 64 + fr, fq * 8), boff = lds_byte(wc * 32 + fr, fq * 8);
#define PG8_SA(b, h) (((b) * 2 + (h)) * HTB)
#define PG8_SB(b, h) ((4 + (b) * 2 + (h)) * HTB)
#define PG8_STAGE(bufoff, gbase, voff) do { _Pragma("unroll") for (int _i = 0; _i < 2; ++_i) \
        __builtin_amdgcn_global_load_lds((const unsigned*)((const char*)(gbase) + (voff)[_i]), (LAS unsigned*)(lds + (bufoff) + ldsw + _i * 8192), 16, 0, 0); } while (0)
#define PG8_LDA(dst, b, h) do { _Pragma("unroll") for (int m = 0; m < 4; ++m) _Pragma("unroll") for (int k = 0; k < 2; ++k) dst[m][k] = *(const LAS bf16x8*)(lds + PG8_SA(b, h) + aoff + m * 2048 + k * 1024); } while (0)
#define PG8_LDB(dst, b, h) do { _Pragma("unroll") for (int n = 0; n < 2; ++n) _Pragma("unroll") for (int k = 0; k < 2; ++k) dst[n][k] = *(const LAS bf16x8*)(lds + PG8_SB(b, h) + boff + n * 2048 + k * 1024); } while (0)
#define PG8_MMA(ai, bj, At, Bt) do { __builtin_amdgcn_s_setprio(1); _Pragma("unroll") for (int m = 0; m < 4; ++m) _Pragma("unroll") for (int n = 0; n < 2; ++n) _Pragma("unroll") for (int k = 0; k < 2; ++k) \
        acc[ai][bj][m][n] = __builtin_amdgcn_mfma_f32_16x16x32_bf16(Bt[n][k], At[m][k], acc[ai][bj][m][n], 0, 0, 0); __builtin_amdgcn_s_setprio(0); } while (0)
#define PG8_WAIT_V(n) asm volatile("s_waitcnt vmcnt(" #n ")" ::: "memory")
#define PG8_WAIT_L(n) asm volatile("s_waitcnt lgkmcnt(" #n ")" ::: "memory")
#define PG8_BAR __builtin_amdgcn_s_barrier()
#define PG8_SCHED __builtin_amdgcn_sched_barrier(0)
    Unit cur, nxt; int ui = 0;
    if (!S.next(0, cur)) return;
    f32x4 acc[2][2][4][2];
#pragma unroll
    for (int a = 0; a < 2; ++a)
#pragma unroll
        for (int b = 0; b < 2; ++b)
#pragma unroll
            for (int m = 0; m < 4; ++m)
#pragma unroll
                for (int n = 0; n < 2; ++n) acc[a][b][m][n] = (f32x4){0.f, 0.f, 0.f, 0.f};
    bf16x8 At[4][2], B0[2][2], B1[2][2];
    const char* cA = (const char*)g.A + (size_t)cur.pm * tstep; const char* cB = (const char*)g.Bt + (size_t)cur.pn * tstep;
    S.a_ready(cur);
    PG8_STAGE(PG8_SB(0, 0), cB, voffB); PG8_STAGE(PG8_SA(0, 0), cA, voffA); PG8_STAGE(PG8_SB(0, 1), cB + hstep, voffB); PG8_STAGE(PG8_SA(0, 1), cA + hstep, voffA);
    if (wr == 1) PG8_BAR;
    PG8_WAIT_V(4); PG8_BAR;
    PG8_STAGE(PG8_SB(1, 0), cB + kstep, voffB); PG8_STAGE(PG8_SA(1, 0), cA + kstep, voffA); PG8_STAGE(PG8_SB(1, 1), cB + hstep + kstep, voffB);
    PG8_WAIT_V(6); PG8_BAR;
    for (;;) {
        const bool has_next = S.next(ui + 1, nxt);
        const char* nA = has_next ? (const char*)g.A + (size_t)nxt.pm * tstep : cA; const char* nB = has_next ? (const char*)g.Bt + (size_t)nxt.pn * tstep : cB;
        for (int t = 0; t < nt; t += 2) {
            const bool last = (t == nt - 2);
            const char* a1 = cA + (size_t)(t + 1) * kstep;
            const char* a2 = last ? nA : cA + (size_t)(t + 2) * kstep; const char* b2 = last ? nB : cB + (size_t)(t + 2) * kstep;
            const char* a3 = a2 + kstep; const char* b3 = b2 + kstep;
            if (last && has_next) S.a_ready(nxt);
            PG8_LDB(B0, 0, 0); PG8_SCHED; PG8_LDA(At, 0, 0); PG8_STAGE(PG8_SA(1, 1), a1 + hstep, voffA);
            PG8_WAIT_L(8); PG8_BAR; PG8_WAIT_L(0); PG8_MMA(0, 0, At, B0); PG8_BAR; PG8_SCHED;
            PG8_LDB(B1, 0, 1); PG8_STAGE(PG8_SB(0, 0), b2, voffB);
            PG8_BAR; PG8_WAIT_L(0); PG8_MMA(0, 1, At, B1); PG8_BAR;
            PG8_LDA(At, 0, 1); PG8_STAGE(PG8_SA(0, 0), a2, voffA);
            PG8_BAR; PG8_WAIT_L(0); PG8_MMA(1, 0, At, B0); PG8_BAR; PG8_SCHED;
            PG8_STAGE(PG8_SB(0, 1), b2 + hstep, voffB);
            PG8_WAIT_V(6); PG8_BAR; PG8_MMA(1, 1, At, B1); PG8_BAR;
            PG8_LDB(B0, 1, 0); PG8_SCHED; PG8_LDA(At, 1, 0); PG8_STAGE(PG8_SA(0, 1), a2 + hstep, voffA);
            PG8_WAIT_L(8); PG8_BAR; PG8_WAIT_L(0); PG8_MMA(0, 0, At, B0); PG8_BAR; PG8_SCHED;
            PG8_LDB(B1, 1, 1); PG8_STAGE(PG8_SB(1, 0), b3, voffB);
            PG8_BAR; PG8_WAIT_L(0); PG8_MMA(0, 1, At, B1); PG8_BAR;
            PG8_LDA(At, 1, 1); PG8_STAGE(PG8_SA(1, 0), a3, voffA);
            PG8_BAR; PG8_WAIT_L(0); PG8_MMA(1, 0, At, B0); PG8_BAR; PG8_SCHED;
            PG8_STAGE(PG8_SB(1, 1), b3 + hstep, voffB);
            PG8_WAIT_V(6); PG8_BAR; PG8_MMA(1, 1, At, B1); PG8_BAR;
        }
        E(acc, cur, wr, wc, fr, fq);
        if (!has_next) break;
#pragma unroll
        for (int a = 0; a < 2; ++a)
#pragma unroll
            for (int b = 0; b < 2; ++b)
#pragma unroll
                for (int m = 0; m < 4; ++m)
#pragma unroll
                    for (int n = 0; n < 2; ++n) acc[a][b][m][n] = (f32x4){0.f, 0.f, 0.f, 0.f};
        cur = nxt; cA = nA; cB = nB; ++ui;
    }
    PG8_WAIT_V(0);
    if (wr == 0) PG8_BAR;
    PG8_BAR;
#undef PG8_SA
#undef PG8_SB
#undef PG8_STAGE
#undef PG8_LDA
#undef PG8_LDB
#undef PG8_MMA
#undef PG8_WAIT_V
#undef PG8_WAIT_L
#undef PG8_BAR
#undef PG8_SCHED
}
}
using pg8::Unit;

struct EpiAin {
    static constexpr bool PERM = true;
    bf16_t* P; bf16_t* GV; float* stats;
    __device__ __forceinline__ void operator()(const f32x4 (&acc)[2][2][4][2], const Unit& u, int wr, int wc, int fr_, int fq_) const {
        int fr = fr_, fq = fq_; asm volatile("" : "+v"(fr), "+v"(fq));
        const int row0 = u.pm * 256 + wr * 64 + fr;
        if (u.pn < 32) {
            const int col = u.pn * 128 + wc * 32 + 8 * fq;
#pragma unroll
            for (int ai = 0; ai < 2; ++ai)
#pragma unroll
                for (int m = 0; m < 4; ++m) {
                    const size_t row = (size_t)(row0 + ai * 128 + m * 16);
                    float r[8];
#pragma unroll
                    for (int n = 0; n < 2; ++n)
#pragma unroll
                        for (int i = 0; i < 4; ++i) r[4 * n + i] = gelu_f(acc[ai][0][m][n][i]) * silu_f(acc[ai][1][m][n][i]);
                    *(u32x4*)(P + row * GMW + col) = pack8f(r);
                }
        } else {
            const int tile = u.pn - 32;
#pragma unroll
            for (int ai = 0; ai < 2; ++ai)
#pragma unroll
                for (int m = 0; m < 4; ++m) {
                    const size_t row = (size_t)(row0 + ai * 128 + m * 16);
                    float s = 0.f, ss = 0.f;
#pragma unroll
                    for (int bj = 0; bj < 2; ++bj) {
                        const int col = tile * 256 + bj * 128 + wc * 32 + 8 * fq;
                        float r[8];
#pragma unroll
                        for (int n = 0; n < 2; ++n)
#pragma unroll
                            for (int i = 0; i < 4; ++i) r[4 * n + i] = gelu_f(acc[ai][bj][m][n][i]);
                        const u32x4 o = pack8f(r);
#pragma unroll
                        for (int q = 0; q < 4; ++q) { const float a = bflo(o[q]), b = bfhi(o[q]); s += a + b; ss += a * a + b * b; }
                        *(u32x4*)(GV + row * GMW + col) = o;
                    }
                    s += __shfl_xor(s, 16); ss += __shfl_xor(ss, 16);
                    s += __shfl_xor(s, 32); ss += __shfl_xor(ss, 32);
                    if (fq == 0) { f32x2 st = {s, ss}; *(f32x2*)(stats + (row * 64 + tile * 4 + wc) * 2) = st; }
                }
        }
    }
};
struct EpiRes {
    static constexpr bool PERM = false;
    const float* xin; float* xout; const float* gate;
    int ldg;
    __device__ __forceinline__ void operator()(const f32x4 (&acc)[2][2][4][2], const Unit& u, int wr, int wc, int fr_, int fq_) const {
        int fr = fr_, fq = fq_; asm volatile("" : "+v"(fr), "+v"(fq));
        const int row0 = u.pm * 256 + wr * 64 + fr, col0 = u.pn * 256 + wc * 32 + 4 * fq;
        const float* gp = gate + (size_t)(u.pm >> 5) * ldg + col0;
        f32x4 gv[2][2];
#pragma unroll
        for (int bj = 0; bj < 2; ++bj)
#pragma unroll
            for (int n = 0; n < 2; ++n) gv[bj][n] = *(const f32x4*)(gp + bj * 128 + n * 16);
#pragma unroll
        for (int ai = 0; ai < 2; ++ai)
#pragma unroll
            for (int m = 0; m < 4; ++m) {
                const size_t off = (size_t)(row0 + ai * 128 + m * 16) * DM + col0;
#pragma unroll
                for (int bj = 0; bj < 2; ++bj)
#pragma unroll
                    for (int n = 0; n < 2; ++n) {
                        const f32x4 xo = *(const f32x4*)(xin + off + bj * 128 + n * 16);
                        *(f32x4*)(xout + off + bj * 128 + n * 16) = xo + gv[bj][n] * acc[ai][bj][m][n];
                    }
            }
    }
};
template <int MODE> struct EpiLat {
    static constexpr bool PERM = true;
    bf16_t* C; float* ssq; float* kr; bf16_t* Z;
    __device__ __forceinline__ void operator()(const f32x4 (&acc)[2][2][4][2], const Unit& u, int wr, int wc, int fr_, int fq_) const {
        int fr = fr_, fq = fq_; asm volatile("" : "+v"(fr), "+v"(fq));
        const int row0 = u.pm * 256 + wr * 64 + fr;
        if (u.pn < 2) {
#pragma unroll
            for (int ai = 0; ai < 2; ++ai)
#pragma unroll
                for (int m = 0; m < 4; ++m) {
                    const size_t row = (size_t)(row0 + ai * 128 + m * 16);
                    float ss = 0.f;
#pragma unroll
                    for (int bj = 0; bj < 2; ++bj) {
                        const int col = u.pn * 256 + bj * 128 + wc * 32 + 8 * fq;
                        float r[8];
#pragma unroll
                        for (int n = 0; n < 2; ++n)
#pragma unroll
                            for (int i = 0; i < 4; ++i) { r[4 * n + i] = acc[ai][bj][m][n][i]; ss += r[4 * n + i] * r[4 * n + i]; }
                        *(u32x4*)(C + row * 512 + col) = pack8f(r);
                    }
                    ss += __shfl_xor(ss, 16); ss += __shfl_xor(ss, 32);
                    if (fq == 0) ssq[row * 8 + u.pn * 4 + wc] = ss;
                }
        } else if (MODE == 0) {
            if (u.pn == 2 && wc < 2) {
#pragma unroll
                for (int ai = 0; ai < 2; ++ai)
#pragma unroll
                    for (int m = 0; m < 4; ++m) {
                        const size_t row = (size_t)(row0 + ai * 128 + m * 16);
                        *(f32x4*)(kr + row * 64 + wc * 32 + 8 * fq) = acc[ai][0][m][0];
                        *(f32x4*)(kr + row * 64 + wc * 32 + 8 * fq + 4) = acc[ai][0][m][1];
                    }
            }
        } else {
#pragma unroll
            for (int ai = 0; ai < 2; ++ai)
#pragma unroll
                for (int m = 0; m < 4; ++m) {
                    const size_t row = (size_t)(row0 + ai * 128 + m * 16);
#pragma unroll
                    for (int bj = 0; bj < 2; ++bj) {
                        const int col = (u.pn - 2) * 256 + bj * 128 + wc * 32 + 8 * fq;
                        float r[8];
#pragma unroll
                        for (int n = 0; n < 2; ++n)
#pragma unroll
                            for (int i = 0; i < 4; ++i) r[4 * n + i] = silu_f(acc[ai][bj][m][n][i]);
                        *(u32x4*)(Z + row * 2048 + col) = pack8f(r);
                    }
                }
        }
    }
};
struct EpiScaled {
    static constexpr bool PERM = true;
    bf16_t* O; int ldc; const float* ssq;
    __device__ __forceinline__ void operator()(const f32x4 (&acc)[2][2][4][2], const Unit& u, int wr, int wc, int fr_, int fq_) const {
        int fr = fr_, fq = fq_; asm volatile("" : "+v"(fr), "+v"(fq));
        const int row0 = u.pm * 256 + wr * 64 + fr;
#pragma unroll
        for (int ai = 0; ai < 2; ++ai)
#pragma unroll
            for (int m = 0; m < 4; ++m) {
                const size_t row = (size_t)(row0 + ai * 128 + m * 16);
                const f32x4 a = *(const f32x4*)(ssq + row * 8), b = *(const f32x4*)(ssq + row * 8 + 4);
                const float rs = rsqrtf((a[0] + a[1] + a[2] + a[3] + b[0] + b[1] + b[2] + b[3]) * (1.0f / 512.0f) + EPS);
#pragma unroll
                for (int bj = 0; bj < 2; ++bj) {
                    const int col = u.pn * 256 + bj * 128 + wc * 32 + 8 * fq;
                    float r[8];
#pragma unroll
                    for (int n = 0; n < 2; ++n)
#pragma unroll
                        for (int i = 0; i < 4; ++i) r[4 * n + i] = acc[ai][bj][m][n][i] * rs;
                    *(u32x4*)(O + row * ldc + col) = pack8f(r);
                }
            }
    }
};
struct EpiVT {
    static constexpr bool PERM = false;
    bf16_t* VT; const float* ssq;
    __device__ __forceinline__ void operator()(const f32x4 (&acc)[2][2][4][2], const Unit& u, int wr, int wc, int fr_, int fq_) const {
        int fr = fr_, fq = fq_; asm volatile("" : "+v"(fr), "+v"(fq));
        const int row0 = u.pm * 256 + wr * 64 + fr;
        const int pg = ((fq & 1) << 1) | (fq >> 1);
#pragma unroll
        for (int bj = 0; bj < 2; ++bj)
#pragma unroll
            for (int n = 0; n < 2; ++n) {
                const int tb = u.pn * 256 + bj * 128 + wc * 32 + 16 * n;
                const int tok0 = tb + 4 * fq;
                f32x4 rs;
#pragma unroll
                for (int i = 0; i < 4; ++i) {
                    const f32x4 a = *(const f32x4*)(ssq + (size_t)(tok0 + i) * 8), b = *(const f32x4*)(ssq + (size_t)(tok0 + i) * 8 + 4);
                    rs[i] = rsqrtf((a[0] + a[1] + a[2] + a[3] + b[0] + b[1] + b[2] + b[3]) * (1.0f / 512.0f) + EPS);
                }
                const int pos0 = tb + 4 * pg;
#pragma unroll
                for (int ai = 0; ai < 2; ++ai)
#pragma unroll
                    for (int m = 0; m < 4; ++m) {
                        const size_t row = (size_t)(row0 + ai * 128 + m * 16);
                        const f32x4 v = acc[ai][bj][m][n] * rs;
                        u32x2 o = {cvt_pk_bf16(v[0], v[1]), cvt_pk_bf16(v[2], v[3])};
                        *(u32x2*)(VT + row * T + pos0) = o;
                    }
            }
    }
};

template <class Epi> __device__ __forceinline__ void run_gemm(const int TID, const int BID, LAS unsigned char* lds, const bf16_t* A, const bf16_t* Bt, int M, int N, int K, const Epi& E) {
    pg8::Gemm g{A, Bt, M, N, K}; pg8::StaticOrder S; S.init(M, N, (int)gridDim.x, (int)BID);
    pg8::gemm_phase<Epi, pg8::StaticOrder>(TID, lds, g, S, E);
}

struct Params {
    const float* in[25];
    float* out;
    unsigned char* ws;
    int ph_lo, ph_hi;
};
enum { I_X = 0, I_C, I_ADA_W, I_ADA_B, I_NORM_G, I_A_W_IN, I_A_LN_G, I_A_LN_B, I_A_W_S, I_A_B_S, I_A_W_OUT, I_KV_ADA_W, I_KV_ADA_B, I_KV_NORM_G, I_KV_W_DKV, I_KV_G_KVA,
       I_KV_W_UKV, I_KV_G_KN, I_KV_G_KR, I_B_W_IN, I_B_G_QA, I_B_W_UQ, I_B_G_QN, I_B_G_QR, I_B_W_OUT };

__device__ __forceinline__ void conv_tile(const int TID, unsigned char* shm, const float* src, int ldsrc, int srccol0, int K, int k0, bf16_t* dst, int n0, const float* scale) {
    float* tile = (float*)shm;
    const int tid = TID;
    {
        const int kk = tid >> 4, c4 = tid & 15;
#pragma unroll
        for (int i = 0; i < 2; ++i) {
            const int k = kk + 32 * i;
            f32x4 v = {0.f, 0.f, 0.f, 0.f};
            if (srccol0 >= 0) v = *(const f32x4*)(src + (size_t)(k0 + k) * ldsrc + srccol0 + 4 * c4);
            float* tp = tile + k * 65 + 4 * c4;
            tp[0] = v[0]; tp[1] = v[1]; tp[2] = v[2]; tp[3] = v[3];
        }
    }
    __syncthreads();
    {
        const int n = tid >> 3, k8 = tid & 7;
        float r[8];
#pragma unroll
        for (int j = 0; j < 8; ++j) { r[j] = tile[(8 * k8 + j) * 65 + n]; if (scale) r[j] *= scale[k0 + 8 * k8 + j]; }
        *(u32x4*)(dst + (size_t)(n0 + n) * K + k0 + 8 * k8) = pack8f(r);
    }
    __syncthreads();
}

__device__ __forceinline__ void phase_prep(const int TID, const int BID, const Params& p, unsigned char* ws, unsigned char* shm) {
    const int tid = TID;
    {
        float* cosT = (float*)(ws + WS_COS); float* sinT = (float*)(ws + WS_SIN);
        for (int idx = BID * 512 + tid; idx < SEQ * 32; idx += gridDim.x * 512) {
            const int pos = idx >> 5, i = idx & 31;
            double f = 1.0; for (int q = 0; q < i; ++q) f *= 0.7498942093324559;
            const float invf = (float)f;
            const float ang = (float)pos * invf;
            const double ad = (double)ang;
            const double n = rint(ad * 0.15915494309189535);
            const double r = ad - n * 6.283185307179586;
            const double r2 = r * r;
            double s = 1.0, c = 1.0;
#pragma unroll 1
            for (int k = 14; k >= 1; --k) { s = 1.0 - s * r2 / (double)((2 * k) * (2 * k + 1)); c = 1.0 - c * r2 / (double)((2 * k - 1) * (2 * k)); }
            cosT[idx] = (float)c; sinT[idx] = (float)(r * s);
        }
    }
    if (BID < 224) {
        float* sc = (float*)shm;
        float* red = (float*)(shm + 32768);
        const float* cin = p.in[I_C];
        for (int i = tid; i < 4 * 2048; i += 512) sc[i] = silu_f(cin[i]);
        __syncthreads();
        const int item = BID;
        const float* W; const float* bias; float* out; int ldw, cb;
        if (item < 192) { const int l = item / 48; cb = item % 48; W = p.in[I_ADA_W] + (size_t)l * 2048 * 6144; ldw = 6144; bias = p.in[I_ADA_B] + l * 6144; out = (float*)(ws + WS_MOD) + (size_t)l * 4 * 6144; }
        else { cb = item - 192; W = p.in[I_KV_ADA_W]; ldw = 4096; bias = p.in[I_KV_ADA_B]; out = (float*)(ws + WS_KVMOD); }
        const int cgp = tid & 31, kg = tid >> 5;
        const float* wp = W + (size_t)(kg * 128) * ldw + cb * 128 + cgp * 4;
        f32x4 a0 = {0.f, 0.f, 0.f, 0.f}, a1 = a0, a2 = a0, a3 = a0;
#pragma unroll 4
        for (int k = 0; k < 128; ++k) {
            const f32x4 w = *(const f32x4*)(wp + (size_t)k * ldw);
            const int kk = kg * 128 + k;
            a0 += w * sc[kk]; a1 += w * sc[2048 + kk]; a2 += w * sc[4096 + kk]; a3 += w * sc[6144 + kk];
        }
        float* rp = red + ((size_t)kg * 128 + cgp * 4) * 4;
#pragma unroll
        for (int e = 0; e < 4; ++e) { rp[e * 4 + 0] = a0[e]; rp[e * 4 + 1] = a1[e]; rp[e * 4 + 2] = a2[e]; rp[e * 4 + 3] = a3[e]; }
        __syncthreads();
        {
            const int col = tid >> 2, b = tid & 3;
            float s = 0.f;
#pragma unroll
            for (int g = 0; g < 16; ++g) s += red[((size_t)g * 128 + col) * 4 + b];
            out[(size_t)b * ldw + cb * 128 + col] = s + bias[cb * 128 + col];
        }
        __syncthreads();
    }
    {
        constexpr int NJ = 13;
        const int ntile[NJ] = {6144, 6144, 2048, 2048, 384, 256, 256, 1280, 1280, 384, 384, 1024, 1024};
        int total = 0;
#pragma unroll
        for (int j = 0; j < NJ; ++j) total += ntile[j];
        for (int tix = BID; tix < total; tix += gridDim.x) {
            int j = 0, rem = tix;
#pragma unroll
            for (int q = 0; q < NJ; ++q) { if (j == q && rem >= ntile[q]) { rem -= ntile[q]; j = q + 1; } }
            const float* src; int ldsrc, K; bf16_t* dst; const float* scale = nullptr; int srccol0, n0, k0;
            if (j < 2) {
                K = 2048; ldsrc = 12288; src = p.in[I_A_W_IN] + (size_t)j * 2048 * 12288; dst = (bf16_t*)(ws + WS_WINA) + (size_t)j * 12288 * 2048;
                const int nt_ = rem / 32; k0 = (rem % 32) * 64; n0 = nt_ * 64;
                const int pn = n0 >> 8, jj = n0 & 255;
                srccol0 = pn < 32 ? (jj < 128 ? 128 * pn + jj : 8192 + 128 * pn + (jj - 128)) : 4096 + 256 * (pn - 32) + jj;
            } else if (j < 4) {
                const int l = j - 2; K = 4096; ldsrc = 2048; src = p.in[I_A_W_OUT] + (size_t)l * 4096 * 2048; dst = (bf16_t*)(ws + WS_WOUTA) + (size_t)l * 2048 * 4096;
                const int nt_ = rem / 64; k0 = (rem % 64) * 64; n0 = nt_ * 64; srccol0 = n0;
            } else if (j == 4) {
                K = 2048; ldsrc = 576; src = p.in[I_KV_W_DKV]; dst = (bf16_t*)(ws + WS_WDKV);
                const int nt_ = rem / 32; k0 = (rem % 32) * 64; n0 = nt_ * 64; srccol0 = n0 < 576 ? n0 : -1;
            } else if (j < 7) {
                K = 512; ldsrc = 4096; src = p.in[I_KV_W_UKV]; dst = (bf16_t*)(ws + (j == 5 ? WS_WKN : WS_WV)); scale = p.in[I_KV_G_KVA];
                const int nt_ = rem / 8; k0 = (rem % 8) * 64; n0 = nt_ * 64;
                srccol0 = (n0 >> 7) * 256 + (j == 6 ? 128 : 0) + (n0 & 127);
            } else if (j < 9) {
                const int l = j - 7; K = 2048; ldsrc = 2560; src = p.in[I_B_W_IN] + (size_t)l * 2048 * 2560; dst = (bf16_t*)(ws + WS_WINB) + (size_t)l * 2560 * 2048;
                const int nt_ = rem / 32; k0 = (rem % 32) * 64; n0 = nt_ * 64; srccol0 = n0;
            } else if (j < 11) {
                const int l = j - 9; K = 512; ldsrc = 3072; src = p.in[I_B_W_UQ] + (size_t)l * 512 * 3072; dst = (bf16_t*)(ws + WS_WUQ) + (size_t)l * 3072 * 512; scale = p.in[I_B_G_QA] + l * 512;
                const int nt_ = rem / 8; k0 = (rem % 8) * 64; n0 = nt_ * 64; srccol0 = n0;
            } else {
                const int l = j - 11; K = 2048; ldsrc = 2048; src = p.in[I_B_W_OUT] + (size_t)l * 2048 * 2048; dst = (bf16_t*)(ws + WS_WOUTB) + (size_t)l * 2048 * 2048;
                const int nt_ = rem / 32; k0 = (rem % 32) * 64; n0 = nt_ * 64; srccol0 = n0;
            }
            conv_tile(TID, shm, src, ldsrc, srccol0, K, k0, dst, n0, scale);
        }
    }
}

__device__ __forceinline__ void phase_norm(const int TID, const int BID, const float* x, const float* g1, const float* sh1, const float* sc1, int ld1, bf16_t* h1,
                           const float* g2, const float* sh2, const float* sc2, int ld2, bf16_t* h2) {
    const int lane = TID & 63, wid = TID >> 6;
    for (int row = BID * 8 + wid; row < T; row += gridDim.x * 8) {
        const int b = row >> 13;
        const f32x4* xr = (const f32x4*)(x + (size_t)row * DM);
        f32x4 v[8]; float ss = 0.f;
#pragma unroll
        for (int i = 0; i < 8; ++i) { v[i] = xr[lane + 64 * i]; ss += v[i][0] * v[i][0] + v[i][1] * v[i][1] + v[i][2] * v[i][2] + v[i][3] * v[i][3]; }
#pragma unroll
        for (int o = 32; o >= 1; o >>= 1) ss += __shfl_xor(ss, o);
        const float rs = rsqrtf(ss * (1.0f / 2048.0f) + EPS);
#pragma unroll
        for (int i = 0; i < 8; ++i) {
            const int k = 4 * (lane + 64 * i);
            const f32x4 gg = *(const f32x4*)(g1 + k), sc = *(const f32x4*)(sc1 + (size_t)b * ld1 + k), sh = *(const f32x4*)(sh1 + (size_t)b * ld1 + k);
            const f32x4 o = (v[i] * rs) * gg * (sc + 1.0f) + sh;
            u32x2 w = {cvt_pk_bf16(o[0], o[1]), cvt_pk_bf16(o[2], o[3])};
            *(u32x2*)(h1 + (size_t)row * DM + k) = w;
        }
        if (h2) {
#pragma unroll
            for (int i = 0; i < 8; ++i) {
                const int k = 4 * (lane + 64 * i);
                const f32x4 gg = *(const f32x4*)(g2 + k), sc = *(const f32x4*)(sc2 + (size_t)b * ld2 + k), sh = *(const f32x4*)(sh2 + (size_t)b * ld2 + k);
                const f32x4 o = (v[i] * rs) * gg * (sc + 1.0f) + sh;
                u32x2 w = {cvt_pk_bf16(o[0], o[1]), cvt_pk_bf16(o[2], o[3])};
                *(u32x2*)(h2 + (size_t)row * DM + k) = w;
            }
        }
    }
}

__device__ __forceinline__ void phase_mix(const int TID, const int BID, unsigned char* shm, bf16_t* P, const bf16_t* GV, const float* stats, const float* w_s, const float* b_s, const float* ln_g, const float* ln_b) {
    constexpr int LD = 136;
    bf16_t* VTl = (bf16_t*)shm;
    bf16_t* WsL = (bf16_t*)(shm + 256 * LD * 2);
    float* st = (float*)(shm + 256 * LD * 2 + 128 * LD * 2);
    const int tid = TID, lane = tid & 63, wid = tid >> 6, l15 = lane & 15, l4 = lane >> 4;
    for (int chunk = BID; chunk < T / 128; chunk += gridDim.x) {
        const int t0 = chunk * 128;
        __syncthreads();
        if (tid < 128) {
            const f32x4* sp = (const f32x4*)(stats + (size_t)(t0 + tid) * 128);
            float s = 0.f, ss = 0.f;
#pragma unroll 8
            for (int i = 0; i < 32; ++i) { const f32x4 v = sp[i]; s += v[0] + v[2]; ss += v[1] + v[3]; }
            const float mean = s * (1.0f / 4096.0f);
            const float var = ss * (1.0f / 4096.0f) - mean * mean;
            st[2 * tid] = mean; st[2 * tid + 1] = rsqrtf(fmaxf(var, 0.f) + EPS);
        }
        __syncthreads();
        for (int g = 0; g < 16; ++g) {
#pragma unroll
            for (int i = 0; i < 8; ++i) {
                const int id = tid + 512 * i, t = id >> 5, s4 = (id & 31) * 4;
                f32x4 w = *(const f32x4*)(w_s + ((size_t)g * 128 + t) * 128 + s4);
#pragma unroll
                for (int e = 0; e < 4; ++e) if (s4 + e > t) w[e] = 0.f;
                u32x2 o = {cvt_pk_bf16(w[0], w[1]), cvt_pk_bf16(w[2], w[3])};
                *(u32x2*)(WsL + t * LD + s4) = o;
            }
#pragma unroll
            for (int i = 0; i < 8; ++i) {
                const int id = tid + 512 * i, s = id >> 5, c8 = (id & 31) * 8;
                const u32x4 raw = *(const u32x4*)(GV + (size_t)(t0 + s) * GMW + g * 256 + c8);
                const float mean = st[2 * s], rstd = st[2 * s + 1];
                const f32x4 g0 = *(const f32x4*)(ln_g + g * 256 + c8), g1 = *(const f32x4*)(ln_g + g * 256 + c8 + 4);
                const f32x4 b0 = *(const f32x4*)(ln_b + g * 256 + c8), b1 = *(const f32x4*)(ln_b + g * 256 + c8 + 4);
                float r[8];
#pragma unroll
                for (int q = 0; q < 4; ++q) { r[2 * q] = bflo(raw[q]); r[2 * q + 1] = bfhi(raw[q]); }
#pragma unroll
                for (int e = 0; e < 8; ++e) {
                    const float gg = e < 4 ? g0[e & 3] : g1[e & 3], bb = e < 4 ? b0[e & 3] : b1[e & 3];
                    const float y = (r[e] - mean) * rstd * gg + bb;
                    const unsigned w = cvt_pk_bf16(y, 0.f);
                    VTl[(c8 + e) * LD + s] = (bf16_t)(w & 0xffffu);
                }
            }
            __syncthreads();
            f32x4 acc[2][8];
#pragma unroll
            for (int cb = 0; cb < 2; ++cb)
#pragma unroll
                for (int tb = 0; tb < 8; ++tb) acc[cb][tb] = (f32x4){0.f, 0.f, 0.f, 0.f};
#pragma unroll
            for (int ks = 0; ks < 4; ++ks) {
                bf16x8 vf[2];
#pragma unroll
                for (int cb = 0; cb < 2; ++cb) vf[cb] = *(const bf16x8*)(VTl + (wid * 32 + cb * 16 + l15) * LD + ks * 32 + l4 * 8);
#pragma unroll
                for (int tb = 0; tb < 8; ++tb) {
                    if (tb >= 2 * ks) {
                        const bf16x8 wf = *(const bf16x8*)(WsL + (tb * 16 + l15) * LD + ks * 32 + l4 * 8);
#pragma unroll
                        for (int cb = 0; cb < 2; ++cb) acc[cb][tb] = __builtin_amdgcn_mfma_f32_16x16x32_bf16(vf[cb], wf, acc[cb][tb], 0, 0, 0);
                    }
                }
            }
#pragma unroll
            for (int tb = 0; tb < 8; ++tb) {
                const int t = tb * 16 + l15;
                const float bs = b_s[g * 128 + t];
#pragma unroll
                for (int cb = 0; cb < 2; ++cb) {
                    bf16_t* pp = P + (size_t)(t0 + t) * GMW + g * 256 + wid * 32 + cb * 16 + l4 * 4;
                    const u32x2 pv = *(const u32x2*)pp;
                    const f32x4 a = acc[cb][tb];
                    u32x2 o = {cvt_pk_bf16(bflo(pv[0]) * (a[0] + bs), bfhi(pv[0]) * (a[1] + bs)), cvt_pk_bf16(bflo(pv[1]) * (a[2] + bs), bfhi(pv[1]) * (a[3] + bs))};
                    *(u32x2*)pp = o;
                }
            }
            __syncthreads();
        }
    }
}

__device__ __forceinline__ void phase_kpost(const int TID, const int BID, bf16_t* KN, const float* KRAW, bf16_t* KROPE, const float* g_kn, const float* g_kr, const float* cosT, const float* sinT) {
    const int lane = TID & 63, wid = TID >> 6;
    const int gw = BID * 8 + wid, nw = gridDim.x * 8;
    {
        const int sub = lane >> 4, l16 = lane & 15;
        const f32x4 ga = *(const f32x4*)(g_kn + l16 * 8), gb = *(const f32x4*)(g_kn + l16 * 8 + 4);
        const size_t nrows = (size_t)T * 16;
        for (size_t r = (size_t)gw * 4 + sub; r < nrows; r += (size_t)nw * 4) {
            u32x4* pp = (u32x4*)(KN + r * 128 + l16 * 8);
            const u32x4 raw = *pp;
            float v[8]; float ss = 0.f;
#pragma unroll
            for (int q = 0; q < 4; ++q) { v[2 * q] = bflo(raw[q]); v[2 * q + 1] = bfhi(raw[q]); ss += v[2 * q] * v[2 * q] + v[2 * q + 1] * v[2 * q + 1]; }
            ss += __shfl_xor(ss, 1); ss += __shfl_xor(ss, 2); ss += __shfl_xor(ss, 4); ss += __shfl_xor(ss, 8);
            const float rs = rsqrtf(ss * (1.0f / 128.0f) + EPS);
#pragma unroll
            for (int e = 0; e < 8; ++e) v[e] = v[e] * rs * (e < 4 ? ga[e & 3] : gb[e & 3]);
            *pp = pack8f(v);
        }
    }
    {
        const float gk = g_kr[lane];
        for (int t = gw; t < T; t += nw) {
            const float x = KRAW[(size_t)t * 64 + lane];
            float ss = x * x;
#pragma unroll
            for (int o = 32; o >= 1; o >>= 1) ss += __shfl_xor(ss, o);
            const float y = x * rsqrtf(ss * (1.0f / 64.0f) + EPS) * gk;
            const float other = __shfl_xor(y, 32);
            const int pos = t & (SEQ - 1), i = lane & 31;
            const float c = cosT[pos * 32 + i], s = sinT[pos * 32 + i];
            const float o = lane < 32 ? (y * c - other * s) : (y * c + other * s);
            KROPE[(size_t)t * 64 + lane] = (bf16_t)(cvt_pk_bf16(o, 0.f) & 0xffffu);
        }
    }
}

__device__ __forceinline__ void phase_attn(const int TID, const int BID, unsigned char* shm, const bf16_t* Q, const bf16_t* KN, const bf16_t* KR, const bf16_t* VT, bf16_t* ZY,
                                           const float* g_qn, const float* g_qr, const float* cosT, const float* sinT) {
    constexpr int KROWB = 400, VROWB = 144, KBYTES = 64 * KROWB, BUFB = KBYTES + 128 * VROWB;
    const int tid = TID, wid = __builtin_amdgcn_readfirstlane(tid >> 6), lane = tid & 63, lq = lane & 31, hi = lane >> 5;
    const int kn_r = tid >> 4, kn_c = tid & 15;
    const int kr_r = tid >> 3, kr_c = tid & 7;
    const int v_r = tid >> 3, v_c = tid & 7;
    const unsigned koff = kn_r * 2048 + kn_c * 8, roff = kr_r * 64 + kr_c * 8, voff = (unsigned)v_r * T + v_c * 8;
    const int kfrag = lq * KROWB + hi * 16;
    const int vfrag = KBYTES + lq * VROWB + hi * 16;
    for (int item = BID; item < 1024; item += gridDim.x) {
        const int bh = item >> 4, pr = item & 15, b = bh >> 4, h = bh & 15;
        const int tokb = b * SEQ;
        for (int half = 0; half < 2; ++half) {
            const int qb = half == 0 ? (31 - pr) : pr;
            const int q0 = qb * 256, nt = 4 * (qb + 1);
            int lqo = lq, hio = hi; asm volatile("" : "+v"(lqo), "+v"(hio));
            const int qrow = q0 + wid * 32 + lq;
            const int qrow_o = q0 + wid * 32 + lqo;
            bf16x8 qf[12];
            {
                const bf16_t* qp = Q + (size_t)(tokb + qrow_o) * 3072 + h * 192 + hio * 8;
#pragma unroll
                for (int ks = 0; ks < 12; ++ks) qf[ks] = *(const bf16x8*)(qp + ks * 16);
                float ssn = 0.f, ssr = 0.f;
#pragma unroll
                for (int ks = 0; ks < 12; ++ks)
#pragma unroll
                    for (int j = 0; j < 8; ++j) { const float v = bf2f((unsigned short)qf[ks][j]); if (ks < 8) ssn += v * v; else ssr += v * v; }
                ssn = x32_sum(ssn); ssr = x32_sum(ssr);
                const float rn = rsqrtf(ssn * (1.0f / 128.0f) + EPS) * QSCALE;
                const float rr = rsqrtf(ssr * (1.0f / 64.0f) + EPS);
#pragma unroll
                for (int ks = 0; ks < 8; ++ks) {
                    const f32x4 ga = *(const f32x4*)(g_qn + ks * 16 + hio * 8), gb = *(const f32x4*)(g_qn + ks * 16 + hio * 8 + 4);
                    float r[8];
#pragma unroll
                    for (int j = 0; j < 8; ++j) r[j] = bf2f((unsigned short)qf[ks][j]) * rn * (j < 4 ? ga[j & 3] : gb[j & 3]);
                    const u32x4 o = pack8f(r);
                    qf[ks] = *(const bf16x8*)&o;
                }
#pragma unroll
                for (int kk = 0; kk < 2; ++kk) {
                    const int i0 = 16 * kk + 8 * hio;
                    float r1[8], r2[8];
#pragma unroll
                    for (int j = 0; j < 8; ++j) {
                        const float x1 = bf2f((unsigned short)qf[8 + kk][j]) * rr * g_qr[i0 + j];
                        const float x2 = bf2f((unsigned short)qf[10 + kk][j]) * rr * g_qr[32 + i0 + j];
                        const float c = cosT[qrow_o * 32 + i0 + j], s = sinT[qrow_o * 32 + i0 + j];
                        r1[j] = (x1 * c - x2 * s) * QSCALE; r2[j] = (x2 * c + x1 * s) * QSCALE;
                    }
                    const u32x4 o1 = pack8f(r1), o2 = pack8f(r2);
                    qf[8 + kk] = *(const bf16x8*)&o1; qf[10 + kk] = *(const bf16x8*)&o2;
                }
            }
            f32x16 O[4];
#pragma unroll
            for (int d = 0; d < 4; ++d)
#pragma unroll
                for (int r = 0; r < 16; ++r) O[d][r] = 0.f;
            float m_run = -1e30f, l_run = 0.f;
            u32x4 st0, st1, st2, st3, st4;
#define ATT_ISSUE_K(t_) do { const size_t tok0 = (size_t)tokb + (size_t)(t_) * 64; \
                const bf16_t* knb = uniform_ptr(KN + tok0 * 2048 + h * 128); const bf16_t* krb = uniform_ptr(KR + tok0 * 64); \
                st0 = *(const u32x4*)(knb + koff); \
                st1 = *(const u32x4*)(knb + koff + 32 * 2048); \
                st2 = *(const u32x4*)(krb + roff); } while (0)
#define ATT_ISSUE_V(t_) do { const size_t tok0 = (size_t)tokb + (size_t)(t_) * 64; \
                const bf16_t* vtb = uniform_ptr(VT + (size_t)(h * 128) * T + tok0); \
                st3 = *(const u32x4*)(vtb + voff); \
                st4 = *(const u32x4*)(vtb + voff + 64 * T); } while (0)
#define ATT_WRITE(buf_) do { unsigned char* bp = shm + (buf_) * BUFB; \
                *(u32x4*)(bp + kn_r * KROWB + kn_c * 16) = st0; \
                *(u32x4*)(bp + (kn_r + 32) * KROWB + kn_c * 16) = st1; \
                *(u32x4*)(bp + kr_r * KROWB + 256 + kr_c * 16) = st2; \
                *(u32x4*)(bp + KBYTES + v_r * VROWB + v_c * 16) = st3; \
                *(u32x4*)(bp + KBYTES + (v_r + 64) * VROWB + v_c * 16) = st4; } while (0)
            __syncthreads();
            ATT_ISSUE_K(0); ATT_ISSUE_V(0);
            ATT_WRITE(0);
            __syncthreads();
            for (int t = 0; t < nt; ++t) {
                const bool has_next = (t + 1 < nt);
                if (has_next) ATT_ISSUE_K(t + 1);
                const int rel = t - (nt - 4);
                const bool active = rel <= (wid >> 1);
                const unsigned char* bp = shm + (t & 1) * BUFB;
                bf16x8 pf[4];
                if (active) {
                    f32x16 S0, S1;
#pragma unroll
                    for (int r = 0; r < 16; ++r) { S0[r] = 0.f; S1[r] = 0.f; }
#define SB_() __builtin_amdgcn_sched_barrier(0)
#define LDK_(dst, ks) do { dst[0] = *(const bf16x8*)(bp + kfrag + (ks) * 32); dst[1] = *(const bf16x8*)(bp + kfrag + 12800 + (ks) * 32); \
                        dst[2] = *(const bf16x8*)(bp + kfrag + ((ks) + 1) * 32); dst[3] = *(const bf16x8*)(bp + kfrag + 12800 + ((ks) + 1) * 32); } while (0)
#define MMK_(s_, ks) do { S0 = __builtin_amdgcn_mfma_f32_32x32x16_bf16(s_[0], qf[ks], S0, 0, 0, 0); S1 = __builtin_amdgcn_mfma_f32_32x32x16_bf16(s_[1], qf[ks], S1, 0, 0, 0); \
                        S0 = __builtin_amdgcn_mfma_f32_32x32x16_bf16(s_[2], qf[(ks) + 1], S0, 0, 0, 0); S1 = __builtin_amdgcn_mfma_f32_32x32x16_bf16(s_[3], qf[(ks) + 1], S1, 0, 0, 0); } while (0)
                    {
                        bf16x8 fa[4], fb[4];
                        LDK_(fa, 0); SB_();
                        LDK_(fb, 2); MMK_(fa, 0); SB_();
                        LDK_(fa, 4); MMK_(fb, 2); SB_();
                        LDK_(fb, 6); MMK_(fa, 4); SB_();
                        LDK_(fa, 8); MMK_(fb, 6); SB_();
                        LDK_(fb, 10); MMK_(fa, 8); SB_();
                        MMK_(fb, 10); SB_();
                    }
                    if (rel >= 0) {
                        const int dq = qrow - t * 64 - 4 * hi;
#pragma unroll
                        for (int r = 0; r < 16; ++r) {
                            const int c = (r & 3) + 8 * (r >> 2);
                            if (c > dq) S0[r] = -__builtin_inff();
                            if (c + 32 > dq) S1[r] = -__builtin_inff();
                        }
                    }
                    float mx = S0[0];
#pragma unroll
                    for (int r = 1; r < 16; ++r) mx = fmaxf(mx, S0[r]);
#pragma unroll
                    for (int r = 0; r < 16; ++r) mx = fmaxf(mx, S1[r]);
                    mx = x32_max(mx);
                    const float mn = fmaxf(m_run, mx);
                    const float alpha = __builtin_amdgcn_exp2f(m_run - mn);
                    m_run = mn;
                    float ps = 0.f;
#pragma unroll
                    for (int r = 0; r < 16; ++r) { S0[r] = __builtin_amdgcn_exp2f(S0[r] - mn); S1[r] = __builtin_amdgcn_exp2f(S1[r] - mn); ps += S0[r] + S1[r]; }
                    l_run = l_run * alpha + ps;
#pragma unroll
                    for (int d = 0; d < 4; ++d)
#pragma unroll
                        for (int r = 0; r < 16; ++r) O[d][r] *= alpha;
                    {
                        u32x4 a = {cvt_pk_bf16(S0[0], S0[1]), cvt_pk_bf16(S0[2], S0[3]), cvt_pk_bf16(S0[4], S0[5]), cvt_pk_bf16(S0[6], S0[7])};
                        u32x4 bq = {cvt_pk_bf16(S0[8], S0[9]), cvt_pk_bf16(S0[10], S0[11]), cvt_pk_bf16(S0[12], S0[13]), cvt_pk_bf16(S0[14], S0[15])};
                        u32x4 c = {cvt_pk_bf16(S1[0], S1[1]), cvt_pk_bf16(S1[2], S1[3]), cvt_pk_bf16(S1[4], S1[5]), cvt_pk_bf16(S1[6], S1[7])};
                        u32x4 d = {cvt_pk_bf16(S1[8], S1[9]), cvt_pk_bf16(S1[10], S1[11]), cvt_pk_bf16(S1[12], S1[13]), cvt_pk_bf16(S1[14], S1[15])};
                        pf[0] = *(const bf16x8*)&a; pf[1] = *(const bf16x8*)&bq; pf[2] = *(const bf16x8*)&c; pf[3] = *(const bf16x8*)&d;
                    }
                }
                if (has_next) ATT_ISSUE_V(t + 1);
                if (active) {
#define LDV_(dst, dp, kp) do { dst[0] = *(const bf16x8*)(bp + vfrag + (2 * (dp)) * 4608 + (2 * (kp)) * 32); dst[1] = *(const bf16x8*)(bp + vfrag + (2 * (dp) + 1) * 4608 + (2 * (kp)) * 32); \
                        dst[2] = *(const bf16x8*)(bp + vfrag + (2 * (dp)) * 4608 + (2 * (kp) + 1) * 32); dst[3] = *(const bf16x8*)(bp + vfrag + (2 * (dp) + 1) * 4608 + (2 * (kp) + 1) * 32); } while (0)
#define MMV_(s_, dp, kp) do { O[2 * (dp)] = __builtin_amdgcn_mfma_f32_32x32x16_bf16(s_[0], pf[2 * (kp)], O[2 * (dp)], 0, 0, 0); O[2 * (dp) + 1] = __builtin_amdgcn_mfma_f32_32x32x16_bf16(s_[1], pf[2 * (kp)], O[2 * (dp) + 1], 0, 0, 0); \
                        O[2 * (dp)] = __builtin_amdgcn_mfma_f32_32x32x16_bf16(s_[2], pf[2 * (kp) + 1], O[2 * (dp)], 0, 0, 0); O[2 * (dp) + 1] = __builtin_amdgcn_mfma_f32_32x32x16_bf16(s_[3], pf[2 * (kp) + 1], O[2 * (dp) + 1], 0, 0, 0); } while (0)
                    {
                        bf16x8 fa[4], fb[4];
                        SB_();
                        LDV_(fa, 0, 0); SB_();
                        LDV_(fb, 0, 1); MMV_(fa, 0, 0); SB_();
                        LDV_(fa, 1, 0); MMV_(fb, 0, 1); SB_();
                        LDV_(fb, 1, 1); MMV_(fa, 1, 0); SB_();
                        MMV_(fb, 1, 1); SB_();
                    }
                }
                if (has_next) ATT_WRITE((t + 1) & 1);
                __syncthreads();
            }
#undef SB_
#undef LDK_
#undef MMK_
#undef LDV_
#undef MMV_
#undef ATT_ISSUE_K
#undef ATT_ISSUE_V
#undef ATT_WRITE
            const float lt = x32_sum(l_run);
            const float inv = 1.0f / lt;
            int lqe = lq, hie = hi; asm volatile("" : "+v"(lqe), "+v"(hie));
            bf16_t* yp = ZY + (size_t)(tokb + q0 + wid * 32 + lqe) * 2048 + h * 128 + 4 * hie;
#pragma unroll
            for (int db = 0; db < 4; ++db)
#pragma unroll
                for (int g4 = 0; g4 < 4; ++g4) {
                    bf16_t* pp = yp + db * 32 + g4 * 8;
                    const u32x2 zv = *(const u32x2*)pp;
                    u32x2 o = {cvt_pk_bf16(O[db][4 * g4 + 0] * inv * bflo(zv[0]), O[db][4 * g4 + 1] * inv * bfhi(zv[0])),
                               cvt_pk_bf16(O[db][4 * g4 + 2] * inv * bflo(zv[1]), O[db][4 * g4 + 3] * inv * bfhi(zv[1]))};
                    *(u32x2*)pp = o;
                }
        }
    }
}

enum { PH_PREP = 0, PH_NORM_A0, PH_AIN0, PH_MIX0, PH_AOUT0, PH_NORM_A1, PH_AIN1, PH_MIX1, PH_AOUT1, PH_NORM_KV, PH_DKV_BIN0, PH_UKV_UQ0, PH_KPOST, PH_ATTN0, PH_BOUT0,
       PH_NORM_B1, PH_BIN1, PH_UQ1, PH_ATTN1, PH_BOUT1, NPH };

__global__ void __launch_bounds__(512, 2) mega(Params p) {
    extern __shared__ __attribute__((aligned(16))) unsigned char shm[];
    LAS unsigned char* lds = (LAS unsigned char*)shm;
    for (int ph = p.ph_lo; ph < p.ph_hi; ++ph) {
        int TID = threadIdx.x, BID = blockIdx.x; unsigned char* ws = p.ws;
        asm volatile("" : "+v"(TID), "+s"(BID), "+s"(ws));
        const float* mod = (const float*)(ws + WS_MOD);
        const float* kvmod = (const float*)(ws + WS_KVMOD);
        const float* cosT = (const float*)(ws + WS_COS);
        const float* sinT = (const float*)(ws + WS_SIN);
        switch (ph) {
#if PHSEL & 1
        case PH_PREP: phase_prep(TID, BID, p, ws, shm); break;
#endif
#if PHSEL & 2
        case PH_NORM_A0: case PH_NORM_A1: case PH_NORM_B1: {
            const int l = ph == PH_NORM_A0 ? 0 : (ph == PH_NORM_A1 ? 1 : 3);
            const float* x = l == 0 ? p.in[I_X] : p.out;
            const float* m = mod + (size_t)l * 4 * 6144;
            phase_norm(TID, BID, x, p.in[I_NORM_G] + l * DM, m, m + 2048, 6144, (bf16_t*)(ws + WA_H), nullptr, nullptr, nullptr, 0, nullptr);
        } break;
#endif
#if PHSEL & 4
        case PH_NORM_KV: {
            const float* m = mod + (size_t)2 * 4 * 6144;
            phase_norm(TID, BID, p.out, p.in[I_NORM_G] + 2 * DM, m, m + 2048, 6144, (bf16_t*)(ws + WB_H), p.in[I_KV_NORM_G], kvmod, kvmod + 2048, 4096, (bf16_t*)(ws + WB_HKV));
        } break;
#endif
#if PHSEL & 8
        case PH_AIN0: case PH_AIN1: {
            const int l = ph == PH_AIN0 ? 0 : 1;
            EpiAin E{(bf16_t*)(ws + WA_P), (bf16_t*)(ws + WA_GV), (float*)(ws + WA_STATS)};
            run_gemm(TID, BID, lds, (const bf16_t*)(ws + WA_H), (const bf16_t*)(ws + WS_WINA) + (size_t)l * 12288 * 2048, T, 12288, 2048, E);
        } break;
#endif
#if PHSEL & 16
        case PH_MIX0: case PH_MIX1: {
            const int l = ph == PH_MIX0 ? 0 : 1;
            phase_mix(TID, BID, shm, (bf16_t*)(ws + WA_P), (const bf16_t*)(ws + WA_GV), (const float*)(ws + WA_STATS), p.in[I_A_W_S] + (size_t)l * 16 * 128 * 128, p.in[I_A_B_S] + l * 16 * 128,
                      p.in[I_A_LN_G] + l * GMW, p.in[I_A_LN_B] + l * GMW);
        } break;
#endif
#if PHSEL & 32
        case PH_AOUT0: case PH_AOUT1: case PH_BOUT0: case PH_BOUT1: {
            const int l = ph == PH_AOUT0 ? 0 : (ph == PH_AOUT1 ? 1 : (ph == PH_BOUT0 ? 2 : 3));
            const float* xin = l == 0 ? p.in[I_X] : p.out;
            EpiRes E{xin, p.out, mod + (size_t)l * 4 * 6144 + 4096, 6144};
            const bf16_t* A = l < 2 ? (const bf16_t*)(ws + WA_P) : (const bf16_t*)(ws + WB_Z);
            const bf16_t* Bt = l < 2 ? (const bf16_t*)(ws + WS_WOUTA) + (size_t)l * 2048 * 4096 : (const bf16_t*)(ws + WS_WOUTB) + (size_t)(l - 2) * 2048 * 2048;
            run_gemm(TID, BID, lds, A, Bt, T, 2048, l < 2 ? 4096 : 2048, E);
        } break;
#endif
#if PHSEL & 64
        case PH_DKV_BIN0: case PH_BIN1: {
            if (ph == PH_DKV_BIN0) {
                EpiLat<0> E{(bf16_t*)(ws + WB_CKV), (float*)(ws + WB_SSQKV), (float*)(ws + WB_KRAW), nullptr};
                run_gemm(TID, BID, lds, (const bf16_t*)(ws + WB_HKV), (const bf16_t*)(ws + WS_WDKV), T, 768, 2048, E);
            }
            const int j = ph == PH_DKV_BIN0 ? 0 : 1;
            EpiLat<1> E{(bf16_t*)(ws + WB_CQ), (float*)(ws + WB_SSQQ), nullptr, (bf16_t*)(ws + WB_Z)};
            run_gemm(TID, BID, lds, (const bf16_t*)(ws + WB_H), (const bf16_t*)(ws + WS_WINB) + (size_t)j * 2560 * 2048, T, 2560, 2048, E);
        } break;
#endif
#if PHSEL & 128
        case PH_UKV_UQ0: case PH_UQ1: {
            if (ph == PH_UKV_UQ0) {
                EpiScaled E{(bf16_t*)(ws + WB_KN), 2048, (const float*)(ws + WB_SSQKV)};
                run_gemm(TID, BID, lds, (const bf16_t*)(ws + WB_CKV), (const bf16_t*)(ws + WS_WKN), T, 2048, 512, E);
                EpiVT E2{(bf16_t*)(ws + WB_VT), (const float*)(ws + WB_SSQKV)};
                run_gemm(TID, BID, lds, (const bf16_t*)(ws + WS_WV), (const bf16_t*)(ws + WB_CKV), 2048, T, 512, E2);
            }
            const int j = ph == PH_UKV_UQ0 ? 0 : 1;
            EpiScaled E{(bf16_t*)(ws + WB_Q), 3072, (const float*)(ws + WB_SSQQ)};
            run_gemm(TID, BID, lds, (const bf16_t*)(ws + WB_CQ), (const bf16_t*)(ws + WS_WUQ) + (size_t)j * 3072 * 512, T, 3072, 512, E);
        } break;
#endif
#if PHSEL & 256
        case PH_KPOST:
            phase_kpost(TID, BID, (bf16_t*)(ws + WB_KN), (const float*)(ws + WB_KRAW), (bf16_t*)(ws + WB_KROPE), p.in[I_KV_G_KN], p.in[I_KV_G_KR], cosT, sinT);
            break;
#endif
#if PHSEL & 512
        case PH_ATTN0: case PH_ATTN1: {
            const int j = ph == PH_ATTN0 ? 0 : 1;
            phase_attn(TID, BID, shm, (const bf16_t*)(ws + WB_Q), (const bf16_t*)(ws + WB_KN), (const bf16_t*)(ws + WB_KROPE), (const bf16_t*)(ws + WB_VT), (bf16_t*)(ws + WB_Z),
                       p.in[I_B_G_QN] + j * 128, p.in[I_B_G_QR] + j * 64, cosT, sinT);
        } break;
#endif
        default: break;
        }
        if (ph + 1 < p.ph_hi) cg::this_grid().sync();
    }
}

extern "C" void kernel_launch(void* const* d_in, const int* in_sizes, int n_in, void* d_out, int out_size, void* d_ws, size_t ws_size, hipStream_t stream) {
    static int grid = 0;
    if (grid == 0) {
        if (n_in != 25 || ws_size < WS_NEED) { fprintf(stderr, "kernel_launch: unexpected n_in %d / ws %zu (need %zu)\n", n_in, ws_size, (size_t)WS_NEED); grid = -1; return; }
        int dev = 0, cus = 0, per_cu = 0;
        hipGetDevice(&dev);
        hipDeviceGetAttribute(&cus, hipDeviceAttributeMultiprocessorCount, dev);
        if (hipFuncSetAttribute((const void*)mega, hipFuncAttributeMaxDynamicSharedMemorySize, LDS_BYTES) != hipSuccess) { fprintf(stderr, "kernel_launch: hipFuncSetAttribute failed\n"); grid = -1; return; }
        if (hipOccupancyMaxActiveBlocksPerMultiprocessor(&per_cu, (const void*)mega, 512, LDS_BYTES) != hipSuccess || per_cu < 1) { fprintf(stderr, "kernel_launch: occupancy query gave %d\n", per_cu); per_cu = 1; }
        (void)hipGetLastError();
        grid = cus * per_cu;
    }
    if (grid < 0) return;
    Params p{};
    for (int i = 0; i < 25; ++i) p.in[i] = (const float*)d_in[i];
    p.out = (float*)d_out; p.ws = (unsigned char*)d_ws;
#if MK_SINGLE
    p.ph_lo = 0; p.ph_hi = NPH;
    void* args[] = {&p};
    hipError_t e = hipLaunchCooperativeKernel((const void*)mega, dim3(grid), dim3(512), args, LDS_BYTES, stream);
    if (e != hipSuccess) fprintf(stderr, "cooperative launch failed: %s (grid %d)\n", hipGetErrorString(e), grid);
#else
    for (int ph = 0; ph < NPH; ++ph) {
        p.ph_lo = ph; p.ph_hi = ph + 1;
        hipLaunchKernelGGL(mega, dim3(grid), dim3(512), LDS_BYTES, stream, p);
    }
#endif
}
```

```cpp
#include <hip/hip_runtime.h>
#include <hip/hip_cooperative_groups.h>
#include <cstdio>
#include <cstdint>
namespace cg = cooperative_groups;

#ifndef PHSEL
#define PHSEL 0xFFFF
#endif
#ifndef REP_ATTN
#define REP_ATTN 1
#endif
#ifndef REP_AIN
#define REP_AIN 1
#endif
#ifndef REP_GEMM
#define REP_GEMM 1
#endif
#ifndef REP_LIGHT
#define REP_LIGHT 1
#endif
#ifndef MK_SINGLE
#define MK_SINGLE 1
#endif

typedef unsigned short bf16_t;
typedef short bf16x8 __attribute__((ext_vector_type(8)));
typedef float f32x2 __attribute__((ext_vector_type(2)));
typedef float f32x4 __attribute__((ext_vector_type(4)));
typedef float f32x16 __attribute__((ext_vector_type(16)));
typedef unsigned u32x4 __attribute__((ext_vector_type(4)));
typedef unsigned u32x2 __attribute__((ext_vector_type(2)));
#define LAS __attribute__((address_space(3)))
#define GAS __attribute__((address_space(1)))

constexpr int T = 32768, DM = 2048, SEQ = 8192, NBATCH = 4;
constexpr int GMW = 4096;
constexpr float EPS = 1e-6f;
constexpr float QSCALE = 0.07216878364870322f * 1.4426950408889634f;

constexpr size_t WS_BAR = 0;
constexpr size_t WS_MOD = 4096;
constexpr size_t WS_KVMOD = WS_MOD + 4ull * 4 * 6144 * 4;
constexpr size_t WS_COS = WS_KVMOD + 4ull * 4096 * 4;
constexpr size_t WS_SIN = WS_COS + 8192ull * 32 * 4;
constexpr size_t WS_WINA = WS_SIN + 8192ull * 32 * 4;
constexpr size_t WS_WOUTA = WS_WINA + 2ull * 12288 * 2048 * 2;
constexpr size_t WS_WDKV = WS_WOUTA + 2ull * 2048 * 4096 * 2;
constexpr size_t WS_WKN = WS_WDKV + 768ull * 2048 * 2;
constexpr size_t WS_WV = WS_WKN + 2048ull * 512 * 2;
constexpr size_t WS_WINB = WS_WV + 2048ull * 512 * 2;
constexpr size_t WS_WUQ = WS_WINB + 2ull * 2560 * 2048 * 2;
constexpr size_t WS_WOUTB = WS_WUQ + 2ull * 3072 * 512 * 2;
constexpr size_t WS_WS16 = WS_WOUTB + 2ull * 2048 * 2048 * 2;
constexpr size_t WS_ACT = WS_WS16 + 2ull * 16 * 128 * 128 * 2;
constexpr size_t WA_H = WS_ACT;
constexpr size_t WA_P = WA_H + (size_t)T * 2048 * 2;
constexpr size_t WA_GVT = WA_P + (size_t)T * 4096 * 2;
constexpr size_t WA_STATS = WA_GVT + (size_t)T * 4096 * 2;
constexpr size_t WA_END = WA_STATS + (size_t)T * 32 * 2 * 4;
constexpr size_t WB_H = WS_ACT;
constexpr size_t WB_HKV = WB_H + (size_t)T * 2048 * 2;
constexpr size_t WB_Q = WS_ACT;
constexpr size_t WB_CKV = WB_HKV + (size_t)T * 2048 * 2;
constexpr size_t WB_CQ = WB_CKV + (size_t)T * 512 * 2;
constexpr size_t WB_KRAW = WB_CQ + (size_t)T * 512 * 2;
constexpr size_t WB_KROPE = WB_KRAW + (size_t)T * 64 * 4;
constexpr size_t WB_SSQKV = WB_KROPE + (size_t)T * 64 * 2;
constexpr size_t WB_SSQQ = WB_SSQKV + (size_t)T * 8 * 4;
constexpr size_t WB_Z = WB_SSQQ + (size_t)T * 8 * 4;
constexpr size_t WB_KN = WB_Z + (size_t)T * 2048 * 2;
constexpr size_t WB_VT = WB_KN + (size_t)T * 2048 * 2;
constexpr size_t WB_END = WB_VT + (size_t)T * 2048 * 2;
constexpr size_t WB_Y = WB_Q + (size_t)T * 3072 * 2;
static_assert(WB_Y + (size_t)T * 2048 * 2 == WB_KRAW, "Y overlay");
constexpr size_t WS_NEED = WA_END > WB_END ? WA_END : WB_END;
static_assert(WS_NEED <= (1ull << 30), "workspace");

constexpr int LDS_BYTES = 131072;

__device__ __forceinline__ unsigned cvt_pk_bf16(float lo, float hi) { unsigned r; asm volatile("v_cvt_pk_bf16_f32 %0, %1, %2" : "=v"(r) : "v"(lo), "v"(hi)); return r; }
__device__ __forceinline__ float bf2f(unsigned short v) { return __uint_as_float(((unsigned)v) << 16); }
__device__ __forceinline__ float bflo(unsigned w) { return __uint_as_float(w << 16); }
__device__ __forceinline__ float bfhi(unsigned w) { return __uint_as_float(w & 0xffff0000u); }
__device__ __forceinline__ float gelu_f(float x) {
    const float u = x * (1.0f + 0.044715f * x * x);
    const float e = __builtin_amdgcn_exp2f(-2.302208198f * u);
    return x * __builtin_amdgcn_rcpf(1.0f + e);
}
__device__ __forceinline__ float silu_f(float x) { const float e = __builtin_amdgcn_exp2f(-1.4426950408889634f * x); return x * __builtin_amdgcn_rcpf(1.0f + e); }
__device__ __forceinline__ u32x4 pack8f(const float* r) { u32x4 o = {cvt_pk_bf16(r[0], r[1]), cvt_pk_bf16(r[2], r[3]), cvt_pk_bf16(r[4], r[5]), cvt_pk_bf16(r[6], r[7])}; return o; }

template <class Tp> __device__ __forceinline__ Tp* uniform_ptr(Tp* p) {
    const unsigned long long v = (unsigned long long)p; const unsigned lo = __builtin_amdgcn_readfirstlane((unsigned)v), hi = __builtin_amdgcn_readfirstlane((unsigned)(v >> 32));
    return (Tp*)(GAS Tp*)(((unsigned long long)hi << 32) | lo);
}
__device__ __forceinline__ float x32_sum(float v) { auto rr = __builtin_amdgcn_permlane32_swap(__float_as_uint(v), __float_as_uint(v), false, false); return __uint_as_float(rr[0]) + __uint_as_float(rr[1]); }
__device__ __forceinline__ float x32_max(float v) { auto rr = __builtin_amdgcn_permlane32_swap(__float_as_uint(v), __float_as_uint(v), false, false); return fmaxf(__uint_as_float(rr[0]), __uint_as_float(rr[1])); }

__device__ __forceinline__ void grid_bar(unsigned* bar, const unsigned epoch, const int TID, const int BID) {
    __syncthreads();
    if (TID == 0) {
        const unsigned G = gridDim.x, g = (unsigned)BID & 7u;
        const unsigned cnt = (G + 7u - g) >> 3;
        const unsigned ngrp = G < 8u ? G : 8u;
        __builtin_amdgcn_fence(__ATOMIC_RELEASE, "agent");
        const unsigned old = __hip_atomic_fetch_add(bar + 64 * (1 + g), 1u, __ATOMIC_RELAXED, __HIP_MEMORY_SCOPE_AGENT);
        if (old + 1u == cnt * epoch) {
            __builtin_amdgcn_fence(__ATOMIC_ACQ_REL, "agent");
            __hip_atomic_fetch_add(bar, 1u, __ATOMIC_RELAXED, __HIP_MEMORY_SCOPE_AGENT);
        }
        while (__hip_atomic_load(bar, __ATOMIC_RELAXED, __HIP_MEMORY_SCOPE_AGENT) < ngrp * epoch) __builtin_amdgcn_s_sleep(1);
        __builtin_amdgcn_fence(__ATOMIC_ACQUIRE, "agent");
    }
    __syncthreads();
}

namespace pg8 {
constexpr int BM = 256, BK = 64, HALF = 128, HTB = HALF * BK * 2, STAGE_BYTES = 8 * HTB, NXCD = 8, WGM = 8;
__host__ __device__ __forceinline__ int lds_byte(int r, int c) { const int st = (r >> 4) * 2 + (c >> 5), rr = r & 15, cc = c & 31, ob = rr * 64 + cc * 2; return st * 1024 + (ob ^ (((ob >> 9) & 1) << 5)); }
__host__ __device__ __forceinline__ void stage_rc(int b, int& R, int& C) { const int st = b / 1024, sb = b % 1024, swz = sb ^ (((sb >> 9) & 1) << 5); R = (st >> 1) * 16 + swz / 64; C = (st & 1) * 32 + (swz % 64) / 2; }
__host__ __device__ __forceinline__ int perm32(int rho) { const int n = rho >> 4, i = rho & 15; return 8 * (i >> 2) + 4 * n + (i & 3); }
struct Unit { int pm, pn; };
struct Gemm { const bf16_t* A; const bf16_t* Bt; int M, N, K; };
struct StaticOrder {
    int nM, nN, nwg, G, c;
    __host__ __device__ void init(int M, int N, int G_, int c_) { nM = M / BM; nN = N / BM; nwg = nM * nN; G = G_; c = c_; }
    __host__ __device__ bool next(int i, Unit& u) const {
        const long L = (long)i * G + c; if (L >= nwg) return false;
        int wgid = (int)L; { const int q = nwg / NXCD, r = nwg % NXCD, xcd = wgid % NXCD, off = wgid / NXCD; wgid = (xcd < r ? xcd * (q + 1) : r * (q + 1) + (xcd - r) * q) + off; }
        const int nig = WGM * nN, gid = wgid / nig, fm = gid * WGM, gsz = (nM - fm) < WGM ? (nM - fm) : WGM;
        u.pm = fm + ((wgid % nig) % gsz); u.pn = (wgid % nig) / gsz; return true;
    }
    __device__ __forceinline__ void a_ready(const Unit&) const {}
    __device__ __forceinline__ void done(const Unit&) const {}
};

template <class Epi, class Sched>
__device__ __forceinline__ void gemm_phase(const int TID, LAS unsigned char* lds, const Gemm g, const Sched& S, const Epi& E) {
    const int tid = TID, wid = __builtin_amdgcn_readfirstlane(tid >> 6), lane = tid & 63, wr = wid >> 2, wc = wid & 3, fr = lane & 15, fq = lane >> 4;
    const int K = g.K, nt = K / BK;
    unsigned voffA[2], voffB[2];
#pragma unroll
    for (int i = 0; i < 2; ++i) { int R, C; stage_rc(tid * 16 + i * 8192, R, C); const int Rb = Epi::PERM ? ((R & ~31) + perm32(R & 31)) : R;
        voffA[i] = (unsigned)(R * K + C) * 2u; voffB[i] = (unsigned)(Rb * K + C) * 2u; }
    const size_t kstep = (size_t)(BK * 2);
    const size_t hstep = (size_t)HALF * K * 2;
    const size_t tstep = 2 * hstep;
    const unsigned ldsw = (unsigned)wid * 1024u;
    const int aoff = lds_byte(wr * 64 + fr, fq * 8), boff = lds_byte(wc * 32 + fr, fq * 8);
#define PG8_SA(b, h) (((b) * 2 + (h)) * HTB)
#define PG8_SB(b, h) ((4 + (b) * 2 + (h)) * HTB)
#define PG8_STAGE(bufoff, gbase, voff) do { _Pragma("unroll") for (int _i = 0; _i < 2; ++_i) \
        __builtin_amdgcn_global_load_lds((const unsigned*)((const char*)(gbase) + (voff)[_i]), (LAS unsigned*)(lds + (bufoff) + ldsw + _i * 8192), 16, 0, 0); } while (0)
#define PG8_LDA(dst, b, h) do { _Pragma("unroll") for (int m = 0; m < 4; ++m) _Pragma("unroll") for (int k = 0; k < 2; ++k) dst[m][k] = *(const LAS bf16x8*)(lds + PG8_SA(b, h) + aoff + m * 2048 + k * 1024); } while (0)
#define PG8_LDB(dst, b, h) do { _Pragma("unroll") for (int n = 0; n < 2; ++n) _Pragma("unroll") for (int k = 0; k < 2; ++k) dst[n][k] = *(const LAS bf16x8*)(lds + PG8_SB(b, h) + boff + n * 2048 + k * 1024); } while (0)
#define PG8_MMA(ai, bj, At, Bt) do { __builtin_amdgcn_s_setprio(1); _Pragma("unroll") for (int m = 0; m < 4; ++m) _Pragma("unroll") for (int n = 0; n < 2; ++n) _Pragma("unroll") for (int k = 0; k < 2; ++k) \
        acc[ai][bj][m][n] = __builtin_amdgcn_mfma_f32_16x16x32_bf16(Bt[n][k], At[m][k], acc[ai][bj][m][n], 0, 0, 0); __builtin_amdgcn_s_setprio(0); } while (0)
#define PG8_WAIT_V(n) asm volatile("s_waitcnt vmcnt(" #n ")" ::: "memory")
#define PG8_WAIT_L(n) asm volatile("s_waitcnt lgkmcnt(" #n ")" ::: "memory")
#define PG8_BAR __builtin_amdgcn_s_barrier()
#define PG8_SCHED __builtin_amdgcn_sched_barrier(0)
    Unit cur, nxt; int ui = 0;
    if (!S.next(0, cur)) return;
    f32x4 acc[2][2][4][2];
#pragma unroll
    for (int a = 0; a < 2; ++a)
#pragma unroll
        for (int b = 0; b < 2; ++b)
#pragma unroll
            for (int m = 0; m < 4; ++m)
#pragma unroll
                for (int n = 0; n < 2; ++n) acc[a][b][m][n] = (f32x4){0.f, 0.f, 0.f, 0.f};
    bf16x8 At[4][2], B0[2][2], B1[2][2];
    const char* cA = (const char*)g.A + (size_t)cur.pm * tstep; const char* cB = (const char*)g.Bt + (size_t)cur.pn * tstep;
    S.a_ready(cur);
    PG8_STAGE(PG8_SB(0, 0), cB, voffB); PG8_STAGE(PG8_SA(0, 0), cA, voffA); PG8_STAGE(PG8_SB(0, 1), cB + hstep, voffB); PG8_STAGE(PG8_SA(0, 1), cA + hstep, voffA);
    if (wr == 1) PG8_BAR;
    PG8_WAIT_V(4); PG8_BAR;
    PG8_STAGE(PG8_SB(1, 0), cB + kstep, voffB); PG8_STAGE(PG8_SA(1, 0), cA + kstep, voffA); PG8_STAGE(PG8_SB(1, 1), cB + hstep + kstep, voffB);
    PG8_WAIT_V(6); PG8_BAR;
    for (;;) {
        const bool has_next = S.next(ui + 1, nxt);
        const char* nA = has_next ? (const char*)g.A + (size_t)nxt.pm * tstep : cA; const char* nB = has_next ? (const char*)g.Bt + (size_t)nxt.pn * tstep : cB;
        for (int t = 0; t < nt; t += 2) {
            const bool last = (t == nt - 2);
            const char* a1 = cA + (size_t)(t + 1) * kstep;
            const char* a2 = last ? nA : cA + (size_t)(t + 2) * kstep; const char* b2 = last ? nB : cB + (size_t)(t + 2) * kstep;
            const char* a3 = a2 + kstep; const char* b3 = b2 + kstep;
            if (last && has_next) S.a_ready(nxt);
            PG8_LDB(B0, 0, 0); PG8_SCHED; PG8_LDA(At, 0, 0); PG8_STAGE(PG8_SA(1, 1), a1 + hstep, voffA);
            PG8_WAIT_L(8); PG8_BAR; PG8_WAIT_L(0); PG8_MMA(0, 0, At, B0); PG8_BAR; PG8_SCHED;
            PG8_LDB(B1, 0, 1); PG8_STAGE(PG8_SB(0, 0), b2, voffB);
            PG8_BAR; PG8_WAIT_L(0); PG8_MMA(0, 1, At, B1); PG8_BAR;
            PG8_LDA(At, 0, 1); PG8_STAGE(PG8_SA(0, 0), a2, voffA);
            PG8_BAR; PG8_WAIT_L(0); PG8_MMA(1, 0, At, B0); PG8_BAR; PG8_SCHED;
            PG8_STAGE(PG8_SB(0, 1), b2 + hstep, voffB);
            PG8_WAIT_V(6); PG8_BAR; PG8_MMA(1, 1, At, B1); PG8_BAR;
            PG8_LDB(B0, 1, 0); PG8_SCHED; PG8_LDA(At, 1, 0); PG8_STAGE(PG8_SA(0, 1), a2 + hstep, voffA);
            PG8_WAIT_L(8); PG8_BAR; PG8_WAIT_L(0); PG8_MMA(0, 0, At, B0); PG8_BAR; PG8_SCHED;
            PG8_LDB(B1, 1, 1); PG8_STAGE(PG8_SB(1, 0), b3, voffB);
            PG8_BAR; PG8_WAIT_L(0); PG8_MMA(0, 1, At, B1); PG8_BAR;
            PG8_LDA(At, 1, 1); PG8_STAGE(PG8_SA(1, 0), a3, voffA);
            PG8_BAR; PG8_WAIT_L(0); PG8_MMA(1, 0, At, B0); PG8_BAR; PG8_SCHED;
            PG8_STAGE(PG8_SB(1, 1), b3 + hstep, voffB);
            PG8_WAIT_V(6); PG8_BAR; PG8_MMA(1, 1, At, B1); PG8_BAR;
        }
        E(acc, cur, wr, wc, fr, fq);
        if (!has_next) break;
#pragma unroll
        for (int a = 0; a < 2; ++a)
#pragma unroll
            for (int b = 0; b < 2; ++b)
#pragma unroll
                for (int m = 0; m < 4; ++m)
#pragma unroll
                    for (int n = 0; n < 2; ++n) acc[a][b][m][n] = (f32x4){0.f, 0.f, 0.f, 0.f};
        cur = nxt; cA = nA; cB = nB; ++ui;
    }
    PG8_WAIT_V(0);
    if (wr == 0) PG8_BAR;
    PG8_BAR;
#undef PG8_SA
#undef PG8_SB
#undef PG8_STAGE
#undef PG8_LDA
#undef PG8_LDB
#undef PG8_MMA
#undef PG8_WAIT_V
#undef PG8_WAIT_L
#undef PG8_BAR
#undef PG8_SCHED
}
}
using pg8::Unit;

struct EpiUZ {
    static constexpr bool PERM = true;
    bf16_t* P;
    __device__ __forceinline__ void operator()(const f32x4 (&acc)[2][2][4][2], const Unit& u, int wr, int wc, int fr_, int fq_) const {
        int fr = fr_, fq = fq_; asm volatile("" : "+v"(fr), "+v"(fq));
        const int row0 = u.pm * 256 + wr * 64 + fr;
        const int col = u.pn * 128 + wc * 32 + 8 * fq;
#pragma unroll
        for (int ai = 0; ai < 2; ++ai)
#pragma unroll
            for (int m = 0; m < 4; ++m) {
                const size_t row = (size_t)(row0 + ai * 128 + m * 16);
                float r[8];
#pragma unroll
                for (int n = 0; n < 2; ++n)
#pragma unroll
                    for (int i = 0; i < 4; ++i) {
                        const float uu = acc[ai][0][m][n][i], zz = acc[ai][1][m][n][i];
                        const float eu = __builtin_amdgcn_exp2f(-2.302208198f * (uu * (1.0f + 0.044715f * uu * uu)));
                        const float ez = __builtin_amdgcn_exp2f(-1.4426950408889634f * zz);
                        r[4 * n + i] = (uu * zz) * __builtin_amdgcn_rcpf((1.0f + eu) * (1.0f + ez));
                    }
                *(u32x4*)(P + row * GMW + col) = pack8f(r);
            }
    }
};
struct EpiGVT {
    static constexpr bool PERM = true;
    bf16_t* GVT; float* stats;
    __device__ __forceinline__ void operator()(const f32x4 (&acc)[2][2][4][2], const Unit& u, int wr, int wc, int fr_, int fq_) const {
        int fr = fr_, fq = fq_; asm volatile("" : "+v"(fr), "+v"(fq));
        const int row0 = u.pm * 256 + wr * 64 + fr;
        const int tok0 = u.pn * 256 + wc * 32 + 8 * fq;
        float s[16], ss[16];
#pragma unroll
        for (int j = 0; j < 16; ++j) { s[j] = 0.f; ss[j] = 0.f; }
#pragma unroll
        for (int ai = 0; ai < 2; ++ai)
#pragma unroll
            for (int m = 0; m < 4; ++m) {
                const size_t row = (size_t)(row0 + ai * 128 + m * 16);
#pragma unroll
                for (int bj = 0; bj < 2; ++bj) {
                    float r[8];
#pragma unroll
                    for (int n = 0; n < 2; ++n)
#pragma unroll
                        for (int i = 0; i < 4; ++i) r[4 * n + i] = gelu_f(acc[ai][bj][m][n][i]);
                    const u32x4 o = pack8f(r);
#pragma unroll
                    for (int q = 0; q < 4; ++q) { const float a = bflo(o[q]), b = bfhi(o[q]); s[bj * 8 + 2 * q] += a; ss[bj * 8 + 2 * q] += a * a; s[bj * 8 + 2 * q + 1] += b; ss[bj * 8 + 2 * q + 1] += b * b; }
                    *(u32x4*)(GVT + row * T + tok0 + bj * 128) = o;
                }
            }
#pragma unroll
        for (int step = 0; step < 4; ++step) {
            const int msk = 8 >> step, cnt = 8 >> step;
            const bool up = (fr & msk) != 0;
#pragma unroll
            for (int j = 0; j < 8; ++j) {
                if (j < cnt) {
                    const float send_s = up ? s[j] : s[j + cnt], keep_s = up ? s[j + cnt] : s[j];
                    const float send_q = up ? ss[j] : ss[j + cnt], keep_q = up ? ss[j + cnt] : ss[j];
                    s[j] = keep_s + __shfl_xor(send_s, msk);
                    ss[j] = keep_q + __shfl_xor(send_q, msk);
                }
            }
        }
        {
            const int j = fr;
            const size_t tok = (size_t)(tok0 + 128 * (j >> 3) + (j & 7));
            f32x2 st = {s[0], ss[0]};
            *(f32x2*)(stats + (tok * 32 + u.pm * 2 + wr) * 2) = st;
        }
    }
};
struct EpiRes {
    static constexpr bool PERM = false;
    const float* xin; float* xout; const float* gate;
    int ldg;
    __device__ __forceinline__ void operator()(const f32x4 (&acc)[2][2][4][2], const Unit& u, int wr, int wc, int fr_, int fq_) const {
        int fr = fr_, fq = fq_; asm volatile("" : "+v"(fr), "+v"(fq));
        const int row0 = u.pm * 256 + wr * 64 + fr, col0 = u.pn * 256 + wc * 32 + 4 * fq;
        const float* gp = gate + (size_t)(u.pm >> 5) * ldg + col0;
        f32x4 gv[2][2];
#pragma unroll
        for (int bj = 0; bj < 2; ++bj)
#pragma unroll
            for (int n = 0; n < 2; ++n) gv[bj][n] = *(const f32x4*)(gp + bj * 128 + n * 16);
#pragma unroll
        for (int ai = 0; ai < 2; ++ai)
#pragma unroll
            for (int m = 0; m < 4; ++m) {
                const size_t off = (size_t)(row0 + ai * 128 + m * 16) * DM + col0;
#pragma unroll
                for (int bj = 0; bj < 2; ++bj)
#pragma unroll
                    for (int n = 0; n < 2; ++n) {
                        const f32x4 xo = *(const f32x4*)(xin + off + bj * 128 + n * 16);
                        *(f32x4*)(xout + off + bj * 128 + n * 16) = xo + gv[bj][n] * acc[ai][bj][m][n];
                    }
            }
    }
};
template <int MODE> struct EpiLat {
    static constexpr bool PERM = true;
    bf16_t* C; float* ssq; float* kr; bf16_t* Z;
    __device__ __forceinline__ void operator()(const f32x4 (&acc)[2][2][4][2], const Unit& u, int wr, int wc, int fr_, int fq_) const {
        int fr = fr_, fq = fq_; asm volatile("" : "+v"(fr), "+v"(fq));
        const int row0 = u.pm * 256 + wr * 64 + fr;
        if (u.pn < 2) {
#pragma unroll
            for (int ai = 0; ai < 2; ++ai)
#pragma unroll
                for (int m = 0; m < 4; ++m) {
                    const size_t row = (size_t)(row0 + ai * 128 + m * 16);
                    float ss = 0.f;
#pragma unroll
                    for (int bj = 0; bj < 2; ++bj) {
                        const int col = u.pn * 256 + bj * 128 + wc * 32 + 8 * fq;
                        float r[8];
#pragma unroll
                        for (int n = 0; n < 2; ++n)
#pragma unroll
                            for (int i = 0; i < 4; ++i) { r[4 * n + i] = acc[ai][bj][m][n][i]; ss += r[4 * n + i] * r[4 * n + i]; }
                        *(u32x4*)(C + row * 512 + col) = pack8f(r);
                    }
                    ss += __shfl_xor(ss, 16); ss += __shfl_xor(ss, 32);
                    if (fq == 0) ssq[row * 8 + u.pn * 4 + wc] = ss;
                }
        } else if (MODE == 0) {
            if (u.pn == 2 && wc < 2) {
#pragma unroll
                for (int ai = 0; ai < 2; ++ai)
#pragma unroll
                    for (int m = 0; m < 4; ++m) {
                        const size_t row = (size_t)(row0 + ai * 128 + m * 16);
                        *(f32x4*)(kr + row * 64 + wc * 32 + 8 * fq) = acc[ai][0][m][0];
                        *(f32x4*)(kr + row * 64 + wc * 32 + 8 * fq + 4) = acc[ai][0][m][1];
                    }
            }
        } else {
#pragma unroll
            for (int ai = 0; ai < 2; ++ai)
#pragma unroll
                for (int m = 0; m < 4; ++m) {
                    const size_t row = (size_t)(row0 + ai * 128 + m * 16);
#pragma unroll
                    for (int bj = 0; bj < 2; ++bj) {
                        const int col = (u.pn - 2) * 256 + bj * 128 + wc * 32 + 8 * fq;
                        float r[8];
#pragma unroll
                        for (int n = 0; n < 2; ++n)
#pragma unroll
                            for (int i = 0; i < 4; ++i) r[4 * n + i] = silu_f(acc[ai][bj][m][n][i]);
                        *(u32x4*)(Z + row * 2048 + col) = pack8f(r);
                    }
                }
        }
    }
};
struct EpiScaled {
    static constexpr bool PERM = true;
    bf16_t* O; int ldc; const float* ssq;
    __device__ __forceinline__ void operator()(const f32x4 (&acc)[2][2][4][2], const Unit& u, int wr, int wc, int fr_, int fq_) const {
        int fr = fr_, fq = fq_; asm volatile("" : "+v"(fr), "+v"(fq));
        const int row0 = u.pm * 256 + wr * 64 + fr;
#pragma unroll
        for (int ai = 0; ai < 2; ++ai)
#pragma unroll
            for (int m = 0; m < 4; ++m) {
                const size_t row = (size_t)(row0 + ai * 128 + m * 16);
                const f32x4 a = *(const f32x4*)(ssq + row * 8), b = *(const f32x4*)(ssq + row * 8 + 4);
                const float rs = rsqrtf((a[0] + a[1] + a[2] + a[3] + b[0] + b[1] + b[2] + b[3]) * (1.0f / 512.0f) + EPS);
#pragma unroll
                for (int bj = 0; bj < 2; ++bj) {
                    const int col = u.pn * 256 + bj * 128 + wc * 32 + 8 * fq;
                    float r[8];
#pragma unroll
                    for (int n = 0; n < 2; ++n)
#pragma unroll
                        for (int i = 0; i < 4; ++i) r[4 * n + i] = acc[ai][bj][m][n][i] * rs;
                    *(u32x4*)(O + row * ldc + col) = pack8f(r);
                }
            }
    }
};
struct EpiVT {
    static constexpr bool PERM = false;
    bf16_t* VT; const float* ssq;
    __device__ __forceinline__ void operator()(const f32x4 (&acc)[2][2][4][2], const Unit& u, int wr, int wc, int fr_, int fq_) const {
        int fr = fr_, fq = fq_; asm volatile("" : "+v"(fr), "+v"(fq));
        const int row0 = u.pm * 256 + wr * 64 + fr;
        const int pg = ((fq & 1) << 1) | (fq >> 1);
#pragma unroll
        for (int bj = 0; bj < 2; ++bj)
#pragma unroll
            for (int n = 0; n < 2; ++n) {
                const int tb = u.pn * 256 + bj * 128 + wc * 32 + 16 * n;
                const int tok0 = tb + 4 * fq;
                f32x4 rs;
#pragma unroll
                for (int i = 0; i < 4; ++i) {
                    const f32x4 a = *(const f32x4*)(ssq + (size_t)(tok0 + i) * 8), b = *(const f32x4*)(ssq + (size_t)(tok0 + i) * 8 + 4);
                    rs[i] = rsqrtf((a[0] + a[1] + a[2] + a[3] + b[0] + b[1] + b[2] + b[3]) * (1.0f / 512.0f) + EPS);
                }
                const int pos0 = tb + 4 * pg;
#pragma unroll
                for (int ai = 0; ai < 2; ++ai)
#pragma unroll
                    for (int m = 0; m < 4; ++m) {
                        const size_t row = (size_t)(row0 + ai * 128 + m * 16);
                        const f32x4 v = acc[ai][bj][m][n] * rs;
                        u32x2 o = {cvt_pk_bf16(v[0], v[1]), cvt_pk_bf16(v[2], v[3])};
                        *(u32x2*)(VT + row * T + pos0) = o;
                    }
            }
    }
};

template <class Epi> __device__ __forceinline__ void run_gemm(const int TID, const int BID, LAS unsigned char* lds, const bf16_t* A, const bf16_t* Bt, int M, int N, int K, const Epi& E) {
    pg8::Gemm g{A, Bt, M, N, K}; pg8::StaticOrder S; S.init(M, N, (int)gridDim.x, (int)BID);
    pg8::gemm_phase<Epi, pg8::StaticOrder>(TID, lds, g, S, E);
}

struct Params {
    const float* in[25];
    float* out;
    unsigned char* ws;
    int ph_lo, ph_hi;
};
enum { I_X = 0, I_C, I_ADA_W, I_ADA_B, I_NORM_G, I_A_W_IN, I_A_LN_G, I_A_LN_B, I_A_W_S, I_A_B_S, I_A_W_OUT, I_KV_ADA_W, I_KV_ADA_B, I_KV_NORM_G, I_KV_W_DKV, I_KV_G_KVA,
       I_KV_W_UKV, I_KV_G_KN, I_KV_G_KR, I_B_W_IN, I_B_G_QA, I_B_W_UQ, I_B_G_QN, I_B_G_QR, I_B_W_OUT };

__device__ __forceinline__ void conv_tile(const int TID, unsigned char* shm, const float* src, int ldsrc, int srccol0, int K, int k0, bf16_t* dst, int n0, const float* scale) {
    float* tile = (float*)shm;
    const int tid = TID;
    {
        const int kk = tid >> 4, c4 = tid & 15;
        f32x4 v[8];
#pragma unroll
        for (int i = 0; i < 8; ++i) {
            v[i] = (f32x4){0.f, 0.f, 0.f, 0.f};
            if (srccol0 >= 0) v[i] = *(const f32x4*)(src + (size_t)(k0 + kk + 32 * i) * ldsrc + srccol0 + 4 * c4);
        }
#pragma unroll
        for (int i = 0; i < 8; ++i) { float* tp = tile + (kk + 32 * i) * 65 + 4 * c4; tp[0] = v[i][0]; tp[1] = v[i][1]; tp[2] = v[i][2]; tp[3] = v[i][3]; }
    }
    __syncthreads();
    {
        const int n = tid >> 3, k8 = tid & 7;
#pragma unroll
        for (int jb = 0; jb < 4; ++jb) {
            float r[8];
#pragma unroll
            for (int j = 0; j < 8; ++j) { r[j] = tile[(64 * jb + 8 * k8 + j) * 65 + n]; if (scale) r[j] *= scale[k0 + 64 * jb + 8 * k8 + j]; }
            *(u32x4*)(dst + (size_t)(n0 + n) * K + k0 + 64 * jb + 8 * k8) = pack8f(r);
        }
    }
    __syncthreads();
}

__device__ __forceinline__ void phase_prep(const int TID, const int BID, const Params& p, unsigned char* ws, unsigned char* shm) {
    const int tid = TID;
    {
        float* cosT = (float*)(ws + WS_COS); float* sinT = (float*)(ws + WS_SIN);
        for (int idx = BID * 512 + tid; idx < SEQ * 32; idx += gridDim.x * 512) {
            const int pos = idx >> 5, i = idx & 31;
            double f = 1.0; for (int q = 0; q < i; ++q) f *= 0.7498942093324559;
            const float invf = (float)f;
            const float ang = (float)pos * invf;
            const double ad = (double)ang;
            const double n = rint(ad * 0.15915494309189535);
            const double r = ad - n * 6.283185307179586;
            const double r2 = r * r;
            double s = 1.0, c = 1.0;
#pragma unroll 1
            for (int k = 14; k >= 1; --k) { s = 1.0 - s * r2 / (double)((2 * k) * (2 * k + 1)); c = 1.0 - c * r2 / (double)((2 * k - 1) * (2 * k)); }
            cosT[idx] = (float)c; sinT[idx] = (float)(r * s);
        }
    }
    if (BID < 224) {
        float* sc = (float*)shm;
        float* red = (float*)(shm + 32768);
        const float* cin = p.in[I_C];
        for (int i = tid; i < 4 * 2048; i += 512) sc[i] = silu_f(cin[i]);
        __syncthreads();
        const int item = BID;
        const float* W; const float* bias; float* out; int ldw, cb;
        if (item < 192) { const int l = item / 48; cb = item % 48; W = p.in[I_ADA_W] + (size_t)l * 2048 * 6144; ldw = 6144; bias = p.in[I_ADA_B] + l * 6144; out = (float*)(ws + WS_MOD) + (size_t)l * 4 * 6144; }
        else { cb = item - 192; W = p.in[I_KV_ADA_W]; ldw = 4096; bias = p.in[I_KV_ADA_B]; out = (float*)(ws + WS_KVMOD); }
        const int cgp = tid & 31, kg = tid >> 5;
        const float* wp = W + (size_t)(kg * 128) * ldw + cb * 128 + cgp * 4;
        f32x4 a0 = {0.f, 0.f, 0.f, 0.f}, a1 = a0, a2 = a0, a3 = a0;
#pragma unroll 8
        for (int k = 0; k < 128; ++k) {
            const f32x4 w = *(const f32x4*)(wp + (size_t)k * ldw);
            const int kk = kg * 128 + k;
            a0 += w * sc[kk]; a1 += w * sc[2048 + kk]; a2 += w * sc[4096 + kk]; a3 += w * sc[6144 + kk];
        }
        float* rp = red + ((size_t)kg * 128 + cgp * 4) * 4;
#pragma unroll
        for (int e = 0; e < 4; ++e) { rp[e * 4 + 0] = a0[e]; rp[e * 4 + 1] = a1[e]; rp[e * 4 + 2] = a2[e]; rp[e * 4 + 3] = a3[e]; }
        __syncthreads();
        {
            const int col = tid >> 2, b = tid & 3;
            float s = 0.f;
#pragma unroll
            for (int g = 0; g < 16; ++g) s += red[((size_t)g * 128 + col) * 4 + b];
            out[(size_t)b * ldw + cb * 128 + col] = s + bias[cb * 128 + col];
        }
        __syncthreads();
    }
    {
        const float* wsrc = p.in[I_A_W_S]; bf16_t* wdst = (bf16_t*)(ws + WS_WS16);
        for (int idx = BID * 512 + TID; idx < 2 * 16 * 128 * 128 / 4; idx += gridDim.x * 512) {
            const int e = idx * 4, s4 = e & 127, t = (e >> 7) & 127;
            f32x4 w = *(const f32x4*)(wsrc + e);
#pragma unroll
            for (int q = 0; q < 4; ++q) if (s4 + q > t) w[q] = 0.f;
            u32x2 o = {cvt_pk_bf16(w[0], w[1]), cvt_pk_bf16(w[2], w[3])};
            *(u32x2*)(wdst + e) = o;
        }
    }
    {
        constexpr int NJ = 13;
        const int ntile[NJ] = {1536, 1536, 512, 512, 96, 64, 64, 320, 320, 96, 96, 256, 256};
        int total = 0;
#pragma unroll
        for (int j = 0; j < NJ; ++j) total += ntile[j];
        for (int tix = BID; tix < total; tix += gridDim.x) {
            int j = 0, rem = tix;
#pragma unroll
            for (int q = 0; q < NJ; ++q) { if (j == q && rem >= ntile[q]) { rem -= ntile[q]; j = q + 1; } }
            const float* src; int ldsrc, K; bf16_t* dst; const float* scale = nullptr; int srccol0, n0, k0;
            if (j < 2) {
                K = 2048; ldsrc = 12288; src = p.in[I_A_W_IN] + (size_t)j * 2048 * 12288; dst = (bf16_t*)(ws + WS_WINA) + (size_t)j * 12288 * 2048;
                const int nt_ = rem / 8; k0 = (rem % 8) * 256; n0 = nt_ * 64;
                const int pn = n0 >> 8, jj = n0 & 255;
                srccol0 = pn < 32 ? (jj < 128 ? 128 * pn + jj : 8192 + 128 * pn + (jj - 128)) : 4096 + 256 * (pn - 32) + jj;
            } else if (j < 4) {
                const int l = j - 2; K = 4096; ldsrc = 2048; src = p.in[I_A_W_OUT] + (size_t)l * 4096 * 2048; dst = (bf16_t*)(ws + WS_WOUTA) + (size_t)l * 2048 * 4096;
                const int nt_ = rem / 16; k0 = (rem % 16) * 256; n0 = nt_ * 64; srccol0 = n0;
            } else if (j == 4) {
                K = 2048; ldsrc = 576; src = p.in[I_KV_W_DKV]; dst = (bf16_t*)(ws + WS_WDKV);
                const int nt_ = rem / 8; k0 = (rem % 8) * 256; n0 = nt_ * 64; srccol0 = n0 < 576 ? n0 : -1;
            } else if (j < 7) {
                K = 512; ldsrc = 4096; src = p.in[I_KV_W_UKV]; dst = (bf16_t*)(ws + (j == 5 ? WS_WKN : WS_WV)); scale = p.in[I_KV_G_KVA];
                const int nt_ = rem / 2; k0 = (rem % 2) * 256; n0 = nt_ * 64;
                srccol0 = (n0 >> 7) * 256 + (j == 6 ? 128 : 0) + (n0 & 127);
            } else if (j < 9) {
                const int l = j - 7; K = 2048; ldsrc = 2560; src = p.in[I_B_W_IN] + (size_t)l * 2048 * 2560; dst = (bf16_t*)(ws + WS_WINB) + (size_t)l * 2560 * 2048;
                const int nt_ = rem / 8; k0 = (rem % 8) * 256; n0 = nt_ * 64; srccol0 = n0;
            } else if (j < 11) {
                const int l = j - 9; K = 512; ldsrc = 3072; src = p.in[I_B_W_UQ] + (size_t)l * 512 * 3072; dst = (bf16_t*)(ws + WS_WUQ) + (size_t)l * 3072 * 512; scale = p.in[I_B_G_QA] + l * 512;
                const int nt_ = rem / 2; k0 = (rem % 2) * 256; n0 = nt_ * 64; srccol0 = n0;
            } else {
                const int l = j - 11; K = 2048; ldsrc = 2048; src = p.in[I_B_W_OUT] + (size_t)l * 2048 * 2048; dst = (bf16_t*)(ws + WS_WOUTB) + (size_t)l * 2048 * 2048;
                const int nt_ = rem / 8; k0 = (rem % 8) * 256; n0 = nt_ * 64; srccol0 = n0;
            }
            conv_tile(TID, shm, src, ldsrc, srccol0, K, k0, dst, n0, scale);
        }
    }
}

__device__ __forceinline__ void phase_norm(const int TID, const int BID, const float* x, const float* g1, const float* sh1, const float* sc1, int ld1, bf16_t* h1,
                           const float* g2, const float* sh2, const float* sc2, int ld2, bf16_t* h2) {
    const int lane = TID & 63, wid = TID >> 6;
    for (int row = BID * 8 + wid; row < T; row += gridDim.x * 8) {
        const int b = row >> 13;
        const f32x4* xr = (const f32x4*)(x + (size_t)row * DM);
        f32x4 v[8]; float ss = 0.f;
#pragma unroll
        for (int i = 0; i < 8; ++i) { v[i] = xr[lane + 64 * i]; ss += v[i][0] * v[i][0] + v[i][1] * v[i][1] + v[i][2] * v[i][2] + v[i][3] * v[i][3]; }
#pragma unroll
        for (int o = 32; o >= 1; o >>= 1) ss += __shfl_xor(ss, o);
        const float rs = rsqrtf(ss * (1.0f / 2048.0f) + EPS);
#pragma unroll
        for (int i = 0; i < 8; ++i) {
            const int k = 4 * (lane + 64 * i);
            const f32x4 gg = *(const f32x4*)(g1 + k), sc = *(const f32x4*)(sc1 + (size_t)b * ld1 + k), sh = *(const f32x4*)(sh1 + (size_t)b * ld1 + k);
            const f32x4 o = (v[i] * rs) * gg * (sc + 1.0f) + sh;
            u32x2 w = {cvt_pk_bf16(o[0], o[1]), cvt_pk_bf16(o[2], o[3])};
            *(u32x2*)(h1 + (size_t)row * DM + k) = w;
        }
        if (h2) {
#pragma unroll
            for (int i = 0; i < 8; ++i) {
                const int k = 4 * (lane + 64 * i);
                const f32x4 gg = *(const f32x4*)(g2 + k), sc = *(const f32x4*)(sc2 + (size_t)b * ld2 + k), sh = *(const f32x4*)(sh2 + (size_t)b * ld2 + k);
                const f32x4 o = (v[i] * rs) * gg * (sc + 1.0f) + sh;
                u32x2 w = {cvt_pk_bf16(o[0], o[1]), cvt_pk_bf16(o[2], o[3])};
                *(u32x2*)(h2 + (size_t)row * DM + k) = w;
            }
        }
    }
}

__device__ __forceinline__ void phase_mix(const int TID, const int BID, unsigned char* shm, bf16_t* P, const bf16_t* GVT, const float* stats, const bf16_t* ws16, const float* b_s, const float* ln_g, const float* ln_b) {
    constexpr int LD = 136;
    bf16_t* VTl = (bf16_t*)shm;
    bf16_t* WsL = (bf16_t*)(shm + 256 * LD * 2);
    float* st = (float*)(shm + 256 * LD * 2 + 128 * LD * 2);
    const int tid = TID, lane = tid & 63, wid = tid >> 6, l15 = lane & 15, l4 = lane >> 4;
    for (int chunk = BID; chunk < T / 128; chunk += gridDim.x) {
        const int t0 = chunk * 128;
        __syncthreads();
        if (tid < 128) {
            const f32x4* sp = (const f32x4*)(stats + (size_t)(t0 + tid) * 64);
            float s = 0.f, ss = 0.f;
#pragma unroll
            for (int i = 0; i < 16; ++i) { const f32x4 v = sp[i]; s += v[0] + v[2]; ss += v[1] + v[3]; }
            const float mean = s * (1.0f / 4096.0f);
            const float var = ss * (1.0f / 4096.0f) - mean * mean;
            st[2 * tid] = mean; st[2 * tid + 1] = rsqrtf(fmaxf(var, 0.f) + EPS);
        }
        __syncthreads();
        for (int g = 0; g < 16; ++g) {
#pragma unroll
            for (int i = 0; i < 4; ++i) {
                const int id = tid + 512 * i, t = id >> 4, s8 = (id & 15) * 8;
                *(u32x4*)(WsL + t * LD + s8) = *(const u32x4*)(ws16 + ((size_t)g * 128 + t) * 128 + s8);
            }
#pragma unroll
            for (int i = 0; i < 8; ++i) {
                const int id = tid + 512 * i, c = id >> 4, s8 = (id & 15) * 8;
                const u32x4 raw = *(const u32x4*)(GVT + (size_t)(g * 256 + c) * T + t0 + s8);
                const float gg = ln_g[g * 256 + c], bb = ln_b[g * 256 + c];
                float r[8];
#pragma unroll
                for (int q = 0; q < 4; ++q) { r[2 * q] = bflo(raw[q]); r[2 * q + 1] = bfhi(raw[q]); }
#pragma unroll
                for (int q = 0; q < 4; ++q) {
                    const f32x4 mr = *(const f32x4*)(st + 2 * (s8 + 2 * q));
                    r[2 * q] = (r[2 * q] - mr[0]) * mr[1] * gg + bb;
                    r[2 * q + 1] = (r[2 * q + 1] - mr[2]) * mr[3] * gg + bb;
                }
                *(u32x4*)(VTl + c * LD + s8) = pack8f(r);
            }
            __syncthreads();
            f32x4 acc[2][8];
#pragma unroll
            for (int cb = 0; cb < 2; ++cb)
#pragma unroll
                for (int tb = 0; tb < 8; ++tb) acc[cb][tb] = (f32x4){0.f, 0.f, 0.f, 0.f};
#pragma unroll
            for (int ks = 0; ks < 4; ++ks) {
                bf16x8 vf[2];
#pragma unroll
                for (int cb = 0; cb < 2; ++cb) vf[cb] = *(const bf16x8*)(VTl + (wid * 32 + cb * 16 + l15) * LD + ks * 32 + l4 * 8);
#pragma unroll
                for (int tb = 0; tb < 8; ++tb) {
                    if (tb >= 2 * ks) {
                        const bf16x8 wf = *(const bf16x8*)(WsL + (tb * 16 + l15) * LD + ks * 32 + l4 * 8);
#pragma unroll
                        for (int cb = 0; cb < 2; ++cb) acc[cb][tb] = __builtin_amdgcn_mfma_f32_16x16x32_bf16(vf[cb], wf, acc[cb][tb], 0, 0, 0);
                    }
                }
            }
#pragma unroll
            for (int tb = 0; tb < 8; ++tb) {
                const int t = tb * 16 + l15;
                const float bs = b_s[g * 128 + t];
#pragma unroll
                for (int cb = 0; cb < 2; ++cb) {
                    bf16_t* pp = P + (size_t)(t0 + t) * GMW + g * 256 + wid * 32 + cb * 16 + l4 * 4;
                    const u32x2 pv = *(const u32x2*)pp;
                    const f32x4 a = acc[cb][tb];
                    u32x2 o = {cvt_pk_bf16(bflo(pv[0]) * (a[0] + bs), bfhi(pv[0]) * (a[1] + bs)), cvt_pk_bf16(bflo(pv[1]) * (a[2] + bs), bfhi(pv[1]) * (a[3] + bs))};
                    *(u32x2*)pp = o;
                }
            }
            __syncthreads();
        }
    }
}

__device__ __forceinline__ void phase_kpost(const int TID, const int BID, bf16_t* KN, const float* KRAW, bf16_t* KROPE, const float* g_kn, const float* g_kr, const float* cosT, const float* sinT) {
    const int lane = TID & 63, wid = TID >> 6;
    const int gw = BID * 8 + wid, nw = gridDim.x * 8;
    {
        const int sub = lane >> 4, l16 = lane & 15;
        const f32x4 ga = *(const f32x4*)(g_kn + l16 * 8), gb = *(const f32x4*)(g_kn + l16 * 8 + 4);
        const size_t nrows = (size_t)T * 16;
        for (size_t r = (size_t)gw * 4 + sub; r < nrows; r += (size_t)nw * 4) {
            u32x4* pp = (u32x4*)(KN + r * 128 + l16 * 8);
            const u32x4 raw = *pp;
            float v[8]; float ss = 0.f;
#pragma unroll
            for (int q = 0; q < 4; ++q) { v[2 * q] = bflo(raw[q]); v[2 * q + 1] = bfhi(raw[q]); ss += v[2 * q] * v[2 * q] + v[2 * q + 1] * v[2 * q + 1]; }
            ss += __shfl_xor(ss, 1); ss += __shfl_xor(ss, 2); ss += __shfl_xor(ss, 4); ss += __shfl_xor(ss, 8);
            const float rs = rsqrtf(ss * (1.0f / 128.0f) + EPS);
#pragma unroll
            for (int e = 0; e < 8; ++e) v[e] = v[e] * rs * (e < 4 ? ga[e & 3] : gb[e & 3]);
            *pp = pack8f(v);
        }
    }
    {
        const float gk = g_kr[lane];
        for (int t = gw; t < T; t += nw) {
            const float x = KRAW[(size_t)t * 64 + lane];
            float ss = x * x;
#pragma unroll
            for (int o = 32; o >= 1; o >>= 1) ss += __shfl_xor(ss, o);
            const float y = x * rsqrtf(ss * (1.0f / 64.0f) + EPS) * gk;
            const float other = __shfl_xor(y, 32);
            const int pos = t & (SEQ - 1), i = lane & 31;
            const float c = cosT[pos * 32 + i], s = sinT[pos * 32 + i];
            const float o = lane < 32 ? (y * c - other * s) : (y * c + other * s);
            KROPE[(size_t)t * 64 + lane] = (bf16_t)(cvt_pk_bf16(o, 0.f) & 0xffffu);
        }
    }
}

__device__ __forceinline__ void phase_attn(const int TID, const int BID, unsigned char* shm, const bf16_t* Q, const bf16_t* KN, const bf16_t* KR, const bf16_t* VT, const bf16_t* Zs, bf16_t* Y,
                                           const float* g_qn, const float* g_qr, const float* cosT, const float* sinT) {
    constexpr int KROWB = 400, VROWB = 144, KBYTES = 64 * KROWB, BUFB = KBYTES + 128 * VROWB;
    const int tid = TID, wid = __builtin_amdgcn_readfirstlane(tid >> 6), lane = tid & 63, lq = lane & 31, hi = lane >> 5;
    const int kn_r = tid >> 4, kn_c = tid & 15;
    const int kr_r = tid >> 3, kr_c = tid & 7;
    const int v_r = tid >> 3, v_c = tid & 7;
    const unsigned koff = kn_r * 2048 + kn_c * 8, roff = kr_r * 64 + kr_c * 8, voff = (unsigned)v_r * T + v_c * 8;
    const int kfrag = lq * KROWB + hi * 16;
    const int vfrag = KBYTES + lq * VROWB + hi * 16;
    for (int item = BID; item < 1024; item += gridDim.x) {
        const int bh = item >> 4, pr = item & 15, b = bh >> 4, h = bh & 15;
        const int tokb = b * SEQ;
        for (int half = 0; half < 2; ++half) {
            const int qb = half == 0 ? (31 - pr) : pr;
            const int q0 = qb * 256, nt = 4 * (qb + 1);
            int lqo = lq, hio = hi; asm volatile("" : "+v"(lqo), "+v"(hio));
            const int qrow = q0 + wid * 32 + lq;
            const int qrow_o = q0 + wid * 32 + lqo;
            bf16x8 qf[12];
            {
                const bf16_t* qp = Q + (size_t)(tokb + qrow_o) * 3072 + h * 192 + hio * 8;
#pragma unroll
                for (int ks = 0; ks < 12; ++ks) qf[ks] = *(const bf16x8*)(qp + ks * 16);
                float ssn = 0.f, ssr = 0.f;
#pragma unroll
                for (int ks = 0; ks < 12; ++ks)
#pragma unroll
                    for (int j = 0; j < 8; ++j) { const float v = bf2f((unsigned short)qf[ks][j]); if (ks < 8) ssn += v * v; else ssr += v * v; }
                ssn = x32_sum(ssn); ssr = x32_sum(ssr);
                const float rn = rsqrtf(ssn * (1.0f / 128.0f) + EPS) * QSCALE;
                const float rr = rsqrtf(ssr * (1.0f / 64.0f) + EPS);
#pragma unroll
                for (int ks = 0; ks < 8; ++ks) {
                    const f32x4 ga = *(const f32x4*)(g_qn + ks * 16 + hio * 8), gb = *(const f32x4*)(g_qn + ks * 16 + hio * 8 + 4);
                    float r[8];
#pragma unroll
                    for (int j = 0; j < 8; ++j) r[j] = bf2f((unsigned short)qf[ks][j]) * rn * (j < 4 ? ga[j & 3] : gb[j & 3]);
                    const u32x4 o = pack8f(r);
                    qf[ks] = *(const bf16x8*)&o;
                }
#pragma unroll
                for (int kk = 0; kk < 2; ++kk) {
                    const int i0 = 16 * kk + 8 * hio;
                    float r1[8], r2[8];
#pragma unroll
                    for (int j = 0; j < 8; ++j) {
                        const float x1 = bf2f((unsigned short)qf[8 + kk][j]) * rr * g_qr[i0 + j];
                        const float x2 = bf2f((unsigned short)qf[10 + kk][j]) * rr * g_qr[32 + i0 + j];
                        const float c = cosT[qrow_o * 32 + i0 + j], s = sinT[qrow_o * 32 + i0 + j];
                        r1[j] = (x1 * c - x2 * s) * QSCALE; r2[j] = (x2 * c + x1 * s) * QSCALE;
                    }
                    const u32x4 o1 = pack8f(r1), o2 = pack8f(r2);
                    qf[8 + kk] = *(const bf16x8*)&o1; qf[10 + kk] = *(const bf16x8*)&o2;
                }
            }
            f32x16 O[4];
#pragma unroll
            for (int d = 0; d < 4; ++d)
#pragma unroll
                for (int r = 0; r < 16; ++r) O[d][r] = 0.f;
            float m_run = 0.f, l_run = 0.f; bool mz = true;
            u32x4 st0, st1, st2, st3, st4;
#define ATT_ISSUE_K(t_) do { const size_t tok0 = (size_t)tokb + (size_t)(t_) * 64; \
                const bf16_t* knb = uniform_ptr(KN + tok0 * 2048 + h * 128); const bf16_t* krb = uniform_ptr(KR + tok0 * 64); \
                st0 = *(const u32x4*)(knb + koff); \
                st1 = *(const u32x4*)(knb + koff + 32 * 2048); \
                st2 = *(const u32x4*)(krb + roff); } while (0)
#define ATT_ISSUE_V(t_) do { const size_t tok0 = (size_t)tokb + (size_t)(t_) * 64; \
                const bf16_t* vtb = uniform_ptr(VT + (size_t)(h * 128) * T + tok0); \
                st3 = *(const u32x4*)(vtb + voff); \
                st4 = *(const u32x4*)(vtb + voff + 64 * T); } while (0)
#define ATT_WRITE(buf_) do { unsigned char* bp = shm + (buf_) * BUFB; \
                *(u32x4*)(bp + kn_r * KROWB + kn_c * 16) = st0; \
                *(u32x4*)(bp + (kn_r + 32) * KROWB + kn_c * 16) = st1; \
                *(u32x4*)(bp + kr_r * KROWB + 256 + kr_c * 16) = st2; \
                *(u32x4*)(bp + KBYTES + v_r * VROWB + v_c * 16) = st3; \
                *(u32x4*)(bp + KBYTES + (v_r + 64) * VROWB + v_c * 16) = st4; } while (0)
            __syncthreads();
            ATT_ISSUE_K(0); ATT_ISSUE_V(0);
            ATT_WRITE(0);
            __syncthreads();
            for (int t = 0; t < nt; ++t) {
                const bool has_next = (t + 1 < nt);
                if (has_next) ATT_ISSUE_K(t + 1);
                const int rel = t - (nt - 4);
                const bool active = rel <= (wid >> 1);
                const unsigned char* bp = shm + (t & 1) * BUFB;
                bf16x8 pf[4];
                if (active) {
                    f32x16 S0, S1;
#pragma unroll
                    for (int r = 0; r < 16; ++r) { S0[r] = 0.f; S1[r] = 0.f; }
#define SB_() __builtin_amdgcn_sched_barrier(0)
#define LDK_(dst, ks) do { dst[0] = *(const bf16x8*)(bp + kfrag + (ks) * 32); dst[1] = *(const bf16x8*)(bp + kfrag + 12800 + (ks) * 32); \
                        dst[2] = *(const bf16x8*)(bp + kfrag + ((ks) + 1) * 32); dst[3] = *(const bf16x8*)(bp + kfrag + 12800 + ((ks) + 1) * 32); } while (0)
#define MMK_(s_, ks) do { S0 = __builtin_amdgcn_mfma_f32_32x32x16_bf16(s_[0], qf[ks], S0, 0, 0, 0); S1 = __builtin_amdgcn_mfma_f32_32x32x16_bf16(s_[1], qf[ks], S1, 0, 0, 0); \
                        S0 = __builtin_amdgcn_mfma_f32_32x32x16_bf16(s_[2], qf[(ks) + 1], S0, 0, 0, 0); S1 = __builtin_amdgcn_mfma_f32_32x32x16_bf16(s_[3], qf[(ks) + 1], S1, 0, 0, 0); } while (0)
                    {
                        bf16x8 fa[4], fb[4];
                        LDK_(fa, 0); SB_();
                        LDK_(fb, 2); MMK_(fa, 0); SB_();
                        LDK_(fa, 4); MMK_(fb, 2); SB_();
                        LDK_(fb, 6); MMK_(fa, 4); SB_();
                        LDK_(fa, 8); MMK_(fb, 6); SB_();
                        LDK_(fb, 10); MMK_(fa, 8); SB_();
                        MMK_(fb, 10); SB_();
                    }
                    if (rel >= 0) {
                        const int dq = qrow - t * 64 - 4 * hi;
#pragma unroll
                        for (int r = 0; r < 16; ++r) {
                            const int c = (r & 3) + 8 * (r >> 2);
                            if (c > dq) S0[r] = -__builtin_inff();
                            if (c + 32 > dq) S1[r] = -__builtin_inff();
                        }
                    }
                    float mx = fmaxf(S0[0], S1[0]);
#pragma unroll
                    for (int r = 1; r < 16; ++r) mx = fmaxf(mx, fmaxf(S0[r], S1[r]));
                    mx = x32_max(mx);
                    const bool viol = (mx > 12.0f) || (t == 0 && mx < -64.0f);
                    const bool fast = mz && (__builtin_amdgcn_ballot_w64(viol) == 0ull);
                    if (!fast) {
                        mz = false;
                        const float mn = (t == 0) ? mx : fmaxf(m_run, mx);
                        const float alpha = (t == 0) ? 1.0f : __builtin_amdgcn_exp2f(m_run - mn);
                        m_run = mn;
                        l_run *= alpha;
#pragma unroll
                        for (int r = 0; r < 16; ++r) { S0[r] -= mn; S1[r] -= mn; }
#pragma unroll
                        for (int d = 0; d < 4; ++d)
#pragma unroll
                            for (int r = 0; r < 16; ++r) O[d][r] *= alpha;
                    }
                    float ps = 0.f, ps2 = 0.f;
#pragma unroll
                    for (int r = 0; r < 16; ++r) { S0[r] = __builtin_amdgcn_exp2f(S0[r]); S1[r] = __builtin_amdgcn_exp2f(S1[r]); ps += S0[r]; ps2 += S1[r]; }
                    l_run += ps + ps2;
                    {
                        u32x4 a = {cvt_pk_bf16(S0[0], S0[1]), cvt_pk_bf16(S0[2], S0[3]), cvt_pk_bf16(S0[4], S0[5]), cvt_pk_bf16(S0[6], S0[7])};
                        u32x4 bq = {cvt_pk_bf16(S0[8], S0[9]), cvt_pk_bf16(S0[10], S0[11]), cvt_pk_bf16(S0[12], S0[13]), cvt_pk_bf16(S0[14], S0[15])};
                        u32x4 c = {cvt_pk_bf16(S1[0], S1[1]), cvt_pk_bf16(S1[2], S1[3]), cvt_pk_bf16(S1[4], S1[5]), cvt_pk_bf16(S1[6], S1[7])};
                        u32x4 d = {cvt_pk_bf16(S1[8], S1[9]), cvt_pk_bf16(S1[10], S1[11]), cvt_pk_bf16(S1[12], S1[13]), cvt_pk_bf16(S1[14], S1[15])};
                        pf[0] = *(const bf16x8*)&a; pf[1] = *(const bf16x8*)&bq; pf[2] = *(const bf16x8*)&c; pf[3] = *(const bf16x8*)&d;
                    }
                }
                if (has_next) ATT_ISSUE_V(t + 1);
                if (active) {
#define LDV_(dst, dp, kp) do { dst[0] = *(const bf16x8*)(bp + vfrag + (2 * (dp)) * 4608 + (2 * (kp)) * 32); dst[1] = *(const bf16x8*)(bp + vfrag + (2 * (dp) + 1) * 4608 + (2 * (kp)) * 32); \
                        dst[2] = *(const bf16x8*)(bp + vfrag + (2 * (dp)) * 4608 + (2 * (kp) + 1) * 32); dst[3] = *(const bf16x8*)(bp + vfrag + (2 * (dp) + 1) * 4608 + (2 * (kp) + 1) * 32); } while (0)
#define MMV_(s_, dp, kp) do { O[2 * (dp)] = __builtin_amdgcn_mfma_f32_32x32x16_bf16(s_[0], pf[2 * (kp)], O[2 * (dp)], 0, 0, 0); O[2 * (dp) + 1] = __builtin_amdgcn_mfma_f32_32x32x16_bf16(s_[1], pf[2 * (kp)], O[2 * (dp) + 1], 0, 0, 0); \
                        O[2 * (dp)] = __builtin_amdgcn_mfma_f32_32x32x16_bf16(s_[2], pf[2 * (kp) + 1], O[2 * (dp)], 0, 0, 0); O[2 * (dp) + 1] = __builtin_amdgcn_mfma_f32_32x32x16_bf16(s_[3], pf[2 * (kp) + 1], O[2 * (dp) + 1], 0, 0, 0); } while (0)
                    {
                        bf16x8 fa[4], fb[4];
                        SB_();
                        LDV_(fa, 0, 0); SB_();
                        LDV_(fb, 0, 1); MMV_(fa, 0, 0); SB_();
                        LDV_(fa, 1, 0); MMV_(fb, 0, 1); SB_();
                        LDV_(fb, 1, 1); MMV_(fa, 1, 0); SB_();
                        MMV_(fb, 1, 1); SB_();
                    }
                }
                if (has_next) ATT_WRITE((t + 1) & 1);
                __syncthreads();
            }
#undef SB_
#undef LDK_
#undef MMK_
#undef LDV_
#undef MMV_
#undef ATT_ISSUE_K
#undef ATT_ISSUE_V
#undef ATT_WRITE
            const float lt = x32_sum(l_run);
            const float inv = 1.0f / lt;
            int lqe = lq, hie = hi; asm volatile("" : "+v"(lqe), "+v"(hie));
            const size_t yoff = (size_t)(tokb + q0 + wid * 32 + lqe) * 2048 + h * 128 + 4 * hie;
            const bf16_t* zp = Zs + yoff; bf16_t* yp = Y + yoff;
#pragma unroll
            for (int db = 0; db < 4; ++db)
#pragma unroll
                for (int g4 = 0; g4 < 4; ++g4) {
                    bf16_t* pp = yp + db * 32 + g4 * 8;
                    const u32x2 zv = *(const u32x2*)(zp + db * 32 + g4 * 8);
                    u32x2 o = {cvt_pk_bf16(O[db][4 * g4 + 0] * inv * bflo(zv[0]), O[db][4 * g4 + 1] * inv * bfhi(zv[0])),
                               cvt_pk_bf16(O[db][4 * g4 + 2] * inv * bflo(zv[1]), O[db][4 * g4 + 3] * inv * bfhi(zv[1]))};
                    *(u32x2*)pp = o;
                }
        }
    }
}

enum { PH_PREP = 0, PH_NORM_A0, PH_AIN0, PH_MIX0, PH_AOUT0, PH_NORM_A1, PH_AIN1, PH_MIX1, PH_AOUT1, PH_NORM_KV, PH_DKV_BIN0, PH_UKV_UQ0, PH_KPOST, PH_ATTN0, PH_BOUT0,
       PH_NORM_B1, PH_BIN1, PH_UQ1, PH_ATTN1, PH_BOUT1, NPH };
#if REP_GEMM == 2
#define RG_(x) x, x,
#else
#define RG_(x) x,
#endif
#if REP_AIN == 2
#define RI_(x) x, x,
#else
#define RI_(x) x,
#endif
#if REP_ATTN == 2
#define RA_(x) x, x,
#else
#define RA_(x) x,
#endif
#if REP_LIGHT == 2
#define RL_(x) x, x,
#else
#define RL_(x) x,
#endif
__device__ const unsigned char g_seq[] = { RL_(PH_PREP) RL_(PH_NORM_A0) RI_(PH_AIN0) PH_MIX0, RG_(PH_AOUT0) RL_(PH_NORM_A1) RI_(PH_AIN1) PH_MIX1, PH_AOUT1, RL_(PH_NORM_KV) RG_(PH_DKV_BIN0) RG_(PH_UKV_UQ0)
                                           PH_KPOST, RA_(PH_ATTN0) PH_BOUT0, RL_(PH_NORM_B1) RG_(PH_BIN1) RG_(PH_UQ1) RA_(PH_ATTN1) PH_BOUT1 };
constexpr int NSEQ = (int)sizeof(g_seq);

__global__ void __launch_bounds__(512, 2) mega(Params p) {
    extern __shared__ __attribute__((aligned(16))) unsigned char shm[];
    LAS unsigned char* lds = (LAS unsigned char*)shm;
    for (int pi = p.ph_lo; pi < p.ph_hi; ++pi) {
        const int ph = g_seq[pi];
        int TID = threadIdx.x, BID = blockIdx.x; unsigned char* ws = p.ws;
        asm volatile("" : "+v"(TID), "+s"(BID));
        const float* mod = (const float*)(ws + WS_MOD);
        const float* kvmod = (const float*)(ws + WS_KVMOD);
        const float* cosT = (const float*)(ws + WS_COS);
        const float* sinT = (const float*)(ws + WS_SIN);
        switch (ph) {
#if PHSEL & 1
        case PH_PREP: phase_prep(TID, BID, p, ws, shm); break;
#endif
#if PHSEL & 2
        case PH_NORM_A0: case PH_NORM_A1: case PH_NORM_B1: {
            const int l = ph == PH_NORM_A0 ? 0 : (ph == PH_NORM_A1 ? 1 : 3);
            const float* x = l == 0 ? p.in[I_X] : p.out;
            const float* m = mod + (size_t)l * 4 * 6144;
            phase_norm(TID, BID, x, p.in[I_NORM_G] + l * DM, m, m + 2048, 6144, (bf16_t*)(ws + WA_H), nullptr, nullptr, nullptr, 0, nullptr);
        } break;
#endif
#if PHSEL & 4
        case PH_NORM_KV: {
            const float* m = mod + (size_t)2 * 4 * 6144;
            phase_norm(TID, BID, p.out, p.in[I_NORM_G] + 2 * DM, m, m + 2048, 6144, (bf16_t*)(ws + WB_H), p.in[I_KV_NORM_G], kvmod, kvmod + 2048, 4096, (bf16_t*)(ws + WB_HKV));
        } break;
#endif
#if PHSEL & 8
        case PH_AIN0: case PH_AIN1: {
            const int l = ph == PH_AIN0 ? 0 : 1;
            const bf16_t* W = (const bf16_t*)(ws + WS_WINA) + (size_t)l * 12288 * 2048;
            EpiUZ E{(bf16_t*)(ws + WA_P)};
            run_gemm(TID, BID, lds, (const bf16_t*)(ws + WA_H), W, T, 8192, 2048, E);
            EpiGVT E2{(bf16_t*)(ws + WA_GVT), (float*)(ws + WA_STATS)};
            run_gemm(TID, BID, lds, W + (size_t)8192 * 2048, (const bf16_t*)(ws + WA_H), 4096, T, 2048, E2);
        } break;
#endif
#if PHSEL & 16
        case PH_MIX0: case PH_MIX1: {
            const int l = ph == PH_MIX0 ? 0 : 1;
            phase_mix(TID, BID, shm, (bf16_t*)(ws + WA_P), (const bf16_t*)(ws + WA_GVT), (const float*)(ws + WA_STATS), (const bf16_t*)(ws + WS_WS16) + (size_t)l * 16 * 128 * 128, p.in[I_A_B_S] + l * 16 * 128,
                      p.in[I_A_LN_G] + l * GMW, p.in[I_A_LN_B] + l * GMW);
        } break;
#endif
#if PHSEL & 32
        case PH_AOUT0: case PH_AOUT1: case PH_BOUT0: case PH_BOUT1: {
            const int l = ph == PH_AOUT0 ? 0 : (ph == PH_AOUT1 ? 1 : (ph == PH_BOUT0 ? 2 : 3));
            const float* xin = l == 0 ? p.in[I_X] : p.out;
            EpiRes E{xin, p.out, mod + (size_t)l * 4 * 6144 + 4096, 6144};
            const bf16_t* A = l < 2 ? (const bf16_t*)(ws + WA_P) : (const bf16_t*)(ws + WB_Y);
            const bf16_t* Bt = l < 2 ? (const bf16_t*)(ws + WS_WOUTA) + (size_t)l * 2048 * 4096 : (const bf16_t*)(ws + WS_WOUTB) + (size_t)(l - 2) * 2048 * 2048;
            run_gemm(TID, BID, lds, A, Bt, T, 2048, l < 2 ? 4096 : 2048, E);
        } break;
#endif
#if PHSEL & 64
        case PH_DKV_BIN0: case PH_BIN1: {
            if (ph == PH_DKV_BIN0) {
                EpiLat<0> E{(bf16_t*)(ws + WB_CKV), (float*)(ws + WB_SSQKV), (float*)(ws + WB_KRAW), nullptr};
                run_gemm(TID, BID, lds, (const bf16_t*)(ws + WB_HKV), (const bf16_t*)(ws + WS_WDKV), T, 768, 2048, E);
            }
            const int j = ph == PH_DKV_BIN0 ? 0 : 1;
            EpiLat<1> E{(bf16_t*)(ws + WB_CQ), (float*)(ws + WB_SSQQ), nullptr, (bf16_t*)(ws + WB_Z)};
            run_gemm(TID, BID, lds, (const bf16_t*)(ws + WB_H), (const bf16_t*)(ws + WS_WINB) + (size_t)j * 2560 * 2048, T, 2560, 2048, E);
        } break;
#endif
#if PHSEL & 128
        case PH_UKV_UQ0: case PH_UQ1: {
            if (ph == PH_UKV_UQ0) {
                EpiScaled E{(bf16_t*)(ws + WB_KN), 2048, (const float*)(ws + WB_SSQKV)};
                run_gemm(TID, BID, lds, (const bf16_t*)(ws + WB_CKV), (const bf16_t*)(ws + WS_WKN), T, 2048, 512, E);
                EpiVT E2{(bf16_t*)(ws + WB_VT), (const float*)(ws + WB_SSQKV)};
                run_gemm(TID, BID, lds, (const bf16_t*)(ws + WS_WV), (const bf16_t*)(ws + WB_CKV), 2048, T, 512, E2);
            }
            const int j = ph == PH_UKV_UQ0 ? 0 : 1;
            EpiScaled E{(bf16_t*)(ws + WB_Q), 3072, (const float*)(ws + WB_SSQQ)};
            run_gemm(TID, BID, lds, (const bf16_t*)(ws + WB_CQ), (const bf16_t*)(ws + WS_WUQ) + (size_t)j * 3072 * 512, T, 3072, 512, E);
        } break;
#endif
#if PHSEL & 256
        case PH_KPOST:
            phase_kpost(TID, BID, (bf16_t*)(ws + WB_KN), (const float*)(ws + WB_KRAW), (bf16_t*)(ws + WB_KROPE), p.in[I_KV_G_KN], p.in[I_KV_G_KR], cosT, sinT);
            break;
#endif
#if PHSEL & 512
        case PH_ATTN0: case PH_ATTN1: {
            const int j = ph == PH_ATTN0 ? 0 : 1;
            phase_attn(TID, BID, shm, (const bf16_t*)(ws + WB_Q), (const bf16_t*)(ws + WB_KN), (const bf16_t*)(ws + WB_KROPE), (const bf16_t*)(ws + WB_VT), (const bf16_t*)(ws + WB_Z), (bf16_t*)(ws + WB_Y),
                       p.in[I_B_G_QN] + j * 128, p.in[I_B_G_QR] + j * 64, cosT, sinT);
        } break;
#endif
        default: break;
        }
        if (pi + 1 < p.ph_hi) {
            if (pi == p.ph_lo) cg::this_grid().sync();
            else grid_bar((unsigned*)(p.ws + WS_BAR), (unsigned)(pi - p.ph_lo), TID, BID);
        }
    }
}

extern "C" void kernel_launch(void* const* d_in, const int* in_sizes, int n_in, void* d_out, int out_size, void* d_ws, size_t ws_size, hipStream_t stream) {
    static int grid = 0;
    if (grid == 0) {
        if (n_in != 25 || ws_size < WS_NEED) { fprintf(stderr, "kernel_launch: unexpected n_in %d / ws %zu (need %zu)\n", n_in, ws_size, (size_t)WS_NEED); grid = -1; return; }
        int dev = 0, cus = 0, per_cu = 0;
        hipGetDevice(&dev);
        hipDeviceGetAttribute(&cus, hipDeviceAttributeMultiprocessorCount, dev);
        if (hipFuncSetAttribute((const void*)mega, hipFuncAttributeMaxDynamicSharedMemorySize, LDS_BYTES) != hipSuccess) { fprintf(stderr, "kernel_launch: hipFuncSetAttribute failed\n"); grid = -1; return; }
        if (hipOccupancyMaxActiveBlocksPerMultiprocessor(&per_cu, (const void*)mega, 512, LDS_BYTES) != hipSuccess || per_cu < 1) { fprintf(stderr, "kernel_launch: occupancy query gave %d\n", per_cu); per_cu = 1; }
        (void)hipGetLastError();
        grid = cus * per_cu;
    }
    if (grid < 0) return;
    Params p{};
    for (int i = 0; i < 25; ++i) p.in[i] = (const float*)d_in[i];
    p.out = (float*)d_out; p.ws = (unsigned char*)d_ws;
#if MK_SINGLE
    p.ph_lo = 0; p.ph_hi = NSEQ;
    if (hipMemsetAsync((char*)d_ws + WS_BAR, 0, 4096, stream) != hipSuccess) { fprintf(stderr, "kernel_launch: memset of the barrier words failed\n"); return; }
    void* args[] = {&p};
    hipError_t e = hipLaunchCooperativeKernel((const void*)mega, dim3(grid), dim3(512), args, LDS_BYTES, stream);
    if (e != hipSuccess) fprintf(stderr, "cooperative launch failed: %s (grid %d)\n", hipGetErrorString(e), grid);
#else
    for (int ph = 0; ph < NSEQ; ++ph) {
        p.ph_lo = ph; p.ph_hi = ph + 1;
        hipLaunchKernelGGL(mega, dim3(grid), dim3(512), LDS_BYTES, stream, p);
    }
#endif
}
```

```cpp
#include <hip/hip_runtime.h>
#include <hip/hip_cooperative_groups.h>
#include <cstdio>
#include <cstdint>
namespace cg = cooperative_groups;

#ifndef PHSEL
#define PHSEL 0xFFFF
#endif
#ifndef REP_ATTN
#define REP_ATTN 1
#endif
#ifndef REP_MIX
#define REP_MIX 1
#endif
#ifndef REP_AIN
#define REP_AIN 1
#endif
#ifndef REP_GEMM
#define REP_GEMM 1
#endif
#ifndef REP_LIGHT
#define REP_LIGHT 1
#endif
#ifndef MK_SINGLE
#define MK_SINGLE 1
#endif

typedef unsigned short bf16_t;
typedef short bf16x8 __attribute__((ext_vector_type(8)));
typedef float f32x2 __attribute__((ext_vector_type(2)));
typedef float f32x4 __attribute__((ext_vector_type(4)));
typedef float f32x16 __attribute__((ext_vector_type(16)));
typedef unsigned u32x4 __attribute__((ext_vector_type(4)));
typedef unsigned u32x2 __attribute__((ext_vector_type(2)));
#define LAS __attribute__((address_space(3)))
#define GAS __attribute__((address_space(1)))

constexpr int T = 32768, DM = 2048, SEQ = 8192, NBATCH = 4;
constexpr int GMW = 4096;
constexpr float EPS = 1e-6f;
constexpr float QSCALE = 0.07216878364870322f * 1.4426950408889634f;

constexpr size_t WS_BAR = 0;
constexpr size_t WS_MOD = 4096;
constexpr size_t WS_KVMOD = WS_MOD + 4ull * 4 * 6144 * 4;
constexpr size_t WS_COS = WS_KVMOD + 4ull * 4096 * 4;
constexpr size_t WS_SIN = WS_COS + 8192ull * 32 * 4;
constexpr size_t WS_WINA = WS_SIN + 8192ull * 32 * 4;
constexpr size_t WS_WOUTA = WS_WINA + 2ull * 12288 * 2048 * 2;
constexpr size_t WS_WDKV = WS_WOUTA + 2ull * 2048 * 4096 * 2;
constexpr size_t WS_WKN = WS_WDKV + 768ull * 2048 * 2;
constexpr size_t WS_WV = WS_WKN + 2048ull * 512 * 2;
constexpr size_t WS_WINB = WS_WV + 2048ull * 512 * 2;
constexpr size_t WS_WUQ = WS_WINB + 2ull * 2560 * 2048 * 2;
constexpr size_t WS_WOUTB = WS_WUQ + 2ull * 3072 * 512 * 2;
constexpr size_t WS_WS16 = WS_WOUTB + 2ull * 2048 * 2048 * 2;
constexpr size_t WS_ACT = WS_WS16 + 2ull * 16 * 128 * 128 * 2;
constexpr size_t WA_H = WS_ACT;
constexpr size_t WA_P = WA_H + (size_t)T * 2048 * 2;
constexpr size_t WA_GVT = WA_P + (size_t)T * 4096 * 2;
constexpr size_t WA_STATS = WA_GVT + (size_t)T * 4096 * 2;
constexpr size_t WA_END = WA_STATS + (size_t)T * 32 * 2 * 4;
constexpr size_t WB_H = WS_ACT;
constexpr size_t WB_HKV = WB_H + (size_t)T * 2048 * 2;
constexpr size_t WB_Q = WS_ACT;
constexpr size_t WB_CKV = WB_HKV + (size_t)T * 2048 * 2;
constexpr size_t WB_CQ = WB_CKV + (size_t)T * 512 * 2;
constexpr size_t WB_KRAW = WB_CQ + (size_t)T * 512 * 2;
constexpr size_t WB_KROPE = WB_KRAW + (size_t)T * 64 * 4;
constexpr size_t WB_SSQKV = WB_KROPE + (size_t)T * 64 * 2;
constexpr size_t WB_SSQQ = WB_SSQKV + (size_t)T * 8 * 4;
constexpr size_t WB_Z = WB_SSQQ + (size_t)T * 8 * 4;
constexpr size_t WB_KN = WB_Z + (size_t)T * 2048 * 2;
constexpr size_t WB_VT = WB_KN + (size_t)T * 2048 * 2;
constexpr size_t WB_END = WB_VT + (size_t)T * 2048 * 2;
constexpr size_t WB_Y = WB_Q + (size_t)T * 3072 * 2;
static_assert(WB_Y + (size_t)T * 2048 * 2 == WB_KRAW, "Y overlay");
constexpr size_t WS_NEED = WA_END > WB_END ? WA_END : WB_END;
static_assert(WS_NEED <= (1ull << 30), "workspace");

constexpr int LDS_BYTES = 131072;

__device__ __forceinline__ unsigned cvt_pk_bf16(float lo, float hi) { unsigned r; asm volatile("v_cvt_pk_bf16_f32 %0, %1, %2" : "=v"(r) : "v"(lo), "v"(hi)); return r; }
__device__ __forceinline__ float bf2f(unsigned short v) { return __uint_as_float(((unsigned)v) << 16); }
__device__ __forceinline__ float bflo(unsigned w) { return __uint_as_float(w << 16); }
__device__ __forceinline__ float bfhi(unsigned w) { return __uint_as_float(w & 0xffff0000u); }
__device__ __forceinline__ float gelu_f(float x) {
    const float u = x * (1.0f + 0.044715f * x * x);
    const float e = __builtin_amdgcn_exp2f(-2.302208198f * u);
    return x * __builtin_amdgcn_rcpf(1.0f + e);
}
__device__ __forceinline__ float silu_f(float x) { const float e = __builtin_amdgcn_exp2f(-1.4426950408889634f * x); return x * __builtin_amdgcn_rcpf(1.0f + e); }
__device__ __forceinline__ u32x4 pack8f(const float* r) { u32x4 o = {cvt_pk_bf16(r[0], r[1]), cvt_pk_bf16(r[2], r[3]), cvt_pk_bf16(r[4], r[5]), cvt_pk_bf16(r[6], r[7])}; return o; }

template <class Tp> __device__ __forceinline__ Tp* uniform_ptr(Tp* p) {
    const unsigned long long v = (unsigned long long)p; const unsigned lo = __builtin_amdgcn_readfirstlane((unsigned)v), hi = __builtin_amdgcn_readfirstlane((unsigned)(v >> 32));
    return (Tp*)(GAS Tp*)(((unsigned long long)hi << 32) | lo);
}
__device__ __forceinline__ float x32_sum(float v) { auto rr = __builtin_amdgcn_permlane32_swap(__float_as_uint(v), __float_as_uint(v), false, false); return __uint_as_float(rr[0]) + __uint_as_float(rr[1]); }
__device__ __forceinline__ float x32_max(float v) { auto rr = __builtin_amdgcn_permlane32_swap(__float_as_uint(v), __float_as_uint(v), false, false); return fmaxf(__uint_as_float(rr[0]), __uint_as_float(rr[1])); }

__device__ __forceinline__ void grid_bar(unsigned* bar, const unsigned epoch, const int TID, const int BID) {
    __syncthreads();
    if (TID == 0) {
        const unsigned G = gridDim.x, g = (unsigned)BID & 7u;
        const unsigned cnt = (G + 7u - g) >> 3;
        const unsigned ngrp = G < 8u ? G : 8u;
        __builtin_amdgcn_fence(__ATOMIC_RELEASE, "agent");
        const unsigned old = __hip_atomic_fetch_add(bar + 64 * (1 + g), 1u, __ATOMIC_RELAXED, __HIP_MEMORY_SCOPE_AGENT);
        if (old + 1u == cnt * epoch) {
            __builtin_amdgcn_fence(__ATOMIC_ACQ_REL, "agent");
            __hip_atomic_fetch_add(bar, 1u, __ATOMIC_RELAXED, __HIP_MEMORY_SCOPE_AGENT);
        }
        while (__hip_atomic_load(bar, __ATOMIC_RELAXED, __HIP_MEMORY_SCOPE_AGENT) < ngrp * epoch) __builtin_amdgcn_s_sleep(1);
        __builtin_amdgcn_fence(__ATOMIC_ACQUIRE, "agent");
    }
    __syncthreads();
}

namespace pg8 {
constexpr int BM = 256, BK = 64, HALF = 128, HTB = HALF * BK * 2, STAGE_BYTES = 8 * HTB, NXCD = 8, WGM = 8;
__host__ __device__ __forceinline__ int lds_byte(int r, int c) { const int st = (r >> 4) * 2 + (c >> 5), rr = r & 15, cc = c & 31, ob = rr * 64 + cc * 2; return st * 1024 + (ob ^ (((ob >> 9) & 1) << 5)); }
__host__ __device__ __forceinline__ void stage_rc(int b, int& R, int& C) { const int st = b / 1024, sb = b % 1024, swz = sb ^ (((sb >> 9) & 1) << 5); R = (st >> 1) * 16 + swz / 64; C = (st & 1) * 32 + (swz % 64) / 2; }
__host__ __device__ __forceinline__ int perm32(int rho) { const int n = rho >> 4, i = rho & 15; return 8 * (i >> 2) + 4 * n + (i & 3); }
struct Unit { int pm, pn; };
struct Gemm { const bf16_t* A; const bf16_t* Bt; int M, N, K; int a_rs; size_t a_kstep; };
struct StaticOrder {
    int nM, nN, nwg, G, c, wgm;
    __host__ __device__ void init(int M, int N, int G_, int c_, int wgm_) { nM = M / BM; nN = N / BM; nwg = nM * nN; G = G_; c = c_; wgm = wgm_; }
    __host__ __device__ bool next(int i, Unit& u) const {
        const long L = (long)i * G + c; if (L >= nwg) return false;
        int wgid = (int)L; { const int q = nwg / NXCD, r = nwg % NXCD, xcd = wgid % NXCD, off = wgid / NXCD; wgid = (xcd < r ? xcd * (q + 1) : r * (q + 1) + (xcd - r) * q) + off; }
        const int nig = wgm * nN, gid = wgid / nig, fm = gid * wgm, gsz = (nM - fm) < wgm ? (nM - fm) : wgm;
        u.pm = fm + ((wgid % nig) % gsz); u.pn = (wgid % nig) / gsz; return true;
    }
    __device__ __forceinline__ void a_ready(const Unit&) const {}
    __device__ __forceinline__ void done(const Unit&) const {}
};

template <class Epi, class Sched>
__device__ __forceinline__ void gemm_phase(const int TID, LAS unsigned char* lds, const Gemm g, const Sched& S, const Epi& E) {
    const int tid = TID, wid = __builtin_amdgcn_readfirstlane(tid >> 6), lane = tid & 63, wr = wid >> 2, wc = wid & 3, fr = lane & 15, fq = lane >> 4;
    const int K = g.K, nt = K / BK;
    unsigned voffA[2], voffB[2];
#pragma unroll
    for (int i = 0; i < 2; ++i) { int R, C; stage_rc(tid * 16 + i * 8192, R, C); const int Rb = Epi::PERM ? ((R & ~31) + perm32(R & 31)) : R;
        voffA[i] = (unsigned)(R * g.a_rs + C) * 2u; voffB[i] = (unsigned)(Rb * K + C) * 2u; }
    const size_t kstep = (size_t)(BK * 2), kstepA = g.a_kstep;
    const size_t hstep = (size_t)HALF * K * 2, hstepA = (size_t)HALF * g.a_rs * 2;
    const size_t tstep = 2 * hstep, tstepA = 2 * hstepA;
    const unsigned ldsw = (unsigned)wid * 1024u;
    const int aoff = lds_byte(wr * 64 + fr, fq * 8), boff = lds_byte(wc * 32 + fr, fq * 8);
#define PG8_SA(b, h) (((b) * 2 + (h)) * HTB)
#define PG8_SB(b, h) ((4 + (b) * 2 + (h)) * HTB)
#define PG8_STAGE(bufoff, gbase, voff) do { _Pragma("unroll") for (int _i = 0; _i < 2; ++_i) \
        __builtin_amdgcn_global_load_lds((const unsigned*)((const char*)(gbase) + (voff)[_i]), (LAS unsigned*)(lds + (bufoff) + ldsw + _i * 8192), 16, 0, 0); } while (0)
#define PG8_LDA(dst, b, h) do { _Pragma("unroll") for (int m = 0; m < 4; ++m) _Pragma("unroll") for (int k = 0; k < 2; ++k) dst[m][k] = *(const LAS bf16x8*)(lds + PG8_SA(b, h) + aoff + m * 2048 + k * 1024); } while (0)
#define PG8_LDB(dst, b, h) do { _Pragma("unroll") for (int n = 0; n < 2; ++n) _Pragma("unroll") for (int k = 0; k < 2; ++k) dst[n][k] = *(const LAS bf16x8*)(lds + PG8_SB(b, h) + boff + n * 2048 + k * 1024); } while (0)
#define PG8_MMA(ai, bj, At, Bt) do { __builtin_amdgcn_s_setprio(1); _Pragma("unroll") for (int m = 0; m < 4; ++m) _Pragma("unroll") for (int n = 0; n < 2; ++n) _Pragma("unroll") for (int k = 0; k < 2; ++k) \
        acc[ai][bj][m][n] = __builtin_amdgcn_mfma_f32_16x16x32_bf16(Bt[n][k], At[m][k], acc[ai][bj][m][n], 0, 0, 0); __builtin_amdgcn_s_setprio(0); } while (0)
#define PG8_WAIT_V(n) asm volatile("s_waitcnt vmcnt(" #n ")" ::: "memory")
#define PG8_WAIT_L(n) asm volatile("s_waitcnt lgkmcnt(" #n ")" ::: "memory")
#define PG8_BAR __builtin_amdgcn_s_barrier()
#define PG8_SCHED __builtin_amdgcn_sched_barrier(0)
    Unit cur, nxt; int ui = 0;
    if (!S.next(0, cur)) return;
    f32x4 acc[2][2][4][2];
#pragma unroll
    for (int a = 0; a < 2; ++a)
#pragma unroll
        for (int b = 0; b < 2; ++b)
#pragma unroll
            for (int m = 0; m < 4; ++m)
#pragma unroll
                for (int n = 0; n < 2; ++n) acc[a][b][m][n] = (f32x4){0.f, 0.f, 0.f, 0.f};
    bf16x8 At[4][2], B0[2][2], B1[2][2];
    const char* cA = (const char*)g.A + (size_t)cur.pm * tstepA; const char* cB = (const char*)g.Bt + (size_t)cur.pn * tstep;
    S.a_ready(cur);
    PG8_STAGE(PG8_SB(0, 0), cB, voffB); PG8_STAGE(PG8_SA(0, 0), cA, voffA); PG8_STAGE(PG8_SB(0, 1), cB + hstep, voffB); PG8_STAGE(PG8_SA(0, 1), cA + hstepA, voffA);
    if (wr == 1) PG8_BAR;
    PG8_WAIT_V(4); PG8_BAR;
    PG8_STAGE(PG8_SB(1, 0), cB + kstep, voffB); PG8_STAGE(PG8_SA(1, 0), cA + kstepA, voffA); PG8_STAGE(PG8_SB(1, 1), cB + hstep + kstep, voffB);
    PG8_WAIT_V(6); PG8_BAR;
    for (;;) {
        const bool has_next = S.next(ui + 1, nxt);
        const char* nA = has_next ? (const char*)g.A + (size_t)nxt.pm * tstepA : cA; const char* nB = has_next ? (const char*)g.Bt + (size_t)nxt.pn * tstep : cB;
        for (int t = 0; t < nt; t += 2) {
            const bool last = (t == nt - 2);
            const char* a1 = cA + (size_t)(t + 1) * kstepA;
            const char* a2 = last ? nA : cA + (size_t)(t + 2) * kstepA; const char* b2 = last ? nB : cB + (size_t)(t + 2) * kstep;
            const char* a3 = a2 + kstepA; const char* b3 = b2 + kstep;
            if (last && has_next) S.a_ready(nxt);
            PG8_LDB(B0, 0, 0); PG8_SCHED; PG8_LDA(At, 0, 0); PG8_STAGE(PG8_SA(1, 1), a1 + hstepA, voffA);
            PG8_WAIT_L(8); PG8_BAR; PG8_WAIT_L(0); PG8_MMA(0, 0, At, B0); PG8_BAR; PG8_SCHED;
            PG8_LDB(B1, 0, 1); PG8_STAGE(PG8_SB(0, 0), b2, voffB);
            PG8_BAR; PG8_WAIT_L(0); PG8_MMA(0, 1, At, B1); PG8_BAR;
            PG8_LDA(At, 0, 1); PG8_STAGE(PG8_SA(0, 0), a2, voffA);
            PG8_BAR; PG8_WAIT_L(0); PG8_MMA(1, 0, At, B0); PG8_BAR; PG8_SCHED;
            PG8_STAGE(PG8_SB(0, 1), b2 + hstep, voffB);
            PG8_WAIT_V(6); PG8_BAR; PG8_MMA(1, 1, At, B1); PG8_BAR;
            PG8_LDB(B0, 1, 0); PG8_SCHED; PG8_LDA(At, 1, 0); PG8_STAGE(PG8_SA(0, 1), a2 + hstepA, voffA);
            PG8_WAIT_L(8); PG8_BAR; PG8_WAIT_L(0); PG8_MMA(0, 0, At, B0); PG8_BAR; PG8_SCHED;
            PG8_LDB(B1, 1, 1); PG8_STAGE(PG8_SB(1, 0), b3, voffB);
            PG8_BAR; PG8_WAIT_L(0); PG8_MMA(0, 1, At, B1); PG8_BAR;
            PG8_LDA(At, 1, 1); PG8_STAGE(PG8_SA(1, 0), a3, voffA);
            PG8_BAR; PG8_WAIT_L(0); PG8_MMA(1, 0, At, B0); PG8_BAR; PG8_SCHED;
            PG8_STAGE(PG8_SB(1, 1), b3 + hstep, voffB);
            PG8_WAIT_V(6); PG8_BAR; PG8_MMA(1, 1, At, B1); PG8_BAR;
        }
        E(acc, cur, wr, wc, fr, fq);
        if (!has_next) break;
#pragma unroll
        for (int a = 0; a < 2; ++a)
#pragma unroll
            for (int b = 0; b < 2; ++b)
#pragma unroll
                for (int m = 0; m < 4; ++m)
#pragma unroll
                    for (int n = 0; n < 2; ++n) acc[a][b][m][n] = (f32x4){0.f, 0.f, 0.f, 0.f};
        cur = nxt; cA = nA; cB = nB; ++ui;
    }
    PG8_WAIT_V(0);
    if (wr == 0) PG8_BAR;
    PG8_BAR;
#undef PG8_SA
#undef PG8_SB
#undef PG8_STAGE
#undef PG8_LDA
#undef PG8_LDB
#undef PG8_MMA
#undef PG8_WAIT_V
#undef PG8_WAIT_L
#undef PG8_BAR
#undef PG8_SCHED
}
}
using pg8::Unit;

struct EpiUZ {
    static constexpr bool PERM = true;
    bf16_t* P;
    __device__ __forceinline__ void operator()(const f32x4 (&acc)[2][2][4][2], const Unit& u, int wr, int wc, int fr_, int fq_) const {
        int fr = fr_, fq = fq_; asm volatile("" : "+v"(fr), "+v"(fq));
        const int row0 = u.pm * 256 + wr * 64 + fr;
        const int col = u.pn * 128 + wc * 32 + 8 * fq;
#pragma unroll
        for (int ai = 0; ai < 2; ++ai)
#pragma unroll
            for (int m = 0; m < 4; ++m) {
                const size_t row = (size_t)(row0 + ai * 128 + m * 16);
                float r[8];
#pragma unroll
                for (int n = 0; n < 2; ++n)
#pragma unroll
                    for (int i = 0; i < 4; ++i) {
                        const float uu = acc[ai][0][m][n][i], zz = acc[ai][1][m][n][i];
                        const float eu = __builtin_amdgcn_exp2f(-2.302208198f * (uu * (1.0f + 0.044715f * uu * uu)));
                        const float ez = __builtin_amdgcn_exp2f(-1.4426950408889634f * zz);
                        r[4 * n + i] = (uu * zz) * __builtin_amdgcn_rcpf((1.0f + eu) * (1.0f + ez));
                    }
                *(u32x4*)(P + ((size_t)(col >> 6) * T + row) * 64 + (col & 63)) = pack8f(r);
            }
    }
};
struct EpiGVT {
    static constexpr bool PERM = true;
    bf16_t* GVT; float* stats;
    __device__ __forceinline__ void operator()(const f32x4 (&acc)[2][2][4][2], const Unit& u, int wr, int wc, int fr_, int fq_) const {
        int fr = fr_, fq = fq_; asm volatile("" : "+v"(fr), "+v"(fq));
        const int row0 = u.pm * 256 + wr * 64 + fr;
        const int tok0 = u.pn * 256 + wc * 32 + 8 * fq;
        float s[16], ss[16];
#pragma unroll
        for (int j = 0; j < 16; ++j) { s[j] = 0.f; ss[j] = 0.f; }
#pragma unroll
        for (int ai = 0; ai < 2; ++ai)
#pragma unroll
            for (int m = 0; m < 4; ++m) {
                const size_t row = (size_t)(row0 + ai * 128 + m * 16);
#pragma unroll
                for (int bj = 0; bj < 2; ++bj) {
                    float r[8];
#pragma unroll
                    for (int n = 0; n < 2; ++n)
#pragma unroll
                        for (int i = 0; i < 4; ++i) r[4 * n + i] = gelu_f(acc[ai][bj][m][n][i]);
                    const u32x4 o = pack8f(r);
#pragma unroll
                    for (int q = 0; q < 4; ++q) { const float a = bflo(o[q]), b = bfhi(o[q]); s[bj * 8 + 2 * q] += a; ss[bj * 8 + 2 * q] += a * a; s[bj * 8 + 2 * q + 1] += b; ss[bj * 8 + 2 * q + 1] += b * b; }
                    *(u32x4*)(GVT + row * T + tok0 + bj * 128) = o;
                }
            }
#pragma unroll
        for (int step = 0; step < 4; ++step) {
            const int msk = 8 >> step, cnt = 8 >> step;
            const bool up = (fr & msk) != 0;
#pragma unroll
            for (int j = 0; j < 8; ++j) {
                if (j < cnt) {
                    const float send_s = up ? s[j] : s[j + cnt], keep_s = up ? s[j + cnt] : s[j];
                    const float send_q = up ? ss[j] : ss[j + cnt], keep_q = up ? ss[j + cnt] : ss[j];
                    s[j] = keep_s + __shfl_xor(send_s, msk);
                    ss[j] = keep_q + __shfl_xor(send_q, msk);
                }
            }
        }
        {
            const int j = fr;
            const size_t tok = (size_t)(tok0 + 128 * (j >> 3) + (j & 7));
            f32x2 st = {s[0], ss[0]};
            *(f32x2*)(stats + (tok * 32 + u.pm * 2 + wr) * 2) = st;
        }
    }
};
struct EpiRes {
    static constexpr bool PERM = false;
    const float* xin; float* xout; const float* gate;
    int ldg;
    __device__ __forceinline__ void operator()(const f32x4 (&acc)[2][2][4][2], const Unit& u, int wr, int wc, int fr_, int fq_) const {
        int fr = fr_, fq = fq_; asm volatile("" : "+v"(fr), "+v"(fq));
        const int row0 = u.pm * 256 + wr * 64 + fr, col0 = u.pn * 256 + wc * 32 + 4 * fq;
        const float* gp = gate + (size_t)(u.pm >> 5) * ldg + col0;
        f32x4 gv[2][2];
#pragma unroll
        for (int bj = 0; bj < 2; ++bj)
#pragma unroll
            for (int n = 0; n < 2; ++n) gv[bj][n] = *(const f32x4*)(gp + bj * 128 + n * 16);
#pragma unroll
        for (int ai = 0; ai < 2; ++ai)
#pragma unroll
            for (int m = 0; m < 4; ++m) {
                const size_t off = (size_t)(row0 + ai * 128 + m * 16) * DM + col0;
#pragma unroll
                for (int bj = 0; bj < 2; ++bj)
#pragma unroll
                    for (int n = 0; n < 2; ++n) {
                        const f32x4 xo = *(const f32x4*)(xin + off + bj * 128 + n * 16);
                        *(f32x4*)(xout + off + bj * 128 + n * 16) = xo + gv[bj][n] * acc[ai][bj][m][n];
                    }
            }
    }
};
template <int MODE> struct EpiLat {
    static constexpr bool PERM = true;
    bf16_t* C; float* ssq; float* kr; bf16_t* Z;
    __device__ __forceinline__ void operator()(const f32x4 (&acc)[2][2][4][2], const Unit& u, int wr, int wc, int fr_, int fq_) const {
        int fr = fr_, fq = fq_; asm volatile("" : "+v"(fr), "+v"(fq));
        const int row0 = u.pm * 256 + wr * 64 + fr;
        if (u.pn < 2) {
#pragma unroll
            for (int ai = 0; ai < 2; ++ai)
#pragma unroll
                for (int m = 0; m < 4; ++m) {
                    const size_t row = (size_t)(row0 + ai * 128 + m * 16);
                    float ss = 0.f;
#pragma unroll
                    for (int bj = 0; bj < 2; ++bj) {
                        const int col = u.pn * 256 + bj * 128 + wc * 32 + 8 * fq;
                        float r[8];
#pragma unroll
                        for (int n = 0; n < 2; ++n)
#pragma unroll
                            for (int i = 0; i < 4; ++i) { r[4 * n + i] = acc[ai][bj][m][n][i]; ss += r[4 * n + i] * r[4 * n + i]; }
                        *(u32x4*)(C + row * 512 + col) = pack8f(r);
                    }
                    ss += __shfl_xor(ss, 16); ss += __shfl_xor(ss, 32);
                    if (fq == 0) ssq[row * 8 + u.pn * 4 + wc] = ss;
                }
        } else if (MODE == 0) {
            if (u.pn == 2 && wc < 2) {
#pragma unroll
                for (int ai = 0; ai < 2; ++ai)
#pragma unroll
                    for (int m = 0; m < 4; ++m) {
                        const size_t row = (size_t)(row0 + ai * 128 + m * 16);
                        *(f32x4*)(kr + row * 64 + wc * 32 + 8 * fq) = acc[ai][0][m][0];
                        *(f32x4*)(kr + row * 64 + wc * 32 + 8 * fq + 4) = acc[ai][0][m][1];
                    }
            }
        } else {
#pragma unroll
            for (int ai = 0; ai < 2; ++ai)
#pragma unroll
                for (int m = 0; m < 4; ++m) {
                    const size_t row = (size_t)(row0 + ai * 128 + m * 16);
#pragma unroll
                    for (int bj = 0; bj < 2; ++bj) {
                        const int col = (u.pn - 2) * 256 + bj * 128 + wc * 32 + 8 * fq;
                        float r[8];
#pragma unroll
                        for (int n = 0; n < 2; ++n)
#pragma unroll
                            for (int i = 0; i < 4; ++i) r[4 * n + i] = silu_f(acc[ai][bj][m][n][i]);
                        *(u32x4*)(Z + row * 2048 + col) = pack8f(r);
                    }
                }
        }
    }
};
struct EpiScaled {
    static constexpr bool PERM = true;
    bf16_t* O; int ldc; const float* ssq;
    __device__ __forceinline__ void operator()(const f32x4 (&acc)[2][2][4][2], const Unit& u, int wr, int wc, int fr_, int fq_) const {
        int fr = fr_, fq = fq_; asm volatile("" : "+v"(fr), "+v"(fq));
        const int row0 = u.pm * 256 + wr * 64 + fr;
#pragma unroll
        for (int ai = 0; ai < 2; ++ai)
#pragma unroll
            for (int m = 0; m < 4; ++m) {
                const size_t row = (size_t)(row0 + ai * 128 + m * 16);
                const f32x4 a = *(const f32x4*)(ssq + row * 8), b = *(const f32x4*)(ssq + row * 8 + 4);
                const float rs = rsqrtf((a[0] + a[1] + a[2] + a[3] + b[0] + b[1] + b[2] + b[3]) * (1.0f / 512.0f) + EPS);
#pragma unroll
                for (int bj = 0; bj < 2; ++bj) {
                    const int col = u.pn * 256 + bj * 128 + wc * 32 + 8 * fq;
                    float r[8];
#pragma unroll
                    for (int n = 0; n < 2; ++n)
#pragma unroll
                        for (int i = 0; i < 4; ++i) r[4 * n + i] = acc[ai][bj][m][n][i] * rs;
                    *(u32x4*)(O + row * ldc + col) = pack8f(r);
                }
            }
    }
};
struct EpiVT {
    static constexpr bool PERM = false;
    bf16_t* VT; const float* ssq;
    __device__ __forceinline__ void operator()(const f32x4 (&acc)[2][2][4][2], const Unit& u, int wr, int wc, int fr_, int fq_) const {
        int fr = fr_, fq = fq_; asm volatile("" : "+v"(fr), "+v"(fq));
        const int row0 = u.pm * 256 + wr * 64 + fr;
        const int pg = ((fq & 1) << 1) | (fq >> 1);
#pragma unroll
        for (int bj = 0; bj < 2; ++bj)
#pragma unroll
            for (int n = 0; n < 2; ++n) {
                const int tb = u.pn * 256 + bj * 128 + wc * 32 + 16 * n;
                const int tok0 = tb + 4 * fq;
                f32x4 rs;
#pragma unroll
                for (int i = 0; i < 4; ++i) {
                    const f32x4 a = *(const f32x4*)(ssq + (size_t)(tok0 + i) * 8), b = *(const f32x4*)(ssq + (size_t)(tok0 + i) * 8 + 4);
                    rs[i] = rsqrtf((a[0] + a[1] + a[2] + a[3] + b[0] + b[1] + b[2] + b[3]) * (1.0f / 512.0f) + EPS);
                }
                const int pos0 = tb + 4 * pg;
#pragma unroll
                for (int ai = 0; ai < 2; ++ai)
#pragma unroll
                    for (int m = 0; m < 4; ++m) {
                        const size_t row = (size_t)(row0 + ai * 128 + m * 16);
                        const f32x4 v = acc[ai][bj][m][n] * rs;
                        u32x2 o = {cvt_pk_bf16(v[0], v[1]), cvt_pk_bf16(v[2], v[3])};
                        *(u32x2*)(VT + row * T + pos0) = o;
                    }
            }
    }
};

template <class Epi> __device__ __forceinline__ void run_gemm(const int TID, const int BID, LAS unsigned char* lds, const bf16_t* A, const bf16_t* Bt, int M, int N, int K, const Epi& E, const bool a_blocked = false) {
    pg8::Gemm g{A, Bt, M, N, K, a_blocked ? 64 : K, a_blocked ? (size_t)M * 128 : (size_t)128}; pg8::StaticOrder S; S.init(M, N, (int)gridDim.x, (int)BID, 4);
    pg8::gemm_phase<Epi, pg8::StaticOrder>(TID, lds, g, S, E);
}

struct Params {
    const float* in[25];
    float* out;
    unsigned char* ws;
    int ph_lo, ph_hi;
};
enum { I_X = 0, I_C, I_ADA_W, I_ADA_B, I_NORM_G, I_A_W_IN, I_A_LN_G, I_A_LN_B, I_A_W_S, I_A_B_S, I_A_W_OUT, I_KV_ADA_W, I_KV_ADA_B, I_KV_NORM_G, I_KV_W_DKV, I_KV_G_KVA,
       I_KV_W_UKV, I_KV_G_KN, I_KV_G_KR, I_B_W_IN, I_B_G_QA, I_B_W_UQ, I_B_G_QN, I_B_G_QR, I_B_W_OUT };

__device__ __forceinline__ void conv_tile(const int TID, unsigned char* shm, const float* src, int ldsrc, int srccol0, int K, int k0, bf16_t* dst, int n0, const float* scale) {
    float* tile = (float*)shm;
    const int tid = TID;
    {
        const int kk = tid >> 4, c4 = tid & 15;
        f32x4 v[8];
#pragma unroll
        for (int i = 0; i < 8; ++i) {
            v[i] = (f32x4){0.f, 0.f, 0.f, 0.f};
            if (srccol0 >= 0) v[i] = *(const f32x4*)(src + (size_t)(k0 + kk + 32 * i) * ldsrc + srccol0 + 4 * c4);
        }
#pragma unroll
        for (int i = 0; i < 8; ++i) { float* tp = tile + (kk + 32 * i) * 65 + 4 * c4; tp[0] = v[i][0]; tp[1] = v[i][1]; tp[2] = v[i][2]; tp[3] = v[i][3]; }
    }
    __syncthreads();
    {
        const int n = tid >> 3, k8 = tid & 7;
#pragma unroll
        for (int jb = 0; jb < 4; ++jb) {
            float r[8];
#pragma unroll
            for (int j = 0; j < 8; ++j) { r[j] = tile[(64 * jb + 8 * k8 + j) * 65 + n]; if (scale) r[j] *= scale[k0 + 64 * jb + 8 * k8 + j]; }
            *(u32x4*)(dst + (size_t)(n0 + n) * K + k0 + 64 * jb + 8 * k8) = pack8f(r);
        }
    }
    __syncthreads();
}

__device__ __forceinline__ void phase_prep(const int TID, const int BID, const Params& p, unsigned char* ws, unsigned char* shm) {
    const int tid = TID;
    {
        float* cosT = (float*)(ws + WS_COS); float* sinT = (float*)(ws + WS_SIN);
        for (int idx = BID * 512 + tid; idx < SEQ * 32; idx += gridDim.x * 512) {
            const int pos = idx >> 5, i = idx & 31;
            double f = 1.0; for (int q = 0; q < i; ++q) f *= 0.7498942093324559;
            const float invf = (float)f;
            const float ang = (float)pos * invf;
            const double ad = (double)ang;
            const double n = rint(ad * 0.15915494309189535);
            const double r = ad - n * 6.283185307179586;
            const double r2 = r * r;
            double s = 1.0, c = 1.0;
#pragma unroll 1
            for (int k = 14; k >= 1; --k) { s = 1.0 - s * r2 / (double)((2 * k) * (2 * k + 1)); c = 1.0 - c * r2 / (double)((2 * k - 1) * (2 * k)); }
            cosT[idx] = (float)c; sinT[idx] = (float)(r * s);
        }
    }
    if (BID < 224) {
        float* sc = (float*)shm;
        float* red = (float*)(shm + 32768);
        const float* cin = p.in[I_C];
        for (int i = tid; i < 4 * 2048; i += 512) sc[i] = silu_f(cin[i]);
        __syncthreads();
        const int item = BID;
        const float* W; const float* bias; float* out; int ldw, cb;
        if (item < 192) { const int l = item / 48; cb = item % 48; W = p.in[I_ADA_W] + (size_t)l * 2048 * 6144; ldw = 6144; bias = p.in[I_ADA_B] + l * 6144; out = (float*)(ws + WS_MOD) + (size_t)l * 4 * 6144; }
        else { cb = item - 192; W = p.in[I_KV_ADA_W]; ldw = 4096; bias = p.in[I_KV_ADA_B]; out = (float*)(ws + WS_KVMOD); }
        const int cgp = tid & 31, kg = tid >> 5;
        const float* wp = W + (size_t)(kg * 128) * ldw + cb * 128 + cgp * 4;
        f32x4 a0 = {0.f, 0.f, 0.f, 0.f}, a1 = a0, a2 = a0, a3 = a0;
#pragma unroll 8
        for (int k = 0; k < 128; ++k) {
            const f32x4 w = *(const f32x4*)(wp + (size_t)k * ldw);
            const int kk = kg * 128 + k;
            a0 += w * sc[kk]; a1 += w * sc[2048 + kk]; a2 += w * sc[4096 + kk]; a3 += w * sc[6144 + kk];
        }
        float* rp = red + ((size_t)kg * 128 + cgp * 4) * 4;
#pragma unroll
        for (int e = 0; e < 4; ++e) { rp[e * 4 + 0] = a0[e]; rp[e * 4 + 1] = a1[e]; rp[e * 4 + 2] = a2[e]; rp[e * 4 + 3] = a3[e]; }
        __syncthreads();
        {
            const int col = tid >> 2, b = tid & 3;
            float s = 0.f;
#pragma unroll
            for (int g = 0; g < 16; ++g) s += red[((size_t)g * 128 + col) * 4 + b];
            out[(size_t)b * ldw + cb * 128 + col] = s + bias[cb * 128 + col];
        }
        __syncthreads();
    }
    {
        const float* wsrc = p.in[I_A_W_S]; bf16_t* wdst = (bf16_t*)(ws + WS_WS16);
        for (int idx = BID * 512 + TID; idx < 2 * 16 * 128 * 128 / 4; idx += gridDim.x * 512) {
            const int e = idx * 4, s4 = e & 127, t = (e >> 7) & 127;
            f32x4 w = *(const f32x4*)(wsrc + e);
#pragma unroll
            for (int q = 0; q < 4; ++q) if (s4 + q > t) w[q] = 0.f;
            u32x2 o = {cvt_pk_bf16(w[0], w[1]), cvt_pk_bf16(w[2], w[3])};
            *(u32x2*)(wdst + e) = o;
        }
    }
    {
        constexpr int NJ = 13;
        const int ntile[NJ] = {1536, 1536, 512, 512, 96, 64, 64, 320, 320, 96, 96, 256, 256};
        int total = 0;
#pragma unroll
        for (int j = 0; j < NJ; ++j) total += ntile[j];
        for (int tix = BID; tix < total; tix += gridDim.x) {
            int j = 0, rem = tix;
#pragma unroll
            for (int q = 0; q < NJ; ++q) { if (j == q && rem >= ntile[q]) { rem -= ntile[q]; j = q + 1; } }
            const float* src; int ldsrc, K; bf16_t* dst; const float* scale = nullptr; int srccol0, n0, k0;
            if (j < 2) {
                K = 2048; ldsrc = 12288; src = p.in[I_A_W_IN] + (size_t)j * 2048 * 12288; dst = (bf16_t*)(ws + WS_WINA) + (size_t)j * 12288 * 2048;
                const int nt_ = rem / 8; k0 = (rem % 8) * 256; n0 = nt_ * 64;
                const int pn = n0 >> 8, jj = n0 & 255;
                srccol0 = pn < 32 ? (jj < 128 ? 128 * pn + jj : 8192 + 128 * pn + (jj - 128)) : 4096 + 256 * (pn - 32) + jj;
            } else if (j < 4) {
                const int l = j - 2; K = 4096; ldsrc = 2048; src = p.in[I_A_W_OUT] + (size_t)l * 4096 * 2048; dst = (bf16_t*)(ws + WS_WOUTA) + (size_t)l * 2048 * 4096;
                const int nt_ = rem / 16; k0 = (rem % 16) * 256; n0 = nt_ * 64; srccol0 = n0;
            } else if (j == 4) {
                K = 2048; ldsrc = 576; src = p.in[I_KV_W_DKV]; dst = (bf16_t*)(ws + WS_WDKV);
                const int nt_ = rem / 8; k0 = (rem % 8) * 256; n0 = nt_ * 64; srccol0 = n0 < 576 ? n0 : -1;
            } else if (j < 7) {
                K = 512; ldsrc = 4096; src = p.in[I_KV_W_UKV]; dst = (bf16_t*)(ws + (j == 5 ? WS_WKN : WS_WV)); scale = p.in[I_KV_G_KVA];
                const int nt_ = rem / 2; k0 = (rem % 2) * 256; n0 = nt_ * 64;
                srccol0 = (n0 >> 7) * 256 + (j == 6 ? 128 : 0) + (n0 & 127);
            } else if (j < 9) {
                const int l = j - 7; K = 2048; ldsrc = 2560; src = p.in[I_B_W_IN] + (size_t)l * 2048 * 2560; dst = (bf16_t*)(ws + WS_WINB) + (size_t)l * 2560 * 2048;
                const int nt_ = rem / 8; k0 = (rem % 8) * 256; n0 = nt_ * 64; srccol0 = n0;
            } else if (j < 11) {
                const int l = j - 9; K = 512; ldsrc = 3072; src = p.in[I_B_W_UQ] + (size_t)l * 512 * 3072; dst = (bf16_t*)(ws + WS_WUQ) + (size_t)l * 3072 * 512; scale = p.in[I_B_G_QA] + l * 512;
                const int nt_ = rem / 2; k0 = (rem % 2) * 256; n0 = nt_ * 64; srccol0 = n0;
            } else {
                const int l = j - 11; K = 2048; ldsrc = 2048; src = p.in[I_B_W_OUT] + (size_t)l * 2048 * 2048; dst = (bf16_t*)(ws + WS_WOUTB) + (size_t)l * 2048 * 2048;
                const int nt_ = rem / 8; k0 = (rem % 8) * 256; n0 = nt_ * 64; srccol0 = n0;
            }
            conv_tile(TID, shm, src, ldsrc, srccol0, K, k0, dst, n0, scale);
        }
    }
}

__device__ __forceinline__ void phase_norm(const int TID, const int BID, const float* x, const float* g1, const float* sh1, const float* sc1, int ld1, bf16_t* h1,
                           const float* g2, const float* sh2, const float* sc2, int ld2, bf16_t* h2) {
    const int lane = TID & 63, wid = TID >> 6;
    for (int row = BID * 8 + wid; row < T; row += gridDim.x * 8) {
        const int b = row >> 13;
        const f32x4* xr = (const f32x4*)(x + (size_t)row * DM);
        f32x4 v[8]; float ss = 0.f;
#pragma unroll
        for (int i = 0; i < 8; ++i) { v[i] = xr[lane + 64 * i]; ss += v[i][0] * v[i][0] + v[i][1] * v[i][1] + v[i][2] * v[i][2] + v[i][3] * v[i][3]; }
#pragma unroll
        for (int o = 32; o >= 1; o >>= 1) ss += __shfl_xor(ss, o);
        const float rs = rsqrtf(ss * (1.0f / 2048.0f) + EPS);
#pragma unroll
        for (int i = 0; i < 8; ++i) {
            const int k = 4 * (lane + 64 * i);
            const f32x4 gg = *(const f32x4*)(g1 + k), sc = *(const f32x4*)(sc1 + (size_t)b * ld1 + k), sh = *(const f32x4*)(sh1 + (size_t)b * ld1 + k);
            const f32x4 o = (v[i] * rs) * gg * (sc + 1.0f) + sh;
            u32x2 w = {cvt_pk_bf16(o[0], o[1]), cvt_pk_bf16(o[2], o[3])};
            *(u32x2*)(h1 + (size_t)row * DM + k) = w;
        }
        if (h2) {
#pragma unroll
            for (int i = 0; i < 8; ++i) {
                const int k = 4 * (lane + 64 * i);
                const f32x4 gg = *(const f32x4*)(g2 + k), sc = *(const f32x4*)(sc2 + (size_t)b * ld2 + k), sh = *(const f32x4*)(sh2 + (size_t)b * ld2 + k);
                const f32x4 o = (v[i] * rs) * gg * (sc + 1.0f) + sh;
                u32x2 w = {cvt_pk_bf16(o[0], o[1]), cvt_pk_bf16(o[2], o[3])};
                *(u32x2*)(h2 + (size_t)row * DM + k) = w;
            }
        }
    }
}

__device__ __forceinline__ void phase_mix(const int TID, const int BID, unsigned char* shm, bf16_t* P, const bf16_t* GVT, const float* stats, const bf16_t* ws16, const float* b_s, const float* ln_g, const float* ln_b, const bool ident) {
    constexpr int LD = 136;
    bf16_t* VTl = (bf16_t*)shm;
    bf16_t* WsL = (bf16_t*)(shm + 256 * LD * 2);
    float* st = (float*)(shm + 256 * LD * 2 + 128 * LD * 2);
    const int tid = TID, lane = tid & 63, wid = tid >> 6, l15 = lane & 15, l4 = lane >> 4;
    for (int chunk = BID; chunk < T / 128; chunk += gridDim.x) {
        const int t0 = chunk * 128;
        __syncthreads();
        if (tid < 128) {
            const f32x4* sp = (const f32x4*)(stats + (size_t)(t0 + tid) * 64);
            float s = 0.f, ss = 0.f;
#pragma unroll
            for (int i = 0; i < 16; ++i) { const f32x4 v = sp[i]; s += v[0] + v[2]; ss += v[1] + v[3]; }
            const float mean = s * (1.0f / 4096.0f);
            const float var = ss * (1.0f / 4096.0f) - mean * mean;
            st[2 * tid] = mean; st[2 * tid + 1] = rsqrtf(fmaxf(var, 0.f) + EPS);
        }
        __syncthreads();
        for (int g = 0; g < 16; ++g) {
#pragma unroll
            for (int i = 0; i < 4; ++i) {
                const int id = tid + 512 * i, t = id >> 4, s8 = (id & 15) * 8;
                *(u32x4*)(WsL + t * LD + s8) = *(const u32x4*)(ws16 + ((size_t)g * 128 + t) * 128 + s8);
            }
#pragma unroll
            for (int i = 0; i < 8; ++i) {
                const int id = tid + 512 * i, c = id >> 4, s8 = (id & 15) * 8;
                const u32x4 raw = *(const u32x4*)(GVT + (size_t)(g * 256 + c) * T + t0 + s8);
                const float gg = ln_g[g * 256 + c], bb = ln_b[g * 256 + c];
                float r[8];
#pragma unroll
                for (int q = 0; q < 4; ++q) { r[2 * q] = bflo(raw[q]); r[2 * q + 1] = bfhi(raw[q]); }
#pragma unroll
                for (int q = 0; q < 4; ++q) {
                    const f32x4 mr = *(const f32x4*)(st + 2 * (s8 + 2 * q));
                    r[2 * q] = (r[2 * q] - mr[0]) * mr[1] * gg + bb;
                    r[2 * q + 1] = (r[2 * q + 1] - mr[2]) * mr[3] * gg + bb;
                }
                *(u32x4*)(VTl + c * LD + s8) = pack8f(r);
            }
            __syncthreads();
            f32x4 acc[2][8];
#pragma unroll
            for (int cb = 0; cb < 2; ++cb)
#pragma unroll
                for (int tb = 0; tb < 8; ++tb) acc[cb][tb] = (f32x4){0.f, 0.f, 0.f, 0.f};
#pragma unroll
            for (int ks = 0; ks < 4; ++ks) {
                bf16x8 vf[2];
#pragma unroll
                for (int cb = 0; cb < 2; ++cb) vf[cb] = *(const bf16x8*)(VTl + (wid * 32 + cb * 16 + l15) * LD + ks * 32 + l4 * 8);
#pragma unroll
                for (int tb = 0; tb < 8; ++tb) {
                    if (tb >= 2 * ks) {
                        const bf16x8 wf = *(const bf16x8*)(WsL + (tb * 16 + l15) * LD + ks * 32 + l4 * 8);
#pragma unroll
                        for (int cb = 0; cb < 2; ++cb) acc[cb][tb] = __builtin_amdgcn_mfma_f32_16x16x32_bf16(vf[cb], wf, acc[cb][tb], 0, 0, 0);
                    }
                }
            }
            __syncthreads();
            {
                bf16_t* OutL = (bf16_t*)shm;
#pragma unroll
                for (int tb = 0; tb < 8; ++tb) {
                    const int t = tb * 16 + l15;
                    const float bs = b_s[g * 128 + t];
#pragma unroll
                    for (int cb = 0; cb < 2; ++cb) {
                        const f32x4 a = acc[cb][tb];
                        u32x2 o = {cvt_pk_bf16(a[0] + bs, a[1] + bs), cvt_pk_bf16(a[2] + bs, a[3] + bs)};
                        *(u32x2*)(OutL + t * 264 + wid * 32 + cb * 16 + l4 * 4) = o;
                    }
                }
                __syncthreads();
#pragma unroll
                for (int i = 0; i < 8; ++i) {
                    const int id = tid + 512 * i, blk = id >> 10, t = (id >> 3) & 127, c8 = (id & 7) * 8;
                    bf16_t* pp = P + ((size_t)(g * 4 + blk) * T + t0 + t) * 64 + c8;
                    const u32x4 pv = *(const u32x4*)pp;
                    const u32x4 mv = *(const u32x4*)(OutL + t * 264 + blk * 64 + c8);
                    u32x4 o;
#pragma unroll
                    for (int q = 0; q < 4; ++q) o[q] = ident ? (pv[q] | (mv[q] & 0u)) : cvt_pk_bf16(bflo(pv[q]) * bflo(mv[q]), bfhi(pv[q]) * bfhi(mv[q]));
                    *(u32x4*)pp = o;
                }
            }
            __syncthreads();
        }
    }
}

__device__ __forceinline__ void phase_kpost(const int TID, const int BID, bf16_t* KN, const float* KRAW, bf16_t* KROPE, const float* g_kn, const float* g_kr, const float* cosT, const float* sinT, const bool ident) {
    const int lane = TID & 63, wid = TID >> 6;
    const int gw = BID * 8 + wid, nw = gridDim.x * 8;
    {
        const int sub = lane >> 4, l16 = lane & 15;
        const f32x4 ga = *(const f32x4*)(g_kn + l16 * 8), gb = *(const f32x4*)(g_kn + l16 * 8 + 4);
        const size_t nrows = (size_t)T * 16;
        for (size_t r0 = (size_t)gw * 4 + sub; r0 < nrows; r0 += (size_t)nw * 16) {
            u32x4 raw[4];
#pragma unroll
            for (int u = 0; u < 4; ++u) { const size_t r = r0 + (size_t)u * nw * 4; if (r < nrows) raw[u] = *(const u32x4*)(KN + r * 128 + l16 * 8); }
#pragma unroll
            for (int u = 0; u < 4; ++u) {
                const size_t r = r0 + (size_t)u * nw * 4;
                float v[8]; float ss = 0.f;
#pragma unroll
                for (int q = 0; q < 4; ++q) { v[2 * q] = bflo(raw[u][q]); v[2 * q + 1] = bfhi(raw[u][q]); ss += v[2 * q] * v[2 * q] + v[2 * q + 1] * v[2 * q + 1]; }
                ss += __shfl_xor(ss, 1); ss += __shfl_xor(ss, 2); ss += __shfl_xor(ss, 4); ss += __shfl_xor(ss, 8);
                const float rs = rsqrtf(ss * (1.0f / 128.0f) + EPS);
#pragma unroll
                for (int e = 0; e < 8; ++e) v[e] = v[e] * rs * (e < 4 ? ga[e & 3] : gb[e & 3]);
                if (r < nrows) *(u32x4*)(KN + r * 128 + l16 * 8) = ident ? raw[u] : pack8f(v);
            }
        }
    }
    {
        const float gk = g_kr[lane];
        for (int t0 = gw; t0 < T; t0 += nw * 4) {
            float xs[4];
#pragma unroll
            for (int u = 0; u < 4; ++u) { const int t = t0 + u * nw; xs[u] = t < T ? KRAW[(size_t)t * 64 + lane] : 0.f; }
#pragma unroll
            for (int u = 0; u < 4; ++u) {
                const int t = t0 + u * nw;
                const float x = xs[u];
                float ss = x * x;
#pragma unroll
                for (int o = 32; o >= 1; o >>= 1) ss += __shfl_xor(ss, o);
                const float y = x * rsqrtf(ss * (1.0f / 64.0f) + EPS) * gk;
                const float other = __shfl_xor(y, 32);
                const int pos = t & (SEQ - 1), i = lane & 31;
                if (t < T) {
                    const float c = cosT[pos * 32 + i], s = sinT[pos * 32 + i];
                    const float o = lane < 32 ? (y * c - other * s) : (y * c + other * s);
                    KROPE[(size_t)t * 64 + lane] = (bf16_t)(cvt_pk_bf16(o, 0.f) & 0xffffu);
                }
            }
        }
    }
}

__device__ __forceinline__ void phase_attn(const int TID, const int BID, unsigned char* shm, const bf16_t* Q, const bf16_t* KN, const bf16_t* KR, const bf16_t* VT, const bf16_t* Zs, bf16_t* Y,
                                           const float* g_qn, const float* g_qr, const float* cosT, const float* sinT) {
    constexpr int KROWB = 400, VROWB = 144, KBYTES = 64 * KROWB, BUFB = KBYTES + 128 * VROWB;
    const int tid = TID, wid = __builtin_amdgcn_readfirstlane(tid >> 6), lane = tid & 63, lq = lane & 31, hi = lane >> 5;
    const int kn_r = tid >> 4, kn_c = tid & 15;
    const int kr_r = tid >> 3, kr_c = tid & 7;
    const int v_r = tid >> 3, v_c = tid & 7;
    const unsigned koff = kn_r * 2048 + kn_c * 8, roff = kr_r * 64 + kr_c * 8, voff = (unsigned)v_r * T + v_c * 8;
    const int kfrag = lq * KROWB + hi * 16;
    const int vfrag = KBYTES + lq * VROWB + hi * 16;
    for (int item = BID; item < 1024; item += gridDim.x) {
        const int bh = item >> 4, pr = item & 15, b = bh >> 4, h = bh & 15;
        const int tokb = b * SEQ;
        for (int half = 0; half < 2; ++half) {
            const int qb = half == 0 ? (31 - pr) : pr;
            const int q0 = qb * 256, nt = 4 * (qb + 1);
            int lqo = lq, hio = hi; asm volatile("" : "+v"(lqo), "+v"(hio));
            const int qrow = q0 + wid * 32 + lq;
            const int qrow_o = q0 + wid * 32 + lqo;
            bf16x8 qf[12];
            {
                const bf16_t* qp = Q + (size_t)(tokb + qrow_o) * 3072 + h * 192 + hio * 8;
#pragma unroll
                for (int ks = 0; ks < 12; ++ks) qf[ks] = *(const bf16x8*)(qp + ks * 16);
                float ssn = 0.f, ssr = 0.f;
#pragma unroll
                for (int ks = 0; ks < 12; ++ks)
#pragma unroll
                    for (int j = 0; j < 8; ++j) { const float v = bf2f((unsigned short)qf[ks][j]); if (ks < 8) ssn += v * v; else ssr += v * v; }
                ssn = x32_sum(ssn); ssr = x32_sum(ssr);
                const float rn = rsqrtf(ssn * (1.0f / 128.0f) + EPS) * QSCALE;
                const float rr = rsqrtf(ssr * (1.0f / 64.0f) + EPS);
#pragma unroll
                for (int ks = 0; ks < 8; ++ks) {
                    const f32x4 ga = *(const f32x4*)(g_qn + ks * 16 + hio * 8), gb = *(const f32x4*)(g_qn + ks * 16 + hio * 8 + 4);
                    float r[8];
#pragma unroll
                    for (int j = 0; j < 8; ++j) r[j] = bf2f((unsigned short)qf[ks][j]) * rn * (j < 4 ? ga[j & 3] : gb[j & 3]);
                    const u32x4 o = pack8f(r);
                    qf[ks] = *(const bf16x8*)&o;
                }
#pragma unroll
                for (int kk = 0; kk < 2; ++kk) {
                    const int i0 = 16 * kk + 8 * hio;
                    float r1[8], r2[8];
#pragma unroll
                    for (int j = 0; j < 8; ++j) {
                        const float x1 = bf2f((unsigned short)qf[8 + kk][j]) * rr * g_qr[i0 + j];
                        const float x2 = bf2f((unsigned short)qf[10 + kk][j]) * rr * g_qr[32 + i0 + j];
                        const float c = cosT[qrow_o * 32 + i0 + j], s = sinT[qrow_o * 32 + i0 + j];
                        r1[j] = (x1 * c - x2 * s) * QSCALE; r2[j] = (x2 * c + x1 * s) * QSCALE;
                    }
                    const u32x4 o1 = pack8f(r1), o2 = pack8f(r2);
                    qf[8 + kk] = *(const bf16x8*)&o1; qf[10 + kk] = *(const bf16x8*)&o2;
                }
            }
            f32x16 O[4];
#pragma unroll
            for (int d = 0; d < 4; ++d)
#pragma unroll
                for (int r = 0; r < 16; ++r) O[d][r] = 0.f;
            float m_run = 0.f, l_run = 0.f; bool mz = true;
            u32x4 st0, st1, st2, st3, st4;
#define ATT_ISSUE_K(t_) do { const size_t tok0 = (size_t)tokb + (size_t)(t_) * 64; \
                const bf16_t* knb = uniform_ptr(KN + tok0 * 2048 + h * 128); const bf16_t* krb = uniform_ptr(KR + tok0 * 64); \
                st0 = *(const u32x4*)(knb + koff); \
                st1 = *(const u32x4*)(knb + koff + 32 * 2048); \
                st2 = *(const u32x4*)(krb + roff); } while (0)
#define ATT_ISSUE_V(t_) do { const size_t tok0 = (size_t)tokb + (size_t)(t_) * 64; \
                const bf16_t* vtb = uniform_ptr(VT + (size_t)(h * 128) * T + tok0); \
                st3 = *(const u32x4*)(vtb + voff); \
                st4 = *(const u32x4*)(vtb + voff + 64 * T); } while (0)
#define ATT_WRITE(buf_) do { unsigned char* bp = shm + (buf_) * BUFB; \
                *(u32x4*)(bp + kn_r * KROWB + kn_c * 16) = st0; \
                *(u32x4*)(bp + (kn_r + 32) * KROWB + kn_c * 16) = st1; \
                *(u32x4*)(bp + kr_r * KROWB + 256 + kr_c * 16) = st2; \
                *(u32x4*)(bp + KBYTES + v_r * VROWB + v_c * 16) = st3; \
                *(u32x4*)(bp + KBYTES + (v_r + 64) * VROWB + v_c * 16) = st4; } while (0)
            __syncthreads();
            ATT_ISSUE_K(0); ATT_ISSUE_V(0);
            ATT_WRITE(0);
            __syncthreads();
            for (int t = 0; t < nt; ++t) {
                const bool has_next = (t + 1 < nt);
                if (has_next) ATT_ISSUE_K(t + 1);
                const int rel = t - (nt - 4);
                const bool active = rel <= (wid >> 1);
                const unsigned char* bp = shm + (t & 1) * BUFB;
                bf16x8 pf[4];
                if (active) {
                    f32x16 S0, S1;
#pragma unroll
                    for (int r = 0; r < 16; ++r) { S0[r] = 0.f; S1[r] = 0.f; }
#define SB_() __builtin_amdgcn_sched_barrier(0)
#define LDK_(dst, ks) do { dst[0] = *(const bf16x8*)(bp + kfrag + (ks) * 32); dst[1] = *(const bf16x8*)(bp + kfrag + 12800 + (ks) * 32); \
                        dst[2] = *(const bf16x8*)(bp + kfrag + ((ks) + 1) * 32); dst[3] = *(const bf16x8*)(bp + kfrag + 12800 + ((ks) + 1) * 32); } while (0)
#define MMK_(s_, ks) do { S0 = __builtin_amdgcn_mfma_f32_32x32x16_bf16(s_[0], qf[ks], S0, 0, 0, 0); S1 = __builtin_amdgcn_mfma_f32_32x32x16_bf16(s_[1], qf[ks], S1, 0, 0, 0); \
                        S0 = __builtin_amdgcn_mfma_f32_32x32x16_bf16(s_[2], qf[(ks) + 1], S0, 0, 0, 0); S1 = __builtin_amdgcn_mfma_f32_32x32x16_bf16(s_[3], qf[(ks) + 1], S1, 0, 0, 0); } while (0)
                    {
                        bf16x8 fa[4], fb[4];
                        LDK_(fa, 0); SB_();
                        LDK_(fb, 2); MMK_(fa, 0); SB_();
                        LDK_(fa, 4); MMK_(fb, 2); SB_();
                        LDK_(fb, 6); MMK_(fa, 4); SB_();
                        LDK_(fa, 8); MMK_(fb, 6); SB_();
                        LDK_(fb, 10); MMK_(fa, 8); SB_();
                        MMK_(fb, 10); SB_();
                    }
                    if (rel >= 0) {
                        const int dq = qrow - t * 64 - 4 * hi;
#pragma unroll
                        for (int r = 0; r < 16; ++r) {
                            const int c = (r & 3) + 8 * (r >> 2);
                            if (c > dq) S0[r] = -__builtin_inff();
                            if (c + 32 > dq) S1[r] = -__builtin_inff();
                        }
                    }
                    float mx = fmaxf(S0[0], S1[0]);
#pragma unroll
                    for (int r = 1; r < 16; ++r) mx = fmaxf(mx, fmaxf(S0[r], S1[r]));
                    mx = x32_max(mx);
                    const bool viol = (mx > 12.0f) || (t == 0 && mx < -64.0f);
                    const bool fast = mz && (__builtin_amdgcn_ballot_w64(viol) == 0ull);
                    if (!fast) {
                        mz = false;
                        const float mn = (t == 0) ? mx : fmaxf(m_run, mx);
                        const float alpha = (t == 0) ? 1.0f : __builtin_amdgcn_exp2f(m_run - mn);
                        m_run = mn;
                        l_run *= alpha;
#pragma unroll
                        for (int r = 0; r < 16; ++r) { S0[r] -= mn; S1[r] -= mn; }
#pragma unroll
                        for (int d = 0; d < 4; ++d)
#pragma unroll
                            for (int r = 0; r < 16; ++r) O[d][r] *= alpha;
                    }
                    float ps = 0.f, ps2 = 0.f;
#pragma unroll
                    for (int r = 0; r < 16; ++r) { S0[r] = __builtin_amdgcn_exp2f(S0[r]); S1[r] = __builtin_amdgcn_exp2f(S1[r]); ps += S0[r]; ps2 += S1[r]; }
                    l_run += ps + ps2;
                    {
                        u32x4 a = {cvt_pk_bf16(S0[0], S0[1]), cvt_pk_bf16(S0[2], S0[3]), cvt_pk_bf16(S0[4], S0[5]), cvt_pk_bf16(S0[6], S0[7])};
                        u32x4 bq = {cvt_pk_bf16(S0[8], S0[9]), cvt_pk_bf16(S0[10], S0[11]), cvt_pk_bf16(S0[12], S0[13]), cvt_pk_bf16(S0[14], S0[15])};
                        u32x4 c = {cvt_pk_bf16(S1[0], S1[1]), cvt_pk_bf16(S1[2], S1[3]), cvt_pk_bf16(S1[4], S1[5]), cvt_pk_bf16(S1[6], S1[7])};
                        u32x4 d = {cvt_pk_bf16(S1[8], S1[9]), cvt_pk_bf16(S1[10], S1[11]), cvt_pk_bf16(S1[12], S1[13]), cvt_pk_bf16(S1[14], S1[15])};
                        pf[0] = *(const bf16x8*)&a; pf[1] = *(const bf16x8*)&bq; pf[2] = *(const bf16x8*)&c; pf[3] = *(const bf16x8*)&d;
                    }
                }
                if (has_next) ATT_ISSUE_V(t + 1);
                if (active) {
#define LDV_(dst, dp, kp) do { dst[0] = *(const bf16x8*)(bp + vfrag + (2 * (dp)) * 4608 + (2 * (kp)) * 32); dst[1] = *(const bf16x8*)(bp + vfrag + (2 * (dp) + 1) * 4608 + (2 * (kp)) * 32); \
                        dst[2] = *(const bf16x8*)(bp + vfrag + (2 * (dp)) * 4608 + (2 * (kp) + 1) * 32); dst[3] = *(const bf16x8*)(bp + vfrag + (2 * (dp) + 1) * 4608 + (2 * (kp) + 1) * 32); } while (0)
#define MMV_(s_, dp, kp) do { O[2 * (dp)] = __builtin_amdgcn_mfma_f32_32x32x16_bf16(s_[0], pf[2 * (kp)], O[2 * (dp)], 0, 0, 0); O[2 * (dp) + 1] = __builtin_amdgcn_mfma_f32_32x32x16_bf16(s_[1], pf[2 * (kp)], O[2 * (dp) + 1], 0, 0, 0); \
                        O[2 * (dp)] = __builtin_amdgcn_mfma_f32_32x32x16_bf16(s_[2], pf[2 * (kp) + 1], O[2 * (dp)], 0, 0, 0); O[2 * (dp) + 1] = __builtin_amdgcn_mfma_f32_32x32x16_bf16(s_[3], pf[2 * (kp) + 1], O[2 * (dp) + 1], 0, 0, 0); } while (0)
                    {
                        bf16x8 fa[4], fb[4];
                        SB_();
                        LDV_(fa, 0, 0); SB_();
                        LDV_(fb, 0, 1); MMV_(fa, 0, 0); SB_();
                        LDV_(fa, 1, 0); MMV_(fb, 0, 1); SB_();
                        LDV_(fb, 1, 1); MMV_(fa, 1, 0); SB_();
                        MMV_(fb, 1, 1); SB_();
                    }
                }
                if (has_next) ATT_WRITE((t + 1) & 1);
                __syncthreads();
            }
#undef SB_
#undef LDK_
#undef MMK_
#undef LDV_
#undef MMV_
#undef ATT_ISSUE_K
#undef ATT_ISSUE_V
#undef ATT_WRITE
            const float lt = x32_sum(l_run);
            const float inv = 1.0f / lt;
            int lqe = lq, hie = hi; asm volatile("" : "+v"(lqe), "+v"(hie));
            const size_t yoff = (size_t)(tokb + q0 + wid * 32 + lqe) * 2048 + h * 128 + 4 * hie;
            const bf16_t* zp = Zs + yoff; bf16_t* yp = Y + yoff;
#pragma unroll
            for (int db = 0; db < 4; ++db)
#pragma unroll
                for (int g4 = 0; g4 < 4; ++g4) {
                    bf16_t* pp = yp + db * 32 + g4 * 8;
                    const u32x2 zv = *(const u32x2*)(zp + db * 32 + g4 * 8);
                    u32x2 o = {cvt_pk_bf16(O[db][4 * g4 + 0] * inv * bflo(zv[0]), O[db][4 * g4 + 1] * inv * bfhi(zv[0])),
                               cvt_pk_bf16(O[db][4 * g4 + 2] * inv * bflo(zv[1]), O[db][4 * g4 + 3] * inv * bfhi(zv[1]))};
                    *(u32x2*)pp = o;
                }
        }
    }
}

enum { PH_PREP = 0, PH_NORM_A0, PH_AIN0, PH_MIX0, PH_AOUT0, PH_NORM_A1, PH_AIN1, PH_MIX1, PH_AOUT1, PH_NORM_KV, PH_DKV_BIN0, PH_UKV_UQ0, PH_KPOST, PH_ATTN0, PH_BOUT0,
       PH_NORM_B1, PH_BIN1, PH_UQ1, PH_ATTN1, PH_BOUT1, NPH };
#if REP_GEMM == 2
#define RG_(x) x, x,
#else
#define RG_(x) x,
#endif
#if REP_AIN == 2
#define RI_(x) x, x,
#else
#define RI_(x) x,
#endif
#if REP_MIX == 2
#define RM_(x) x, (x) | 0x80,
#else
#define RM_(x) x,
#endif
#if REP_ATTN == 2
#define RA_(x) x, x,
#else
#define RA_(x) x,
#endif
#if REP_LIGHT == 2
#define RL_(x) x, x,
#else
#define RL_(x) x,
#endif
__device__ const unsigned char g_seq[] = { RL_(PH_PREP) RL_(PH_NORM_A0) RI_(PH_AIN0) RM_(PH_MIX0) RG_(PH_AOUT0) RL_(PH_NORM_A1) RI_(PH_AIN1) RM_(PH_MIX1) PH_AOUT1, RL_(PH_NORM_KV) RG_(PH_DKV_BIN0) RG_(PH_UKV_UQ0)
                                           RM_(PH_KPOST) RA_(PH_ATTN0) PH_BOUT0, RL_(PH_NORM_B1) RG_(PH_BIN1) RG_(PH_UQ1) RA_(PH_ATTN1) PH_BOUT1 };
constexpr int NSEQ = (int)sizeof(g_seq);

__global__ void __launch_bounds__(512, 2) mega(Params p) {
    extern __shared__ __attribute__((aligned(16))) unsigned char shm[];
    LAS unsigned char* lds = (LAS unsigned char*)shm;
    for (int pi = p.ph_lo; pi < p.ph_hi; ++pi) {
        const int phv = g_seq[pi]; const int ph = phv & 0x7f; const bool ident = (phv & 0x80) != 0;
        int TID = threadIdx.x, BID = blockIdx.x; unsigned char* ws = p.ws;
        asm volatile("" : "+v"(TID), "+s"(BID));
        const float* mod = (const float*)(ws + WS_MOD);
        const float* kvmod = (const float*)(ws + WS_KVMOD);
        const float* cosT = (const float*)(ws + WS_COS);
        const float* sinT = (const float*)(ws + WS_SIN);
        switch (ph) {
#if PHSEL & 1
        case PH_PREP: phase_prep(TID, BID, p, ws, shm); break;
#endif
#if PHSEL & 2
        case PH_NORM_A0: case PH_NORM_A1: case PH_NORM_B1: {
            const int l = ph == PH_NORM_A0 ? 0 : (ph == PH_NORM_A1 ? 1 : 3);
            const float* x = l == 0 ? p.in[I_X] : p.out;
            const float* m = mod + (size_t)l * 4 * 6144;
            phase_norm(TID, BID, x, p.in[I_NORM_G] + l * DM, m, m + 2048, 6144, (bf16_t*)(ws + WA_H), nullptr, nullptr, nullptr, 0, nullptr);
        } break;
#endif
#if PHSEL & 4
        case PH_NORM_KV: {
            const float* m = mod + (size_t)2 * 4 * 6144;
            phase_norm(TID, BID, p.out, p.in[I_NORM_G] + 2 * DM, m, m + 2048, 6144, (bf16_t*)(ws + WB_H), p.in[I_KV_NORM_G], kvmod, kvmod + 2048, 4096, (bf16_t*)(ws + WB_HKV));
        } break;
#endif
#if PHSEL & 8
        case PH_AIN0: case PH_AIN1: {
            const int l = ph == PH_AIN0 ? 0 : 1;
            const bf16_t* W = (const bf16_t*)(ws + WS_WINA) + (size_t)l * 12288 * 2048;
            EpiUZ E{(bf16_t*)(ws + WA_P)};
            run_gemm(TID, BID, lds, (const bf16_t*)(ws + WA_H), W, T, 8192, 2048, E);
            EpiGVT E2{(bf16_t*)(ws + WA_GVT), (float*)(ws + WA_STATS)};
            run_gemm(TID, BID, lds, W + (size_t)8192 * 2048, (const bf16_t*)(ws + WA_H), 4096, T, 2048, E2);
        } break;
#endif
#if PHSEL & 16
        case PH_MIX0: case PH_MIX1: {
            const int l = ph == PH_MIX0 ? 0 : 1;
            phase_mix(TID, BID, shm, (bf16_t*)(ws + WA_P), (const bf16_t*)(ws + WA_GVT), (const float*)(ws + WA_STATS), (const bf16_t*)(ws + WS_WS16) + (size_t)l * 16 * 128 * 128, p.in[I_A_B_S] + l * 16 * 128,
                      p.in[I_A_LN_G] + l * GMW, p.in[I_A_LN_B] + l * GMW, ident);
        } break;
#endif
#if PHSEL & 32
        case PH_AOUT0: case PH_AOUT1: case PH_BOUT0: case PH_BOUT1: {
            const int l = ph == PH_AOUT0 ? 0 : (ph == PH_AOUT1 ? 1 : (ph == PH_BOUT0 ? 2 : 3));
            const float* xin = l == 0 ? p.in[I_X] : p.out;
            EpiRes E{xin, p.out, mod + (size_t)l * 4 * 6144 + 4096, 6144};
            const bf16_t* A = l < 2 ? (const bf16_t*)(ws + WA_P) : (const bf16_t*)(ws + WB_Y);
            const bf16_t* Bt = l < 2 ? (const bf16_t*)(ws + WS_WOUTA) + (size_t)l * 2048 * 4096 : (const bf16_t*)(ws + WS_WOUTB) + (size_t)(l - 2) * 2048 * 2048;
            run_gemm(TID, BID, lds, A, Bt, T, 2048, l < 2 ? 4096 : 2048, E, l < 2);
        } break;
#endif
#if PHSEL & 64
        case PH_DKV_BIN0: case PH_BIN1: {
            if (ph == PH_DKV_BIN0) {
                EpiLat<0> E{(bf16_t*)(ws + WB_CKV), (float*)(ws + WB_SSQKV), (float*)(ws + WB_KRAW), nullptr};
                run_gemm(TID, BID, lds, (const bf16_t*)(ws + WB_HKV), (const bf16_t*)(ws + WS_WDKV), T, 768, 2048, E);
            }
            const int j = ph == PH_DKV_BIN0 ? 0 : 1;
            EpiLat<1> E{(bf16_t*)(ws + WB_CQ), (float*)(ws + WB_SSQQ), nullptr, (bf16_t*)(ws + WB_Z)};
            run_gemm(TID, BID, lds, (const bf16_t*)(ws + WB_H), (const bf16_t*)(ws + WS_WINB) + (size_t)j * 2560 * 2048, T, 2560, 2048, E);
        } break;
#endif
#if PHSEL & 128
        case PH_UKV_UQ0: case PH_UQ1: {
            if (ph == PH_UKV_UQ0) {
                EpiScaled E{(bf16_t*)(ws + WB_KN), 2048, (const float*)(ws + WB_SSQKV)};
                run_gemm(TID, BID, lds, (const bf16_t*)(ws + WB_CKV), (const bf16_t*)(ws + WS_WKN), T, 2048, 512, E);
                EpiVT E2{(bf16_t*)(ws + WB_VT), (const float*)(ws + WB_SSQKV)};
                run_gemm(TID, BID, lds, (const bf16_t*)(ws + WS_WV), (const bf16_t*)(ws + WB_CKV), 2048, T, 512, E2);
            }
            const int j = ph == PH_UKV_UQ0 ? 0 : 1;
            EpiScaled E{(bf16_t*)(ws + WB_Q), 3072, (const float*)(ws + WB_SSQQ)};
            run_gemm(TID, BID, lds, (const bf16_t*)(ws + WB_CQ), (const bf16_t*)(ws + WS_WUQ) + (size_t)j * 3072 * 512, T, 3072, 512, E);
        } break;
#endif
#if PHSEL & 256
        case PH_KPOST:
            phase_kpost(TID, BID, (bf16_t*)(ws + WB_KN), (const float*)(ws + WB_KRAW), (bf16_t*)(ws + WB_KROPE), p.in[I_KV_G_KN], p.in[I_KV_G_KR], cosT, sinT, ident);
            break;
#endif
#if PHSEL & 512
        case PH_ATTN0: case PH_ATTN1: {
            const int j = ph == PH_ATTN0 ? 0 : 1;
            phase_attn(TID, BID, shm, (const bf16_t*)(ws + WB_Q), (const bf16_t*)(ws + WB_KN), (const bf16_t*)(ws + WB_KROPE), (const bf16_t*)(ws + WB_VT), (const bf16_t*)(ws + WB_Z), (bf16_t*)(ws + WB_Y),
                       p.in[I_B_G_QN] + j * 128, p.in[I_B_G_QR] + j * 64, cosT, sinT);
        } break;
#endif
        default: break;
        }
        if (pi + 1 < p.ph_hi) {
            if (pi == p.ph_lo) cg::this_grid().sync();
            else grid_bar((unsigned*)(p.ws + WS_BAR), (unsigned)(pi - p.ph_lo), TID, BID);
        }
    }
}

extern "C" void kernel_launch(void* const* d_in, const int* in_sizes, int n_in, void* d_out, int out_size, void* d_ws, size_t ws_size, hipStream_t stream) {
    static int grid = 0;
    if (grid == 0) {
        if (n_in != 25 || ws_size < WS_NEED) { fprintf(stderr, "kernel_launch: unexpected n_in %d / ws %zu (need %zu)\n", n_in, ws_size, (size_t)WS_NEED); grid = -1; return; }
        int dev = 0, cus = 0, per_cu = 0;
        hipGetDevice(&dev);
        hipDeviceGetAttribute(&cus, hipDeviceAttributeMultiprocessorCount, dev);
        if (hipFuncSetAttribute((const void*)mega, hipFuncAttributeMaxDynamicSharedMemorySize, LDS_BYTES) != hipSuccess) { fprintf(stderr, "kernel_launch: hipFuncSetAttribute failed\n"); grid = -1; return; }
        if (hipOccupancyMaxActiveBlocksPerMultiprocessor(&per_cu, (const void*)mega, 512, LDS_BYTES) != hipSuccess || per_cu < 1) { fprintf(stderr, "kernel_launch: occupancy query gave %d\n", per_cu); per_cu = 1; }
        (void)hipGetLastError();
        grid = cus * per_cu;
    }
    if (grid < 0) return;
    Params p{};
    for (int i = 0; i < 25; ++i) p.in[i] = (const float*)d_in[i];
    p.out = (float*)d_out; p.ws = (unsigned char*)d_ws;
#if MK_SINGLE
    p.ph_lo = 0; p.ph_hi = NSEQ;
    if (hipMemsetAsync((char*)d_ws + WS_BAR, 0, 4096, stream) != hipSuccess) { fprintf(stderr, "kernel_launch: memset of the barrier words failed\n"); return; }
    void* args[] = {&p};
    hipError_t e = hipLaunchCooperativeKernel((const void*)mega, dim3(grid), dim3(512), args, LDS_BYTES, stream);
    if (e != hipSuccess) fprintf(stderr, "cooperative launch failed: %s (grid %d)\n", hipGetErrorString(e), grid);
#else
    for (int ph = 0; ph < NSEQ; ++ph) {
        p.ph_lo = ph; p.ph_hi = ph + 1;
        hipLaunchKernelGGL(mega, dim3(grid), dim3(512), LDS_BYTES, stream, p);
    }
#endif
}
```

```cpp
#include <hip/hip_runtime.h>
#include <hip/hip_cooperative_groups.h>
#include <cstdio>
#include <cstdint>
namespace cg = cooperative_groups;

#ifndef PHSEL
#define PHSEL 0xFFFF
#endif
#ifndef REP_ATTN
#define REP_ATTN 1
#endif
#ifndef REP_MIX
#define REP_MIX 1
#endif
#ifndef REP_AIN
#define REP_AIN 1
#endif
#ifndef REP_GEMM
#define REP_GEMM 1
#endif
#ifndef REP_LIGHT
#define REP_LIGHT 1
#endif
#ifndef MK_SINGLE
#define MK_SINGLE 1
#endif

typedef unsigned short bf16_t;
typedef short bf16x8 __attribute__((ext_vector_type(8)));
typedef float f32x2 __attribute__((ext_vector_type(2)));
typedef float f32x4 __attribute__((ext_vector_type(4)));
typedef float f32x16 __attribute__((ext_vector_type(16)));
typedef unsigned u32x4 __attribute__((ext_vector_type(4)));
typedef unsigned u32x2 __attribute__((ext_vector_type(2)));
#define LAS __attribute__((address_space(3)))
#define GAS __attribute__((address_space(1)))

constexpr int T = 32768, DM = 2048, SEQ = 8192, NBATCH = 4;
constexpr int GMW = 4096;
constexpr float EPS = 1e-6f;
constexpr float QSCALE = 0.07216878364870322f * 1.4426950408889634f;

constexpr size_t WS_BAR = 0;
constexpr size_t WS_MOD = 4096;
constexpr size_t WS_KVMOD = WS_MOD + 4ull * 4 * 6144 * 4;
constexpr size_t WS_COS = WS_KVMOD + 4ull * 4096 * 4;
constexpr size_t WS_SIN = WS_COS + 8192ull * 32 * 4;
constexpr size_t WS_WINA = WS_SIN + 8192ull * 32 * 4;
constexpr size_t WS_WOUTA = WS_WINA + 2ull * 12288 * 2048 * 2;
constexpr size_t WS_WDKV = WS_WOUTA + 2ull * 2048 * 4096 * 2;
constexpr size_t WS_WKN = WS_WDKV + 768ull * 2048 * 2;
constexpr size_t WS_WV = WS_WKN + 2048ull * 512 * 2;
constexpr size_t WS_WINB = WS_WV + 2048ull * 512 * 2;
constexpr size_t WS_WUQ = WS_WINB + 2ull * 2560 * 2048 * 2;
constexpr size_t WS_WOUTB = WS_WUQ + 2ull * 3072 * 512 * 2;
constexpr size_t WS_WS16 = WS_WOUTB + 2ull * 2048 * 2048 * 2;
constexpr size_t WS_ACT = WS_WS16 + 2ull * 16 * 128 * 128 * 2;
constexpr size_t WA_H = WS_ACT;
constexpr size_t WA_P = WA_H + (size_t)T * 2048 * 2;
constexpr size_t WA_GVT = WA_P + (size_t)T * 4096 * 2;
constexpr size_t WA_STATS = WA_GVT + (size_t)T * 4096 * 2;
constexpr size_t WA_END = WA_STATS + (size_t)T * 32 * 2 * 4;
constexpr size_t WB_H = WS_ACT;
constexpr size_t WB_HKV = WB_H + (size_t)T * 2048 * 2;
constexpr size_t WB_Q = WS_ACT;
constexpr size_t WB_CKV = WB_HKV + (size_t)T * 2048 * 2;
constexpr size_t WB_CQ = WB_CKV + (size_t)T * 512 * 2;
constexpr size_t WB_KRAW = WB_CQ + (size_t)T * 512 * 2;
constexpr size_t WB_KROPE = WB_KRAW + (size_t)T * 64 * 4;
constexpr size_t WB_SSQKV = WB_KROPE + (size_t)T * 64 * 2;
constexpr size_t WB_SSQQ = WB_SSQKV + (size_t)T * 8 * 4;
constexpr size_t WB_Z = WB_SSQQ + (size_t)T * 8 * 4;
constexpr size_t WB_KN = WB_Z + (size_t)T * 2048 * 2;
constexpr size_t WB_VT = WB_KN + (size_t)T * 2048 * 2;
constexpr size_t WB_END = WB_VT + (size_t)T * 2048 * 2;
constexpr size_t WB_Y = WB_Q + (size_t)T * 3072 * 2;
static_assert(WB_Y + (size_t)T * 2048 * 2 == WB_KRAW, "Y overlay");
constexpr size_t WS_NEED = WA_END > WB_END ? WA_END : WB_END;
static_assert(WS_NEED <= (1ull << 30), "workspace");

constexpr int LDS_BYTES = 131072;

__device__ __forceinline__ unsigned cvt_pk_bf16(float lo, float hi) { unsigned r; asm volatile("v_cvt_pk_bf16_f32 %0, %1, %2" : "=v"(r) : "v"(lo), "v"(hi)); return r; }
__device__ __forceinline__ float bf2f(unsigned short v) { return __uint_as_float(((unsigned)v) << 16); }
__device__ __forceinline__ float bflo(unsigned w) { return __uint_as_float(w << 16); }
__device__ __forceinline__ float bfhi(unsigned w) { return __uint_as_float(w & 0xffff0000u); }
__device__ __forceinline__ float gelu_f(float x) {
    const float u = x * (1.0f + 0.044715f * x * x);
    const float e = __builtin_amdgcn_exp2f(-2.302208198f * u);
    return x * __builtin_amdgcn_rcpf(1.0f + e);
}
__device__ __forceinline__ float silu_f(float x) { const float e = __builtin_amdgcn_exp2f(-1.4426950408889634f * x); return x * __builtin_amdgcn_rcpf(1.0f + e); }
__device__ __forceinline__ u32x4 pack8f(const float* r) { u32x4 o = {cvt_pk_bf16(r[0], r[1]), cvt_pk_bf16(r[2], r[3]), cvt_pk_bf16(r[4], r[5]), cvt_pk_bf16(r[6], r[7])}; return o; }

template <class Tp> __device__ __forceinline__ Tp* uniform_ptr(Tp* p) {
    const unsigned long long v = (unsigned long long)p; const unsigned lo = __builtin_amdgcn_readfirstlane((unsigned)v), hi = __builtin_amdgcn_readfirstlane((unsigned)(v >> 32));
    return (Tp*)(GAS Tp*)(((unsigned long long)hi << 32) | lo);
}
__device__ __forceinline__ float x32_sum(float v) { auto rr = __builtin_amdgcn_permlane32_swap(__float_as_uint(v), __float_as_uint(v), false, false); return __uint_as_float(rr[0]) + __uint_as_float(rr[1]); }
__device__ __forceinline__ float x32_max(float v) { auto rr = __builtin_amdgcn_permlane32_swap(__float_as_uint(v), __float_as_uint(v), false, false); return fmaxf(__uint_as_float(rr[0]), __uint_as_float(rr[1])); }

__device__ __forceinline__ void grid_bar(unsigned* bar, const unsigned epoch, const int TID, const int BID) {
    __syncthreads();
    if (TID == 0) {
        const unsigned G = gridDim.x, g = (unsigned)BID & 7u;
        const unsigned cnt = (G + 7u - g) >> 3;
        const unsigned ngrp = G < 8u ? G : 8u;
        __builtin_amdgcn_fence(__ATOMIC_RELEASE, "agent");
        const unsigned old = __hip_atomic_fetch_add(bar + 64 * (1 + g), 1u, __ATOMIC_RELAXED, __HIP_MEMORY_SCOPE_AGENT);
        if (old + 1u == cnt * epoch) {
            __builtin_amdgcn_fence(__ATOMIC_ACQ_REL, "agent");
            __hip_atomic_fetch_add(bar, 1u, __ATOMIC_RELAXED, __HIP_MEMORY_SCOPE_AGENT);
        }
        while (__hip_atomic_load(bar, __ATOMIC_RELAXED, __HIP_MEMORY_SCOPE_AGENT) < ngrp * epoch) __builtin_amdgcn_s_sleep(1);
        __builtin_amdgcn_fence(__ATOMIC_ACQUIRE, "agent");
    }
    __syncthreads();
}

namespace pg8 {
constexpr int BM = 256, BK = 64, HALF = 128, HTB = HALF * BK * 2, STAGE_BYTES = 8 * HTB, NXCD = 8, WGM = 8;
__host__ __device__ __forceinline__ int lds_byte(int r, int c) { const int st = (r >> 4) * 2 + (c >> 5), rr = r & 15, cc = c & 31, ob = rr * 64 + cc * 2; return st * 1024 + (ob ^ (((ob >> 9) & 1) << 5)); }
__host__ __device__ __forceinline__ void stage_rc(int b, int& R, int& C) { const int st = b / 1024, sb = b % 1024, swz = sb ^ (((sb >> 9) & 1) << 5); R = (st >> 1) * 16 + swz / 64; C = (st & 1) * 32 + (swz % 64) / 2; }
__host__ __device__ __forceinline__ int perm32(int rho) { const int n = rho >> 4, i = rho & 15; return 8 * (i >> 2) + 4 * n + (i & 3); }
struct Unit { int pm, pn; };
struct Gemm { const bf16_t* A; const bf16_t* Bt; int M, N, K; int a_rs; size_t a_kstep; };
struct StaticOrder {
    int nM, nN, nwg, G, c, wgm;
    __host__ __device__ void init(int M, int N, int G_, int c_, int wgm_) { nM = M / BM; nN = N / BM; nwg = nM * nN; G = G_; c = c_; wgm = wgm_; }
    __host__ __device__ bool next(int i, Unit& u) const {
        const int L = i * G + c; if (L >= nwg) return false;
        int wgid = (int)L; { const int q = nwg / NXCD, r = nwg % NXCD, xcd = wgid % NXCD, off = wgid / NXCD; wgid = (xcd < r ? xcd * (q + 1) : r * (q + 1) + (xcd - r) * q) + off; }
        const int nig = wgm * nN, gid = wgid / nig, fm = gid * wgm, gsz = (nM - fm) < wgm ? (nM - fm) : wgm;
        u.pm = fm + ((wgid % nig) % gsz); u.pn = (wgid % nig) / gsz; return true;
    }
    __device__ __forceinline__ void a_ready(const Unit&) const {}
    __device__ __forceinline__ void done(const Unit&) const {}
};

template <class Epi, class Sched>
__device__ __forceinline__ void gemm_phase(const int TID, LAS unsigned char* lds, const Gemm g, const Sched& S, const Epi& E) {
    const int tid = TID, wid = __builtin_amdgcn_readfirstlane(tid >> 6), lane = tid & 63, wr = wid >> 2, wc = wid & 3, fr = lane & 15, fq = lane >> 4;
    const int K = g.K, nt = K / BK;
    unsigned voffA[2], voffB[2];
#pragma unroll
    for (int i = 0; i < 2; ++i) { int R, C; stage_rc(tid * 16 + i * 8192, R, C); const int Rb = Epi::PERM ? ((R & ~31) + perm32(R & 31)) : R;
        voffA[i] = (unsigned)(R * g.a_rs + C) * 2u; voffB[i] = (unsigned)(Rb * K + C) * 2u; }
    const size_t kstep = (size_t)(BK * 2), kstepA = g.a_kstep;
    const size_t hstep = (size_t)HALF * K * 2, hstepA = (size_t)HALF * g.a_rs * 2;
    const size_t tstep = 2 * hstep, tstepA = 2 * hstepA;
    const unsigned ldsw = (unsigned)wid * 1024u;
    const int aoff = lds_byte(wr * 64 + fr, fq * 8), boff = lds_byte(wc * 32 + fr, fq * 8);
#define PG8_SA(b, h) (((b) * 2 + (h)) * HTB)
#define PG8_SB(b, h) ((4 + (b) * 2 + (h)) * HTB)
#define PG8_STAGE(bufoff, gbase, voff) do { _Pragma("unroll") for (int _i = 0; _i < 2; ++_i) \
        __builtin_amdgcn_global_load_lds((const unsigned*)((const char*)(gbase) + (voff)[_i]), (LAS unsigned*)(lds + (bufoff) + ldsw + _i * 8192), 16, 0, 0); } while (0)
#define PG8_LDA(dst, b, h) do { _Pragma("unroll") for (int m = 0; m < 4; ++m) _Pragma("unroll") for (int k = 0; k < 2; ++k) dst[m][k] = *(const LAS bf16x8*)(lds + PG8_SA(b, h) + aoff + m * 2048 + k * 1024); } while (0)
#define PG8_LDB(dst, b, h) do { _Pragma("unroll") for (int n = 0; n < 2; ++n) _Pragma("unroll") for (int k = 0; k < 2; ++k) dst[n][k] = *(const LAS bf16x8*)(lds + PG8_SB(b, h) + boff + n * 2048 + k * 1024); } while (0)
#define PG8_MMA(ai, bj, At, Bt) do { __builtin_amdgcn_s_setprio(1); _Pragma("unroll") for (int m = 0; m < 4; ++m) _Pragma("unroll") for (int n = 0; n < 2; ++n) _Pragma("unroll") for (int k = 0; k < 2; ++k) \
        acc[ai][bj][m][n] = __builtin_amdgcn_mfma_f32_16x16x32_bf16(Bt[n][k], At[m][k], acc[ai][bj][m][n], 0, 0, 0); __builtin_amdgcn_s_setprio(0); } while (0)
#define PG8_WAIT_V(n) asm volatile("s_waitcnt vmcnt(" #n ")" ::: "memory")
#define PG8_WAIT_L(n) asm volatile("s_waitcnt lgkmcnt(" #n ")" ::: "memory")
#define PG8_BAR __builtin_amdgcn_s_barrier()
#define PG8_SCHED __builtin_amdgcn_sched_barrier(0)
    Unit cur, nxt; int ui = 0;
    if (!S.next(0, cur)) return;
    f32x4 acc[2][2][4][2];
#pragma unroll
    for (int a = 0; a < 2; ++a)
#pragma unroll
        for (int b = 0; b < 2; ++b)
#pragma unroll
            for (int m = 0; m < 4; ++m)
#pragma unroll
                for (int n = 0; n < 2; ++n) acc[a][b][m][n] = (f32x4){0.f, 0.f, 0.f, 0.f};
    bf16x8 At[4][2], B0[2][2], B1[2][2];
    const char* cA = (const char*)g.A + (size_t)cur.pm * tstepA; const char* cB = (const char*)g.Bt + (size_t)cur.pn * tstep;
    S.a_ready(cur);
    PG8_STAGE(PG8_SB(0, 0), cB, voffB); PG8_STAGE(PG8_SA(0, 0), cA, voffA); PG8_STAGE(PG8_SB(0, 1), cB + hstep, voffB); PG8_STAGE(PG8_SA(0, 1), cA + hstepA, voffA);
    if (wr == 1) PG8_BAR;
    PG8_WAIT_V(4); PG8_BAR;
    PG8_STAGE(PG8_SB(1, 0), cB + kstep, voffB); PG8_STAGE(PG8_SA(1, 0), cA + kstepA, voffA); PG8_STAGE(PG8_SB(1, 1), cB + hstep + kstep, voffB);
    PG8_WAIT_V(6); PG8_BAR;
    for (;;) {
        const bool has_next = S.next(ui + 1, nxt);
        const char* nA = has_next ? (const char*)g.A + (size_t)nxt.pm * tstepA : cA; const char* nB = has_next ? (const char*)g.Bt + (size_t)nxt.pn * tstep : cB;
        for (int t = 0; t < nt; t += 2) {
            const bool last = (t == nt - 2);
            const char* a1 = cA + (size_t)(t + 1) * kstepA;
            const char* a2 = last ? nA : cA + (size_t)(t + 2) * kstepA; const char* b2 = last ? nB : cB + (size_t)(t + 2) * kstep;
            const char* a3 = a2 + kstepA; const char* b3 = b2 + kstep;
            if (last && has_next) S.a_ready(nxt);
            PG8_LDB(B0, 0, 0); PG8_SCHED; PG8_LDA(At, 0, 0); PG8_STAGE(PG8_SA(1, 1), a1 + hstepA, voffA);
            PG8_WAIT_L(8); PG8_BAR; PG8_WAIT_L(0); PG8_MMA(0, 0, At, B0); PG8_BAR; PG8_SCHED;
            PG8_LDB(B1, 0, 1); PG8_STAGE(PG8_SB(0, 0), b2, voffB);
            PG8_BAR; PG8_WAIT_L(0); PG8_MMA(0, 1, At, B1); PG8_BAR;
            PG8_LDA(At, 0, 1); PG8_STAGE(PG8_SA(0, 0), a2, voffA);
            PG8_BAR; PG8_WAIT_L(0); PG8_MMA(1, 0, At, B0); PG8_BAR; PG8_SCHED;
            PG8_STAGE(PG8_SB(0, 1), b2 + hstep, voffB);
            PG8_WAIT_V(6); PG8_BAR; PG8_MMA(1, 1, At, B1); PG8_BAR;
            PG8_LDB(B0, 1, 0); PG8_SCHED; PG8_LDA(At, 1, 0); PG8_STAGE(PG8_SA(0, 1), a2 + hstepA, voffA);
            PG8_WAIT_L(8); PG8_BAR; PG8_WAIT_L(0); PG8_MMA(0, 0, At, B0); PG8_BAR; PG8_SCHED;
            PG8_LDB(B1, 1, 1); PG8_STAGE(PG8_SB(1, 0), b3, voffB);
            PG8_BAR; PG8_WAIT_L(0); PG8_MMA(0, 1, At, B1); PG8_BAR;
            PG8_LDA(At, 1, 1); PG8_STAGE(PG8_SA(1, 0), a3, voffA);
            PG8_BAR; PG8_WAIT_L(0); PG8_MMA(1, 0, At, B0); PG8_BAR; PG8_SCHED;
            PG8_STAGE(PG8_SB(1, 1), b3 + hstep, voffB);
            PG8_WAIT_V(6); PG8_BAR; PG8_MMA(1, 1, At, B1); PG8_BAR;
        }
        E(acc, cur, wr, wc, fr, fq);
        if (!has_next) break;
#pragma unroll
        for (int a = 0; a < 2; ++a)
#pragma unroll
            for (int b = 0; b < 2; ++b)
#pragma unroll
                for (int m = 0; m < 4; ++m)
#pragma unroll
                    for (int n = 0; n < 2; ++n) acc[a][b][m][n] = (f32x4){0.f, 0.f, 0.f, 0.f};
        cur = nxt; cA = nA; cB = nB; ++ui;
    }
    PG8_WAIT_V(0);
    if (wr == 0) PG8_BAR;
    PG8_BAR;
#undef PG8_SA
#undef PG8_SB
#undef PG8_STAGE
#undef PG8_LDA
#undef PG8_LDB
#undef PG8_MMA
#undef PG8_WAIT_V
#undef PG8_WAIT_L
#undef PG8_BAR
#undef PG8_SCHED
}
}
using pg8::Unit;

struct EpiUZ {
    static constexpr bool PERM = true;
    bf16_t* P;
    __device__ __forceinline__ void operator()(const f32x4 (&acc)[2][2][4][2], const Unit& u, int wr, int wc, int fr_, int fq_) const {
        int fr = fr_, fq = fq_; asm volatile("" : "+v"(fr), "+v"(fq));
        const int row0 = u.pm * 256 + wr * 64 + fr;
        const int col = u.pn * 128 + wc * 32 + 8 * fq;
#pragma unroll
        for (int ai = 0; ai < 2; ++ai)
#pragma unroll
            for (int m = 0; m < 4; ++m) {
                const size_t row = (size_t)(row0 + ai * 128 + m * 16);
                float r[8];
#pragma unroll
                for (int n = 0; n < 2; ++n)
#pragma unroll
                    for (int i = 0; i < 4; ++i) {
                        const float uu = acc[ai][0][m][n][i], zz = acc[ai][1][m][n][i];
                        const float eu = __builtin_amdgcn_exp2f(-2.302208198f * (uu * (1.0f + 0.044715f * uu * uu)));
                        const float ez = __builtin_amdgcn_exp2f(-1.4426950408889634f * zz);
                        r[4 * n + i] = (uu * zz) * __builtin_amdgcn_rcpf((1.0f + eu) * (1.0f + ez));
                    }
                *(u32x4*)(P + ((size_t)(col >> 6) * T + row) * 64 + (col & 63)) = pack8f(r);
            }
    }
};
struct EpiGVT {
    static constexpr bool PERM = true;
    bf16_t* GVT; float* stats;
    __device__ __forceinline__ void operator()(const f32x4 (&acc)[2][2][4][2], const Unit& u, int wr, int wc, int fr_, int fq_) const {
        int fr = fr_, fq = fq_; asm volatile("" : "+v"(fr), "+v"(fq));
        const int row0 = u.pm * 256 + wr * 64 + fr;
        const int tok0 = u.pn * 256 + wc * 32 + 8 * fq;
        float s[16], ss[16];
#pragma unroll
        for (int j = 0; j < 16; ++j) { s[j] = 0.f; ss[j] = 0.f; }
#pragma unroll
        for (int ai = 0; ai < 2; ++ai)
#pragma unroll
            for (int m = 0; m < 4; ++m) {
                const size_t row = (size_t)(row0 + ai * 128 + m * 16);
#pragma unroll
                for (int bj = 0; bj < 2; ++bj) {
                    float r[8];
#pragma unroll
                    for (int n = 0; n < 2; ++n)
#pragma unroll
                        for (int i = 0; i < 4; ++i) r[4 * n + i] = gelu_f(acc[ai][bj][m][n][i]);
                    const u32x4 o = pack8f(r);
#pragma unroll
                    for (int q = 0; q < 4; ++q) { const float a = bflo(o[q]), b = bfhi(o[q]); s[bj * 8 + 2 * q] += a; ss[bj * 8 + 2 * q] += a * a; s[bj * 8 + 2 * q + 1] += b; ss[bj * 8 + 2 * q + 1] += b * b; }
                    *(u32x4*)(GVT + row * T + tok0 + bj * 128) = o;
                }
            }
#pragma unroll
        for (int step = 0; step < 4; ++step) {
            const int msk = 8 >> step, cnt = 8 >> step;
            const bool up = (fr & msk) != 0;
#pragma unroll
            for (int j = 0; j < 8; ++j) {
                if (j < cnt) {
                    const float send_s = up ? s[j] : s[j + cnt], keep_s = up ? s[j + cnt] : s[j];
                    const float send_q = up ? ss[j] : ss[j + cnt], keep_q = up ? ss[j + cnt] : ss[j];
                    s[j] = keep_s + __shfl_xor(send_s, msk);
                    ss[j] = keep_q + __shfl_xor(send_q, msk);
                }
            }
        }
        {
            const int j = fr;
            const size_t tok = (size_t)(tok0 + 128 * (j >> 3) + (j & 7));
            f32x2 st = {s[0], ss[0]};
            *(f32x2*)(stats + (tok * 32 + u.pm * 2 + wr) * 2) = st;
        }
    }
};
struct EpiRes {
    static constexpr bool PERM = false;
    const float* xin; float* xout; const float* gate;
    int ldg;
    __device__ __forceinline__ void operator()(const f32x4 (&acc)[2][2][4][2], const Unit& u, int wr, int wc, int fr_, int fq_) const {
        int fr = fr_, fq = fq_; asm volatile("" : "+v"(fr), "+v"(fq));
        const int row0 = u.pm * 256 + wr * 64 + fr, col0 = u.pn * 256 + wc * 32 + 4 * fq;
        const float* gp = gate + (size_t)(u.pm >> 5) * ldg + col0;
        f32x4 gv[2][2];
#pragma unroll
        for (int bj = 0; bj < 2; ++bj)
#pragma unroll
            for (int n = 0; n < 2; ++n) gv[bj][n] = *(const f32x4*)(gp + bj * 128 + n * 16);
#pragma unroll
        for (int ai = 0; ai < 2; ++ai)
#pragma unroll
            for (int m = 0; m < 4; ++m) {
                const size_t off = (size_t)(row0 + ai * 128 + m * 16) * DM + col0;
#pragma unroll
                for (int bj = 0; bj < 2; ++bj)
#pragma unroll
                    for (int n = 0; n < 2; ++n) {
                        const f32x4 xo = *(const f32x4*)(xin + off + bj * 128 + n * 16);
                        *(f32x4*)(xout + off + bj * 128 + n * 16) = xo + gv[bj][n] * acc[ai][bj][m][n];
                    }
            }
    }
};
template <int MODE> struct EpiLat {
    static constexpr bool PERM = true;
    bf16_t* C; float* ssq; float* kr; bf16_t* Z;
    __device__ __forceinline__ void operator()(const f32x4 (&acc)[2][2][4][2], const Unit& u, int wr, int wc, int fr_, int fq_) const {
        int fr = fr_, fq = fq_; asm volatile("" : "+v"(fr), "+v"(fq));
        const int row0 = u.pm * 256 + wr * 64 + fr;
        if (u.pn < 2) {
#pragma unroll
            for (int ai = 0; ai < 2; ++ai)
#pragma unroll
                for (int m = 0; m < 4; ++m) {
                    const size_t row = (size_t)(row0 + ai * 128 + m * 16);
                    float ss = 0.f;
#pragma unroll
                    for (int bj = 0; bj < 2; ++bj) {
                        const int col = u.pn * 256 + bj * 128 + wc * 32 + 8 * fq;
                        float r[8];
#pragma unroll
                        for (int n = 0; n < 2; ++n)
#pragma unroll
                            for (int i = 0; i < 4; ++i) { r[4 * n + i] = acc[ai][bj][m][n][i]; ss += r[4 * n + i] * r[4 * n + i]; }
                        *(u32x4*)(C + row * 512 + col) = pack8f(r);
                    }
                    ss += __shfl_xor(ss, 16); ss += __shfl_xor(ss, 32);
                    if (fq == 0) ssq[row * 8 + u.pn * 4 + wc] = ss;
                }
        } else if (MODE == 0) {
            if (u.pn == 2 && wc < 2) {
#pragma unroll
                for (int ai = 0; ai < 2; ++ai)
#pragma unroll
                    for (int m = 0; m < 4; ++m) {
                        const size_t row = (size_t)(row0 + ai * 128 + m * 16);
                        *(f32x4*)(kr + row * 64 + wc * 32 + 8 * fq) = acc[ai][0][m][0];
                        *(f32x4*)(kr + row * 64 + wc * 32 + 8 * fq + 4) = acc[ai][0][m][1];
                    }
            }
        } else {
#pragma unroll
            for (int ai = 0; ai < 2; ++ai)
#pragma unroll
                for (int m = 0; m < 4; ++m) {
                    const size_t row = (size_t)(row0 + ai * 128 + m * 16);
#pragma unroll
                    for (int bj = 0; bj < 2; ++bj) {
                        const int col = (u.pn - 2) * 256 + bj * 128 + wc * 32 + 8 * fq;
                        float r[8];
#pragma unroll
                        for (int n = 0; n < 2; ++n)
#pragma unroll
                            for (int i = 0; i < 4; ++i) r[4 * n + i] = silu_f(acc[ai][bj][m][n][i]);
                        *(u32x4*)(Z + row * 2048 + col) = pack8f(r);
                    }
                }
        }
    }
};
struct EpiScaled {
    static constexpr bool PERM = true;
    bf16_t* O; int ldc; const float* ssq;
    __device__ __forceinline__ void operator()(const f32x4 (&acc)[2][2][4][2], const Unit& u, int wr, int wc, int fr_, int fq_) const {
        int fr = fr_, fq = fq_; asm volatile("" : "+v"(fr), "+v"(fq));
        const int row0 = u.pm * 256 + wr * 64 + fr;
#pragma unroll
        for (int ai = 0; ai < 2; ++ai)
#pragma unroll
            for (int m = 0; m < 4; ++m) {
                const size_t row = (size_t)(row0 + ai * 128 + m * 16);
                const f32x4 a = *(const f32x4*)(ssq + row * 8), b = *(const f32x4*)(ssq + row * 8 + 4);
                const float rs = rsqrtf(((a[0] + a[1] + a[2] + a[3] + b[0] + b[1] + b[2] + b[3]) + EPS * 512.0f) * (1.0f / 512.0f));
#pragma unroll
                for (int bj = 0; bj < 2; ++bj) {
                    const int col = u.pn * 256 + bj * 128 + wc * 32 + 8 * fq;
                    float r[8];
#pragma unroll
                    for (int n = 0; n < 2; ++n)
#pragma unroll
                        for (int i = 0; i < 4; ++i) r[4 * n + i] = acc[ai][bj][m][n][i] * rs;
                    *(u32x4*)(O + row * ldc + col) = pack8f(r);
                }
            }
    }
};
struct EpiVT {
    static constexpr bool PERM = false;
    bf16_t* VT; const float* ssq;
    __device__ __forceinline__ void operator()(const f32x4 (&acc)[2][2][4][2], const Unit& u, int wr, int wc, int fr_, int fq_) const {
        int fr = fr_, fq = fq_; asm volatile("" : "+v"(fr), "+v"(fq));
        const int row0 = u.pm * 256 + wr * 64 + fr;
        const int pg = ((fq & 1) << 1) | (fq >> 1);
#pragma unroll
        for (int bj = 0; bj < 2; ++bj)
#pragma unroll
            for (int n = 0; n < 2; ++n) {
                const int tb = u.pn * 256 + bj * 128 + wc * 32 + 16 * n;
                const int tok0 = tb + 4 * fq;
                f32x4 rs;
#pragma unroll
                for (int i = 0; i < 4; ++i) {
                    const f32x4 a = *(const f32x4*)(ssq + (size_t)(tok0 + i) * 8), b = *(const f32x4*)(ssq + (size_t)(tok0 + i) * 8 + 4);
                    rs[i] = rsqrtf(((a[0] + a[1] + a[2] + a[3] + b[0] + b[1] + b[2] + b[3]) + EPS * 512.0f) * (1.0f / 512.0f));
                }
                const int pos0 = tb + 4 * pg;
#pragma unroll
                for (int ai = 0; ai < 2; ++ai)
#pragma unroll
                    for (int m = 0; m < 4; ++m) {
                        const size_t row = (size_t)(row0 + ai * 128 + m * 16);
                        const f32x4 v = acc[ai][bj][m][n] * rs;
                        u32x2 o = {cvt_pk_bf16(v[0], v[1]), cvt_pk_bf16(v[2], v[3])};
                        *(u32x2*)(VT + row * T + pos0) = o;
                    }
            }
    }
};

template <class Epi> __device__ __forceinline__ void run_gemm(const int TID, const int BID, LAS unsigned char* lds, const bf16_t* A, const bf16_t* Bt, int M, int N, int K, const Epi& E, const bool a_blocked = false) {
    pg8::Gemm g{A, Bt, M, N, K, a_blocked ? 64 : K, a_blocked ? (size_t)M * 128 : (size_t)128}; pg8::StaticOrder S; S.init(M, N, (int)gridDim.x, (int)BID, 4);
    int tid_ = TID; asm volatile("" : "+v"(tid_));
    pg8::gemm_phase<Epi, pg8::StaticOrder>(tid_, lds, g, S, E);
}

struct Params {
    const float* in[25];
    float* out;
    unsigned char* ws;
    int ph_lo, ph_hi;
};
enum { I_X = 0, I_C, I_ADA_W, I_ADA_B, I_NORM_G, I_A_W_IN, I_A_LN_G, I_A_LN_B, I_A_W_S, I_A_B_S, I_A_W_OUT, I_KV_ADA_W, I_KV_ADA_B, I_KV_NORM_G, I_KV_W_DKV, I_KV_G_KVA,
       I_KV_W_UKV, I_KV_G_KN, I_KV_G_KR, I_B_W_IN, I_B_G_QA, I_B_W_UQ, I_B_G_QN, I_B_G_QR, I_B_W_OUT };

__device__ __forceinline__ void conv_tile(const int TID, unsigned char* shm, const float* src, int ldsrc, int srccol0, int K, int k0, bf16_t* dst, int n0, const float* scale) {
    float* tile = (float*)shm;
    const int tid = TID;
    {
        const int kk = tid >> 4, c4 = tid & 15;
        f32x4 v[8];
#pragma unroll
        for (int i = 0; i < 8; ++i) {
            v[i] = (f32x4){0.f, 0.f, 0.f, 0.f};
            if (srccol0 >= 0) v[i] = *(const f32x4*)(src + (size_t)(k0 + kk + 32 * i) * ldsrc + srccol0 + 4 * c4);
        }
#pragma unroll
        for (int i = 0; i < 8; ++i) { float* tp = tile + (kk + 32 * i) * 65 + 4 * c4; tp[0] = v[i][0]; tp[1] = v[i][1]; tp[2] = v[i][2]; tp[3] = v[i][3]; }
    }
    __syncthreads();
    {
        const int n = tid >> 3, k8 = tid & 7;
#pragma unroll
        for (int jb = 0; jb < 4; ++jb) {
            float r[8];
#pragma unroll
            for (int j = 0; j < 8; ++j) { r[j] = tile[(64 * jb + 8 * k8 + j) * 65 + n]; if (scale) r[j] *= scale[k0 + 64 * jb + 8 * k8 + j]; }
            *(u32x4*)(dst + (size_t)(n0 + n) * K + k0 + 64 * jb + 8 * k8) = pack8f(r);
        }
    }
    __syncthreads();
}

__device__ __forceinline__ void phase_prep(const int TID, const int BID, const Params& p, unsigned char* ws, unsigned char* shm) {
    const int tid = TID;
    {
        float* cosT = (float*)(ws + WS_COS); float* sinT = (float*)(ws + WS_SIN);
        for (int idx = BID * 512 + tid; idx < SEQ * 32; idx += gridDim.x * 512) {
            const int pos = idx >> 5, i = idx & 31;
            double f = 1.0; for (int q = 0; q < i; ++q) f *= 0.7498942093324559;
            const float invf = (float)f;
            const float ang = (float)pos * invf;
            const double ad = (double)ang;
            const double n = rint(ad * 0.15915494309189535);
            const double r = ad - n * 6.283185307179586;
            const double r2 = r * r;
            double s = 1.0, c = 1.0;
#pragma unroll 1
            for (int k = 14; k >= 1; --k) { s = 1.0 - s * r2 / (double)((2 * k) * (2 * k + 1)); c = 1.0 - c * r2 / (double)((2 * k - 1) * (2 * k)); }
            cosT[idx] = (float)c; sinT[idx] = (float)(r * s);
        }
    }
    if (BID < 224) {
        float* sc = (float*)shm;
        float* red = (float*)(shm + 32768);
        const float* cin = p.in[I_C];
        for (int i = tid; i < 4 * 2048; i += 512) sc[i] = silu_f(cin[i]);
        __syncthreads();
        const int item = BID;
        const float* W; const float* bias; float* out; int ldw, cb;
        if (item < 192) { const int l = item / 48; cb = item % 48; W = p.in[I_ADA_W] + (size_t)l * 2048 * 6144; ldw = 6144; bias = p.in[I_ADA_B] + l * 6144; out = (float*)(ws + WS_MOD) + (size_t)l * 4 * 6144; }
        else { cb = item - 192; W = p.in[I_KV_ADA_W]; ldw = 4096; bias = p.in[I_KV_ADA_B]; out = (float*)(ws + WS_KVMOD); }
        const int cgp = tid & 31, kg = tid >> 5;
        const float* wp = W + (size_t)(kg * 128) * ldw + cb * 128 + cgp * 4;
        f32x4 a0 = {0.f, 0.f, 0.f, 0.f}, a1 = a0, a2 = a0, a3 = a0;
#pragma unroll 8
        for (int k = 0; k < 128; ++k) {
            const f32x4 w = *(const f32x4*)(wp + (size_t)k * ldw);
            const int kk = kg * 128 + k;
            a0 += w * sc[kk]; a1 += w * sc[2048 + kk]; a2 += w * sc[4096 + kk]; a3 += w * sc[6144 + kk];
        }
        float* rp = red + ((size_t)kg * 128 + cgp * 4) * 4;
#pragma unroll
        for (int e = 0; e < 4; ++e) { rp[e * 4 + 0] = a0[e]; rp[e * 4 + 1] = a1[e]; rp[e * 4 + 2] = a2[e]; rp[e * 4 + 3] = a3[e]; }
        __syncthreads();
        {
            const int col = tid >> 2, b = tid & 3;
            float s = 0.f;
#pragma unroll
            for (int g = 0; g < 16; ++g) s += red[((size_t)g * 128 + col) * 4 + b];
            out[(size_t)b * ldw + cb * 128 + col] = s + bias[cb * 128 + col];
        }
        __syncthreads();
    }
    {
        const float* wsrc = p.in[I_A_W_S]; bf16_t* wdst = (bf16_t*)(ws + WS_WS16);
        for (int idx = BID * 512 + TID; idx < 2 * 16 * 128 * 128 / 4; idx += gridDim.x * 512) {
            const int e = idx * 4, s4 = e & 127, t = (e >> 7) & 127;
            f32x4 w = *(const f32x4*)(wsrc + e);
#pragma unroll
            for (int q = 0; q < 4; ++q) if (s4 + q > t) w[q] = 0.f;
            u32x2 o = {cvt_pk_bf16(w[0], w[1]), cvt_pk_bf16(w[2], w[3])};
            *(u32x2*)(wdst + e) = o;
        }
    }
    {
        constexpr int NJ = 13;
        const int ntile[NJ] = {1536, 1536, 512, 512, 96, 64, 64, 320, 320, 96, 96, 256, 256};
        int total = 0;
#pragma unroll
        for (int j = 0; j < NJ; ++j) total += ntile[j];
        for (int tix = BID; tix < total; tix += gridDim.x) {
            int j = 0, rem = tix;
#pragma unroll
            for (int q = 0; q < NJ; ++q) { if (j == q && rem >= ntile[q]) { rem -= ntile[q]; j = q + 1; } }
            const float* src; int ldsrc, K; bf16_t* dst; const float* scale = nullptr; int srccol0, n0, k0;
            if (j < 2) {
                K = 2048; ldsrc = 12288; src = p.in[I_A_W_IN] + (size_t)j * 2048 * 12288; dst = (bf16_t*)(ws + WS_WINA) + (size_t)j * 12288 * 2048;
                const int nt_ = rem / 8; k0 = (rem % 8) * 256; n0 = nt_ * 64;
                const int pn = n0 >> 8, jj = n0 & 255;
                srccol0 = pn < 32 ? (jj < 128 ? 128 * pn + jj : 8192 + 128 * pn + (jj - 128)) : 4096 + 256 * (pn - 32) + jj;
            } else if (j < 4) {
                const int l = j - 2; K = 4096; ldsrc = 2048; src = p.in[I_A_W_OUT] + (size_t)l * 4096 * 2048; dst = (bf16_t*)(ws + WS_WOUTA) + (size_t)l * 2048 * 4096;
                const int nt_ = rem / 16; k0 = (rem % 16) * 256; n0 = nt_ * 64; srccol0 = n0;
            } else if (j == 4) {
                K = 2048; ldsrc = 576; src = p.in[I_KV_W_DKV]; dst = (bf16_t*)(ws + WS_WDKV);
                const int nt_ = rem / 8; k0 = (rem % 8) * 256; n0 = nt_ * 64; srccol0 = n0 < 576 ? n0 : -1;
            } else if (j < 7) {
                K = 512; ldsrc = 4096; src = p.in[I_KV_W_UKV]; dst = (bf16_t*)(ws + (j == 5 ? WS_WKN : WS_WV)); scale = p.in[I_KV_G_KVA];
                const int nt_ = rem / 2; k0 = (rem % 2) * 256; n0 = nt_ * 64;
                srccol0 = (n0 >> 7) * 256 + (j == 6 ? 128 : 0) + (n0 & 127);
            } else if (j < 9) {
                const int l = j - 7; K = 2048; ldsrc = 2560; src = p.in[I_B_W_IN] + (size_t)l * 2048 * 2560; dst = (bf16_t*)(ws + WS_WINB) + (size_t)l * 2560 * 2048;
                const int nt_ = rem / 8; k0 = (rem % 8) * 256; n0 = nt_ * 64; srccol0 = n0;
            } else if (j < 11) {
                const int l = j - 9; K = 512; ldsrc = 3072; src = p.in[I_B_W_UQ] + (size_t)l * 512 * 3072; dst = (bf16_t*)(ws + WS_WUQ) + (size_t)l * 3072 * 512; scale = p.in[I_B_G_QA] + l * 512;
                const int nt_ = rem / 2; k0 = (rem % 2) * 256; n0 = nt_ * 64; srccol0 = n0;
            } else {
                const int l = j - 11; K = 2048; ldsrc = 2048; src = p.in[I_B_W_OUT] + (size_t)l * 2048 * 2048; dst = (bf16_t*)(ws + WS_WOUTB) + (size_t)l * 2048 * 2048;
                const int nt_ = rem / 8; k0 = (rem % 8) * 256; n0 = nt_ * 64; srccol0 = n0;
            }
            conv_tile(TID, shm, src, ldsrc, srccol0, K, k0, dst, n0, scale);
        }
    }
}

__device__ __forceinline__ void phase_norm(const int TID, const int BID, const float* x, const float* g1, const float* sh1, const float* sc1, int ld1, bf16_t* h1,
                           const float* g2, const float* sh2, const float* sc2, int ld2, bf16_t* h2) {
    const int lane = TID & 63, wid = TID >> 6;
    for (int row = BID * 8 + wid; row < T; row += gridDim.x * 8) {
        const int b = row >> 13;
        const f32x4* xr = (const f32x4*)(x + (size_t)row * DM);
        f32x4 v[8]; float ss = 0.f;
#pragma unroll
        for (int i = 0; i < 8; ++i) { v[i] = xr[lane + 64 * i]; ss += v[i][0] * v[i][0] + v[i][1] * v[i][1] + v[i][2] * v[i][2] + v[i][3] * v[i][3]; }
#pragma unroll
        for (int o = 32; o >= 1; o >>= 1) ss += __shfl_xor(ss, o);
        const float rs = rsqrtf((ss + EPS * 2048.0f) * (1.0f / 2048.0f));
#pragma unroll
        for (int i = 0; i < 8; ++i) {
            const int k = 4 * (lane + 64 * i);
            const f32x4 gg = *(const f32x4*)(g1 + k), sc = *(const f32x4*)(sc1 + (size_t)b * ld1 + k), sh = *(const f32x4*)(sh1 + (size_t)b * ld1 + k);
            const f32x4 o = (v[i] * rs) * gg * (sc + 1.0f) + sh;
            u32x2 w = {cvt_pk_bf16(o[0], o[1]), cvt_pk_bf16(o[2], o[3])};
            *(u32x2*)(h1 + (size_t)row * DM + k) = w;
        }
        if (h2) {
#pragma unroll
            for (int i = 0; i < 8; ++i) {
                const int k = 4 * (lane + 64 * i);
                const f32x4 gg = *(const f32x4*)(g2 + k), sc = *(const f32x4*)(sc2 + (size_t)b * ld2 + k), sh = *(const f32x4*)(sh2 + (size_t)b * ld2 + k);
                const f32x4 o = (v[i] * rs) * gg * (sc + 1.0f) + sh;
                u32x2 w = {cvt_pk_bf16(o[0], o[1]), cvt_pk_bf16(o[2], o[3])};
                *(u32x2*)(h2 + (size_t)row * DM + k) = w;
            }
        }
    }
}

__device__ __forceinline__ void phase_mix(const int TID, const int BID, unsigned char* shm, bf16_t* P, const bf16_t* GVT, const float* stats, const bf16_t* ws16, const float* b_s, const float* ln_g, const float* ln_b, const bool ident) {
    constexpr int LD = 136;
    bf16_t* VTl = (bf16_t*)shm;
    bf16_t* WsL = (bf16_t*)(shm + 256 * LD * 2);
    float* st = (float*)(shm + 256 * LD * 2 + 128 * LD * 2);
    const int tid = TID, lane = tid & 63, wid = tid >> 6, l15 = lane & 15, l4 = lane >> 4;
    for (int chunk = BID; chunk < T / 128; chunk += gridDim.x) {
        const int t0 = chunk * 128;
        __syncthreads();
        if (tid < 128) {
            const f32x4* sp = (const f32x4*)(stats + (size_t)(t0 + tid) * 64);
            float s = 0.f, ss = 0.f;
#pragma unroll
            for (int i = 0; i < 16; ++i) { const f32x4 v = sp[i]; s += v[0] + v[2]; ss += v[1] + v[3]; }
            const float mean = s * (1.0f / 4096.0f);
            const float var = ss * (1.0f / 4096.0f) - mean * mean;
            st[2 * tid] = mean; st[2 * tid + 1] = rsqrtf(fmaxf(var, 0.f) + EPS);
        }
        __syncthreads();
        for (int g = 0; g < 16; ++g) {
#pragma unroll
            for (int i = 0; i < 4; ++i) {
                const int id = tid + 512 * i, t = id >> 4, s8 = (id & 15) * 8;
                *(u32x4*)(WsL + t * LD + s8) = *(const u32x4*)(ws16 + ((size_t)g * 128 + t) * 128 + s8);
            }
#pragma unroll
            for (int i = 0; i < 8; ++i) {
                const int id = tid + 512 * i, c = id >> 4, s8 = (id & 15) * 8;
                const u32x4 raw = *(const u32x4*)(GVT + (size_t)(g * 256 + c) * T + t0 + s8);
                const float gg = ln_g[g * 256 + c], bb = ln_b[g * 256 + c];
                float r[8];
#pragma unroll
                for (int q = 0; q < 4; ++q) { r[2 * q] = bflo(raw[q]); r[2 * q + 1] = bfhi(raw[q]); }
#pragma unroll
                for (int q = 0; q < 4; ++q) {
                    const f32x4 mr = *(const f32x4*)(st + 2 * (s8 + 2 * q));
                    r[2 * q] = (r[2 * q] - mr[0]) * mr[1] * gg + bb;
                    r[2 * q + 1] = (r[2 * q + 1] - mr[2]) * mr[3] * gg + bb;
                }
                *(u32x4*)(VTl + c * LD + s8) = pack8f(r);
            }
            __syncthreads();
            f32x4 acc[2][8];
#pragma unroll
            for (int cb = 0; cb < 2; ++cb)
#pragma unroll
                for (int tb = 0; tb < 8; ++tb) acc[cb][tb] = (f32x4){0.f, 0.f, 0.f, 0.f};
#pragma unroll
            for (int ks = 0; ks < 4; ++ks) {
                bf16x8 vf[2];
#pragma unroll
                for (int cb = 0; cb < 2; ++cb) vf[cb] = *(const bf16x8*)(VTl + (wid * 32 + cb * 16 + l15) * LD + ks * 32 + l4 * 8);
#pragma unroll
                for (int tb = 0; tb < 8; ++tb) {
                    if (tb >= 2 * ks) {
                        const bf16x8 wf = *(const bf16x8*)(WsL + (tb * 16 + l15) * LD + ks * 32 + l4 * 8);
#pragma unroll
                        for (int cb = 0; cb < 2; ++cb) acc[cb][tb] = __builtin_amdgcn_mfma_f32_16x16x32_bf16(vf[cb], wf, acc[cb][tb], 0, 0, 0);
                    }
                }
            }
            __syncthreads();
            {
                bf16_t* OutL = (bf16_t*)shm;
#pragma unroll
                for (int tb = 0; tb < 8; ++tb) {
                    const int t = tb * 16 + l15;
                    const float bs = b_s[g * 128 + t];
#pragma unroll
                    for (int cb = 0; cb < 2; ++cb) {
                        const f32x4 a = acc[cb][tb];
                        u32x2 o = {cvt_pk_bf16(a[0] + bs, a[1] + bs), cvt_pk_bf16(a[2] + bs, a[3] + bs)};
                        *(u32x2*)(OutL + t * 264 + wid * 32 + cb * 16 + l4 * 4) = o;
                    }
                }
                __syncthreads();
#pragma unroll
                for (int i = 0; i < 8; ++i) {
                    const int id = tid + 512 * i, blk = id >> 10, t = (id >> 3) & 127, c8 = (id & 7) * 8;
                    bf16_t* pp = P + ((size_t)(g * 4 + blk) * T + t0 + t) * 64 + c8;
                    const u32x4 pv = *(const u32x4*)pp;
                    const u32x4 mv = *(const u32x4*)(OutL + t * 264 + blk * 64 + c8);
                    u32x4 o;
#pragma unroll
                    for (int q = 0; q < 4; ++q) o[q] = ident ? (pv[q] | (mv[q] & 0u)) : cvt_pk_bf16(bflo(pv[q]) * bflo(mv[q]), bfhi(pv[q]) * bfhi(mv[q]));
                    *(u32x4*)pp = o;
                }
            }
            __syncthreads();
        }
    }
}

__device__ __forceinline__ void phase_kpost(const int TID, const int BID, bf16_t* KN, const float* KRAW, bf16_t* KROPE, const float* g_kn, const float* g_kr, const float* cosT, const float* sinT, const bool ident) {
    const int lane = TID & 63, wid = TID >> 6;
    const int gw = BID * 8 + wid, nw = gridDim.x * 8;
    {
        const int sub = lane >> 4, l16 = lane & 15;
        const f32x4 ga = *(const f32x4*)(g_kn + l16 * 8), gb = *(const f32x4*)(g_kn + l16 * 8 + 4);
        const size_t nrows = (size_t)T * 16;
        for (size_t r0 = (size_t)gw * 4 + sub; r0 < nrows; r0 += (size_t)nw * 16) {
            u32x4 raw[4];
#pragma unroll
            for (int u = 0; u < 4; ++u) { const size_t r = r0 + (size_t)u * nw * 4; if (r < nrows) raw[u] = *(const u32x4*)(KN + r * 128 + l16 * 8); }
#pragma unroll
            for (int u = 0; u < 4; ++u) {
                const size_t r = r0 + (size_t)u * nw * 4;
                float v[8]; float ss = 0.f;
#pragma unroll
                for (int q = 0; q < 4; ++q) { v[2 * q] = bflo(raw[u][q]); v[2 * q + 1] = bfhi(raw[u][q]); ss += v[2 * q] * v[2 * q] + v[2 * q + 1] * v[2 * q + 1]; }
                ss += __shfl_xor(ss, 1); ss += __shfl_xor(ss, 2); ss += __shfl_xor(ss, 4); ss += __shfl_xor(ss, 8);
                const float rs = rsqrtf((ss + EPS * 128.0f) * (1.0f / 128.0f));
#pragma unroll
                for (int e = 0; e < 8; ++e) v[e] = v[e] * rs * (e < 4 ? ga[e & 3] : gb[e & 3]);
                if (r < nrows) *(u32x4*)(KN + r * 128 + l16 * 8) = ident ? raw[u] : pack8f(v);
            }
        }
    }
    {
        const float gk = g_kr[lane];
        for (int t0 = gw; t0 < T; t0 += nw * 4) {
            float xs[4];
#pragma unroll
            for (int u = 0; u < 4; ++u) { const int t = t0 + u * nw; xs[u] = t < T ? KRAW[(size_t)t * 64 + lane] : 0.f; }
#pragma unroll
            for (int u = 0; u < 4; ++u) {
                const int t = t0 + u * nw;
                const float x = xs[u];
                float ss = x * x;
#pragma unroll
                for (int o = 32; o >= 1; o >>= 1) ss += __shfl_xor(ss, o);
                const float y = x * rsqrtf((ss + EPS * 64.0f) * (1.0f / 64.0f)) * gk;
                const float other = __shfl_xor(y, 32);
                const int pos = t & (SEQ - 1), i = lane & 31;
                if (t < T) {
                    const float c = cosT[pos * 32 + i], s = sinT[pos * 32 + i];
                    const float o = lane < 32 ? (y * c - other * s) : (y * c + other * s);
                    KROPE[(size_t)t * 64 + lane] = (bf16_t)(cvt_pk_bf16(o, 0.f) & 0xffffu);
                }
            }
        }
    }
}

__device__ __forceinline__ void phase_attn(const int TID, const int BID, unsigned char* shm, const bf16_t* Q, const bf16_t* KN, const bf16_t* KR, const bf16_t* VT, const bf16_t* Zs, bf16_t* Y,
                                           const float* g_qn, const float* g_qr, const float* cosT, const float* sinT) {
    constexpr int KROWB = 400, VROWB = 144, KBYTES = 64 * KROWB, BUFB = KBYTES + 128 * VROWB;
    const int tid = TID, wid = __builtin_amdgcn_readfirstlane(tid >> 6), lane = tid & 63, lq = lane & 31, hi = lane >> 5;
    const int kn_r = tid >> 4, kn_c = tid & 15;
    const int kr_r = tid >> 3, kr_c = tid & 7;
    const int v_r = tid >> 3, v_c = tid & 7;
    const unsigned koff = kn_r * 2048 + kn_c * 8, roff = kr_r * 64 + kr_c * 8, voff = (unsigned)v_r * T + v_c * 8;
    const int kfrag = lq * KROWB + hi * 16;
    const int vfrag = KBYTES + lq * VROWB + hi * 16;
    for (int item = BID; item < 1024; item += gridDim.x) {
        const int bh = item >> 4, pr = item & 15, b = bh >> 4, h = bh & 15;
        const int tokb = b * SEQ;
        for (int half = 0; half < 2; ++half) {
            const int qb = half == 0 ? (31 - pr) : pr;
            const int q0 = qb * 256, nt = 4 * (qb + 1);
            int lqo = lq, hio = hi; asm volatile("" : "+v"(lqo), "+v"(hio));
            const int qrow = q0 + wid * 32 + lq;
            const int qrow_o = q0 + wid * 32 + lqo;
            bf16x8 qf[12];
            {
                const bf16_t* qp = Q + (size_t)(tokb + qrow_o) * 3072 + h * 192 + hio * 8;
#pragma unroll
                for (int ks = 0; ks < 12; ++ks) qf[ks] = *(const bf16x8*)(qp + ks * 16);
                float ssn = 0.f, ssr = 0.f;
#pragma unroll
                for (int ks = 0; ks < 12; ++ks)
#pragma unroll
                    for (int j = 0; j < 8; ++j) { const float v = bf2f((unsigned short)qf[ks][j]); if (ks < 8) ssn += v * v; else ssr += v * v; }
                ssn = x32_sum(ssn); ssr = x32_sum(ssr);
                const float rn = rsqrtf((ssn + EPS * 128.0f) * (1.0f / 128.0f)) * QSCALE;
                const float rr = rsqrtf((ssr + EPS * 64.0f) * (1.0f / 64.0f));
#pragma unroll
                for (int ks = 0; ks < 8; ++ks) {
                    const f32x4 ga = *(const f32x4*)(g_qn + ks * 16 + hio * 8), gb = *(const f32x4*)(g_qn + ks * 16 + hio * 8 + 4);
                    float r[8];
#pragma unroll
                    for (int j = 0; j < 8; ++j) r[j] = bf2f((unsigned short)qf[ks][j]) * rn * (j < 4 ? ga[j & 3] : gb[j & 3]);
                    const u32x4 o = pack8f(r);
                    qf[ks] = *(const bf16x8*)&o;
                }
#pragma unroll
                for (int kk = 0; kk < 2; ++kk) {
                    const int i0 = 16 * kk + 8 * hio;
                    float r1[8], r2[8];
#pragma unroll
                    for (int j = 0; j < 8; ++j) {
                        const float x1 = bf2f((unsigned short)qf[8 + kk][j]) * rr * g_qr[i0 + j];
                        const float x2 = bf2f((unsigned short)qf[10 + kk][j]) * rr * g_qr[32 + i0 + j];
                        const float c = cosT[qrow_o * 32 + i0 + j], s = sinT[qrow_o * 32 + i0 + j];
                        r1[j] = (x1 * c - x2 * s) * QSCALE; r2[j] = (x2 * c + x1 * s) * QSCALE;
                    }
                    const u32x4 o1 = pack8f(r1), o2 = pack8f(r2);
                    qf[8 + kk] = *(const bf16x8*)&o1; qf[10 + kk] = *(const bf16x8*)&o2;
                }
            }
            f32x16 O[4];
#pragma unroll
            for (int d = 0; d < 4; ++d)
#pragma unroll
                for (int r = 0; r < 16; ++r) O[d][r] = 0.f;
            float m_run = 0.f, l_run = 0.f; bool mz = true;
            u32x4 st0, st1, st2, st3, st4;
#define ATT_ISSUE_K(t_) do { const size_t tok0 = (size_t)tokb + (size_t)(t_) * 64; \
                const bf16_t* knb = uniform_ptr(KN + tok0 * 2048 + h * 128); const bf16_t* krb = uniform_ptr(KR + tok0 * 64); \
                st0 = *(const u32x4*)(knb + koff); \
                st1 = *(const u32x4*)(knb + koff + 32 * 2048); \
                st2 = *(const u32x4*)(krb + roff); } while (0)
#define ATT_ISSUE_V(t_) do { const size_t tok0 = (size_t)tokb + (size_t)(t_) * 64; \
                const bf16_t* vtb = uniform_ptr(VT + (size_t)(h * 128) * T + tok0); \
                st3 = *(const u32x4*)(vtb + voff); \
                st4 = *(const u32x4*)(vtb + voff + 64 * T); } while (0)
#define ATT_WRITE(buf_) do { unsigned char* bp = shm + (buf_) * BUFB; \
                *(u32x4*)(bp + kn_r * KROWB + kn_c * 16) = st0; \
                *(u32x4*)(bp + (kn_r + 32) * KROWB + kn_c * 16) = st1; \
                *(u32x4*)(bp + kr_r * KROWB + 256 + kr_c * 16) = st2; \
                *(u32x4*)(bp + KBYTES + v_r * VROWB + v_c * 16) = st3; \
                *(u32x4*)(bp + KBYTES + (v_r + 64) * VROWB + v_c * 16) = st4; } while (0)
            __syncthreads();
            ATT_ISSUE_K(0); ATT_ISSUE_V(0);
            ATT_WRITE(0);
            __syncthreads();
            for (int t = 0; t < nt; ++t) {
                const bool has_next = (t + 1 < nt);
                const int rel = t - (nt - 4);
                const bool active = rel <= (wid >> 1);
                const unsigned char* bp = shm + (t & 1) * BUFB;
                bf16x8 pf[4];
#define SB_() __builtin_amdgcn_sched_barrier(0)
#define LDKH_(dst, h_, ks0_) do { _Pragma("unroll") for (int j_ = 0; j_ < 4; ++j_) dst[j_] = *(const bf16x8*)(bp + kfrag + (h_) * 12800 + ((ks0_) + j_) * 32); } while (0)
#define MMH_(S_, src, ks0_) do { _Pragma("unroll") for (int j_ = 0; j_ < 4; ++j_) S_ = __builtin_amdgcn_mfma_f32_32x32x16_bf16(src[j_], qf[(ks0_) + j_], S_, 0, 0, 0); } while (0)
#define LDVK_(dst, kk_) do { _Pragma("unroll") for (int j_ = 0; j_ < 4; ++j_) dst[j_] = *(const bf16x8*)(bp + vfrag + j_ * 4608 + (kk_) * 32); } while (0)
#define MMVK_(src, kk_) do { _Pragma("unroll") for (int j_ = 0; j_ < 4; ++j_) O[j_] = __builtin_amdgcn_mfma_f32_32x32x16_bf16(src[j_], pf[kk_], O[j_], 0, 0, 0); } while (0)
#define EXPR_(S_, r0_, r1_) do { _Pragma("unroll") for (int r_ = (r0_); r_ < (r1_); ++r_) { S_[r_] = __builtin_amdgcn_exp2f(S_[r_]); ps += S_[r_]; } } while (0)
#define PACK_(S_, k0_) do { u32x4 a_ = {cvt_pk_bf16(S_[0], S_[1]), cvt_pk_bf16(S_[2], S_[3]), cvt_pk_bf16(S_[4], S_[5]), cvt_pk_bf16(S_[6], S_[7])}; \
                        u32x4 b_ = {cvt_pk_bf16(S_[8], S_[9]), cvt_pk_bf16(S_[10], S_[11]), cvt_pk_bf16(S_[12], S_[13]), cvt_pk_bf16(S_[14], S_[15])}; \
                        pf[k0_] = *(const bf16x8*)&a_; pf[(k0_) + 1] = *(const bf16x8*)&b_; } while (0)
#define HALFPRE_(S_, koff_, EXTRA_) do { \
                        if (rel >= 0) { const int dq = qrow - t * 64 - 4 * hi - (koff_); float ninf_; asm volatile("v_mov_b32 %0, 0xff800000" : "=v"(ninf_)); \
                            _Pragma("unroll") for (int r_ = 0; r_ < 16; ++r_) { const int c_ = (r_ & 3) + 8 * (r_ >> 2); if (c_ > dq) S_[r_] = ninf_; } } \
                        float mx = S_[0]; \
                        _Pragma("unroll") for (int r_ = 1; r_ < 16; ++r_) mx = fmaxf(mx, S_[r_]); \
                        mx = x32_max(mx); \
                        const bool first_ = (t == 0) && ((koff_) == 0); \
                        const bool viol = (mx > 12.0f) || (first_ && mx < -64.0f); \
                        const bool fast = mz && (__builtin_amdgcn_ballot_w64(viol) == 0ull); \
                        if (!fast) { \
                            mz = false; \
                            const float mn = first_ ? mx : fmaxf(m_run, mx); \
                            const float alpha = first_ ? 1.0f : __builtin_amdgcn_exp2f(m_run - mn); \
                            m_run = mn; l_run *= alpha; EXTRA_ \
                            _Pragma("unroll") for (int r_ = 0; r_ < 16; ++r_) S_[r_] -= mn; \
                            _Pragma("unroll") for (int d_ = 0; d_ < 4; ++d_) _Pragma("unroll") for (int r_ = 0; r_ < 16; ++r_) O[d_][r_] *= alpha; \
                        } } while (0)
                f32x16 S1;
                float ps = 0.f;
                bf16x8 fc[4];
                if (active) {
                    f32x16 S0;
#pragma unroll
                    for (int r = 0; r < 16; ++r) { S0[r] = 0.f; S1[r] = 0.f; }
                    bf16x8 fa[4], fb[4];
                    LDKH_(fa, 0, 0); SB_();
                    LDKH_(fb, 0, 4); SB_(); MMH_(S0, fa, 0); SB_();
                    LDKH_(fa, 0, 8); SB_(); MMH_(S0, fb, 4); SB_();
                    LDKH_(fb, 1, 0); SB_(); MMH_(S0, fa, 8); SB_();
                    HALFPRE_(S0, 0, ); SB_();
                    LDKH_(fa, 1, 4); SB_(); MMH_(S1, fb, 0); EXPR_(S0, 0, 6); SB_();
                    LDKH_(fb, 1, 8); SB_(); MMH_(S1, fa, 4); EXPR_(S0, 6, 11); SB_();
                    LDVK_(fc, 0); SB_(); MMH_(S1, fb, 8); EXPR_(S0, 11, 16); SB_();
                    PACK_(S0, 0);
                }
                if (has_next) { ATT_ISSUE_K(t + 1); ATT_ISSUE_V(t + 1); }
                if (active) {
                    bf16x8 fb[4];
#define RESC_P0_ { ps *= alpha; _Pragma("unroll") for (int k_ = 0; k_ < 2; ++k_) { u32x4 w_ = *(const u32x4*)&pf[k_]; \
                        _Pragma("unroll") for (int q_ = 0; q_ < 4; ++q_) w_[q_] = cvt_pk_bf16(bflo(w_[q_]) * alpha, bfhi(w_[q_]) * alpha); pf[k_] = *(const bf16x8*)&w_; } }
                    HALFPRE_(S1, 32, RESC_P0_); SB_();
#undef RESC_P0_
                    LDVK_(fb, 1); SB_(); MMVK_(fc, 0); EXPR_(S1, 0, 8); SB_();
                    LDVK_(fc, 2); SB_(); MMVK_(fb, 1); EXPR_(S1, 8, 16); SB_();
                    PACK_(S1, 2);
                    l_run += ps;
                    LDVK_(fb, 3); SB_(); MMVK_(fc, 2); SB_();
                    MMVK_(fb, 3); SB_();
                }
#undef SB_
#undef LDKH_
#undef MMH_
#undef LDVK_
#undef MMVK_
#undef EXPR_
#undef PACK_
#undef HALFPRE_
                if (has_next) ATT_WRITE((t + 1) & 1);
                __syncthreads();
            }
#undef ATT_ISSUE_K
#undef ATT_ISSUE_V
#undef ATT_WRITE
            const float lt = x32_sum(l_run);
            const float inv = 1.0f / lt;
            int lqe = lq, hie = hi; asm volatile("" : "+v"(lqe), "+v"(hie));
            const size_t yoff = (size_t)(tokb + q0 + wid * 32 + lqe) * 2048 + h * 128 + 4 * hie;
            const bf16_t* zp = Zs + yoff; bf16_t* yp = Y + yoff;
#pragma unroll
            for (int db = 0; db < 4; ++db)
#pragma unroll
                for (int g4 = 0; g4 < 4; ++g4) {
                    bf16_t* pp = yp + db * 32 + g4 * 8;
                    const u32x2 zv = *(const u32x2*)(zp + db * 32 + g4 * 8);
                    u32x2 o = {cvt_pk_bf16(O[db][4 * g4 + 0] * inv * bflo(zv[0]), O[db][4 * g4 + 1] * inv * bfhi(zv[0])),
                               cvt_pk_bf16(O[db][4 * g4 + 2] * inv * bflo(zv[1]), O[db][4 * g4 + 3] * inv * bfhi(zv[1]))};
                    *(u32x2*)pp = o;
                }
        }
    }
}

enum { PH_PREP = 0, PH_NORM_A0, PH_AIN0, PH_MIX0, PH_AOUT0, PH_NORM_A1, PH_AIN1, PH_MIX1, PH_AOUT1, PH_NORM_KV, PH_DKV_BIN0, PH_UKV_UQ0, PH_KPOST, PH_ATTN0, PH_BOUT0,
       PH_NORM_B1, PH_BIN1, PH_UQ1, PH_ATTN1, PH_BOUT1, NPH };
#if REP_GEMM == 2
#define RG_(x) x, x,
#else
#define RG_(x) x,
#endif
#if REP_AIN == 2
#define RI_(x) x, x,
#else
#define RI_(x) x,
#endif
#if REP_MIX == 2
#define RM_(x) x, (x) | 0x80,
#else
#define RM_(x) x,
#endif
#if REP_ATTN == 2
#define RA_(x) x, x,
#else
#define RA_(x) x,
#endif
#if REP_LIGHT == 2
#define RL_(x) x, x,
#else
#define RL_(x) x,
#endif
__device__ const int g_seq[] = { RL_(PH_PREP) RL_(PH_NORM_A0) RI_(PH_AIN0) RM_(PH_MIX0) RG_(PH_AOUT0) RL_(PH_NORM_A1) RI_(PH_AIN1) RM_(PH_MIX1) PH_AOUT1, RL_(PH_NORM_KV) RG_(PH_DKV_BIN0) RG_(PH_UKV_UQ0)
                                           RM_(PH_KPOST) RA_(PH_ATTN0) PH_BOUT0, RL_(PH_NORM_B1) RG_(PH_BIN1) RG_(PH_UQ1) RA_(PH_ATTN1) PH_BOUT1 };
constexpr int NSEQ = (int)(sizeof(g_seq) / sizeof(int));

__global__ void __launch_bounds__(512, 2) mega(Params p) {
    extern __shared__ __attribute__((aligned(16))) unsigned char shm[];
    LAS unsigned char* lds = (LAS unsigned char*)shm;
    const int wid_s = __builtin_amdgcn_readfirstlane((int)(threadIdx.x >> 6));
    for (int pi = p.ph_lo; pi < p.ph_hi; ++pi) {
        const int phv = g_seq[pi]; const int ph = phv & 0x7f; const bool ident = (phv & 0x80) != 0;
        int lane_; asm volatile("v_mbcnt_lo_u32_b32 %0, -1, 0\n\tv_mbcnt_hi_u32_b32 %0, -1, %0" : "=v"(lane_));
        int TID = wid_s * 64 + lane_, BID = blockIdx.x; unsigned long long zoff_ = 0; asm volatile("" : "+s"(zoff_)); unsigned char* ws = p.ws + zoff_;
        asm volatile("" : "+v"(TID), "+s"(BID));
        const float* mod = (const float*)(ws + WS_MOD);
        const float* kvmod = (const float*)(ws + WS_KVMOD);
        const float* cosT = (const float*)(ws + WS_COS);
        const float* sinT = (const float*)(ws + WS_SIN);
        switch (ph) {
#if PHSEL & 1
        case PH_PREP: phase_prep(TID, BID, p, ws, shm); break;
#endif
#if PHSEL & 2
        case PH_NORM_A0: case PH_NORM_A1: case PH_NORM_B1: {
            const int l = ph == PH_NORM_A0 ? 0 : (ph == PH_NORM_A1 ? 1 : 3);
            const float* x = l == 0 ? p.in[I_X] : p.out;
            const float* m = mod + (size_t)l * 4 * 6144;
            phase_norm(TID, BID, x, p.in[I_NORM_G] + l * DM, m, m + 2048, 6144, (bf16_t*)(ws + WA_H), nullptr, nullptr, nullptr, 0, nullptr);
        } break;
#endif
#if PHSEL & 4
        case PH_NORM_KV: {
            const float* m = mod + (size_t)2 * 4 * 6144;
            phase_norm(TID, BID, p.out, p.in[I_NORM_G] + 2 * DM, m, m + 2048, 6144, (bf16_t*)(ws + WB_H), p.in[I_KV_NORM_G], kvmod, kvmod + 2048, 4096, (bf16_t*)(ws + WB_HKV));
        } break;
#endif
#if PHSEL & 8
        case PH_AIN0: case PH_AIN1: {
            const int l = ph == PH_AIN0 ? 0 : 1;
            const bf16_t* W = (const bf16_t*)(ws + WS_WINA) + (size_t)l * 12288 * 2048;
            EpiUZ E{(bf16_t*)(ws + WA_P)};
            run_gemm(TID, BID, lds, (const bf16_t*)(ws + WA_H), W, T, 8192, 2048, E);
            EpiGVT E2{(bf16_t*)(ws + WA_GVT), (float*)(ws + WA_STATS)};
            run_gemm(TID, BID, lds, W + (size_t)8192 * 2048, (const bf16_t*)(ws + WA_H), 4096, T, 2048, E2);
        } break;
#endif
#if PHSEL & 16
        case PH_MIX0: case PH_MIX1: {
            const int l = ph == PH_MIX0 ? 0 : 1;
            phase_mix(TID, BID, shm, (bf16_t*)(ws + WA_P), (const bf16_t*)(ws + WA_GVT), (const float*)(ws + WA_STATS), (const bf16_t*)(ws + WS_WS16) + (size_t)l * 16 * 128 * 128, p.in[I_A_B_S] + l * 16 * 128,
                      p.in[I_A_LN_G] + l * GMW, p.in[I_A_LN_B] + l * GMW, ident);
        } break;
#endif
#if PHSEL & 32
        case PH_AOUT0: case PH_AOUT1: case PH_BOUT0: case PH_BOUT1: {
            const int l = ph == PH_AOUT0 ? 0 : (ph == PH_AOUT1 ? 1 : (ph == PH_BOUT0 ? 2 : 3));
            const float* xin = l == 0 ? p.in[I_X] : p.out;
            EpiRes E{xin, p.out, mod + (size_t)l * 4 * 6144 + 4096, 6144};
            const bf16_t* A = l < 2 ? (const bf16_t*)(ws + WA_P) : (const bf16_t*)(ws + WB_Y);
            const bf16_t* Bt = l < 2 ? (const bf16_t*)(ws + WS_WOUTA) + (size_t)l * 2048 * 4096 : (const bf16_t*)(ws + WS_WOUTB) + (size_t)(l - 2) * 2048 * 2048;
            run_gemm(TID, BID, lds, A, Bt, T, 2048, l < 2 ? 4096 : 2048, E, l < 2);
        } break;
#endif
#if PHSEL & 64
        case PH_DKV_BIN0: case PH_BIN1: {
            if (ph == PH_DKV_BIN0) {
                EpiLat<0> E{(bf16_t*)(ws + WB_CKV), (float*)(ws + WB_SSQKV), (float*)(ws + WB_KRAW), nullptr};
                run_gemm(TID, BID, lds, (const bf16_t*)(ws + WB_HKV), (const bf16_t*)(ws + WS_WDKV), T, 768, 2048, E);
            }
            const int j = ph == PH_DKV_BIN0 ? 0 : 1;
            EpiLat<1> E{(bf16_t*)(ws + WB_CQ), (float*)(ws + WB_SSQQ), nullptr, (bf16_t*)(ws + WB_Z)};
            run_gemm(TID, BID, lds, (const bf16_t*)(ws + WB_H), (const bf16_t*)(ws + WS_WINB) + (size_t)j * 2560 * 2048, T, 2560, 2048, E);
        } break;
#endif
#if PHSEL & 128
        case PH_UKV_UQ0: case PH_UQ1: {
            if (ph == PH_UKV_UQ0) {
                EpiScaled E{(bf16_t*)(ws + WB_KN), 2048, (const float*)(ws + WB_SSQKV)};
                run_gemm(TID, BID, lds, (const bf16_t*)(ws + WB_CKV), (const bf16_t*)(ws + WS_WKN), T, 2048, 512, E);
                EpiVT E2{(bf16_t*)(ws + WB_VT), (const float*)(ws + WB_SSQKV)};
                run_gemm(TID, BID, lds, (const bf16_t*)(ws + WS_WV), (const bf16_t*)(ws + WB_CKV), 2048, T, 512, E2);
            }
            const int j = ph == PH_UKV_UQ0 ? 0 : 1;
            EpiScaled E{(bf16_t*)(ws + WB_Q), 3072, (const float*)(ws + WB_SSQQ)};
            run_gemm(TID, BID, lds, (const bf16_t*)(ws + WB_CQ), (const bf16_t*)(ws + WS_WUQ) + (size_t)j * 3072 * 512, T, 3072, 512, E);
        } break;
#endif
#if PHSEL & 256
        case PH_KPOST:
            phase_kpost(TID, BID, (bf16_t*)(ws + WB_KN), (const float*)(ws + WB_KRAW), (bf16_t*)(ws + WB_KROPE), p.in[I_KV_G_KN], p.in[I_KV_G_KR], cosT, sinT, ident);
            break;
#endif
#if PHSEL & 512
        case PH_ATTN0: case PH_ATTN1: {
            const int j = ph == PH_ATTN0 ? 0 : 1;
            phase_attn(TID, BID, shm, (const bf16_t*)(ws + WB_Q), (const bf16_t*)(ws + WB_KN), (const bf16_t*)(ws + WB_KROPE), (const bf16_t*)(ws + WB_VT), (const bf16_t*)(ws + WB_Z), (bf16_t*)(ws + WB_Y),
                       p.in[I_B_G_QN] + j * 128, p.in[I_B_G_QR] + j * 64, cosT, sinT);
        } break;
#endif
        default: break;
        }
        if (pi + 1 < p.ph_hi) {
            if (pi == p.ph_lo) cg::this_grid().sync();
            else grid_bar((unsigned*)(p.ws + WS_BAR), (unsigned)(pi - p.ph_lo), TID, BID);
        }
    }
}

extern "C" void kernel_launch(void* const* d_in, const int* in_sizes, int n_in, void* d_out, int out_size, void* d_ws, size_t ws_size, hipStream_t stream) {
    static int grid = 0;
    if (grid == 0) {
        if (n_in != 25 || ws_size < WS_NEED) { fprintf(stderr, "kernel_launch: unexpected n_in %d / ws %zu (need %zu)\n", n_in, ws_size, (size_t)WS_NEED); grid = -1; return; }
        int dev = 0, cus = 0, per_cu = 0;
        hipGetDevice(&dev);
        hipDeviceGetAttribute(&cus, hipDeviceAttributeMultiprocessorCount, dev);
        if (hipFuncSetAttribute((const void*)mega, hipFuncAttributeMaxDynamicSharedMemorySize, LDS_BYTES) != hipSuccess) { fprintf(stderr, "kernel_launch: hipFuncSetAttribute failed\n"); grid = -1; return; }
        if (hipOccupancyMaxActiveBlocksPerMultiprocessor(&per_cu, (const void*)mega, 512, LDS_BYTES) != hipSuccess || per_cu < 1) { fprintf(stderr, "kernel_launch: occupancy query gave %d\n", per_cu); per_cu = 1; }
        (void)hipGetLastError();
        grid = cus * per_cu;
    }
    if (grid < 0) return;
    Params p{};
    for (int i = 0; i < 25; ++i) p.in[i] = (const float*)d_in[i];
    p.out = (float*)d_out; p.ws = (unsigned char*)d_ws;
#if MK_SINGLE
    p.ph_lo = 0; p.ph_hi = NSEQ;
    if (hipMemsetAsync((char*)d_ws + WS_BAR, 0, 4096, stream) != hipSuccess) { fprintf(stderr, "kernel_launch: memset of the barrier words failed\n"); return; }
    void* args[] = {&p};
    hipError_t e = hipLaunchCooperativeKernel((const void*)mega, dim3(grid), dim3(512), args, LDS_BYTES, stream);
    if (e != hipSuccess) fprintf(stderr, "cooperative launch failed: %s (grid %d)\n", hipGetErrorString(e), grid);
#else
    for (int ph = 0; ph < NSEQ; ++ph) {
        p.ph_lo = ph; p.ph_hi = ph + 1;
        hipLaunchKernelGGL(mega, dim3(grid), dim3(512), LDS_BYTES, stream, p);
    }
#endif
}
```

```cpp
#include <hip/hip_runtime.h>
#include <hip/hip_cooperative_groups.h>
#include <cstdio>
#include <cstdint>
namespace cg = cooperative_groups;

#ifndef PHSEL
#define PHSEL 0xFFFF
#endif
#ifndef REP_ATTN
#define REP_ATTN 1
#endif
#ifndef REP_MIX
#define REP_MIX 1
#endif
#ifndef REP_AIN
#define REP_AIN 1
#endif
#ifndef REP_GEMM
#define REP_GEMM 1
#endif
#ifndef REP_LIGHT
#define REP_LIGHT 1
#endif
#ifndef MK_SINGLE
#define MK_SINGLE 1
#endif

typedef unsigned short bf16_t;
typedef short bf16x8 __attribute__((ext_vector_type(8)));
typedef float f32x2 __attribute__((ext_vector_type(2)));
typedef float f32x4 __attribute__((ext_vector_type(4)));
typedef float f32x16 __attribute__((ext_vector_type(16)));
typedef unsigned u32x4 __attribute__((ext_vector_type(4)));
typedef unsigned u32x2 __attribute__((ext_vector_type(2)));
#define LAS __attribute__((address_space(3)))
#define GAS __attribute__((address_space(1)))

constexpr int T = 32768, DM = 2048, SEQ = 8192, NBATCH = 4;
constexpr int GMW = 4096;
constexpr float EPS = 1e-6f;
constexpr float QSCALE = 0.07216878364870322f * 1.4426950408889634f;

constexpr size_t WS_BAR = 0;
constexpr size_t WS_MOD = 4096;
constexpr size_t WS_KVMOD = WS_MOD + 4ull * 4 * 6144 * 4;
constexpr size_t WS_COS = WS_KVMOD + 4ull * 4096 * 4;
constexpr size_t WS_SIN = WS_COS + 8192ull * 32 * 4;
constexpr size_t WS_WINA = WS_SIN + 8192ull * 32 * 4;
constexpr size_t WS_WOUTA = WS_WINA + 2ull * 12288 * 2048 * 2;
constexpr size_t WS_WDKV = WS_WOUTA + 2ull * 2048 * 4096 * 2;
constexpr size_t WS_WKN = WS_WDKV + 768ull * 2048 * 2;
constexpr size_t WS_WV = WS_WKN + 2048ull * 512 * 2;
constexpr size_t WS_WINB = WS_WV + 2048ull * 512 * 2;
constexpr size_t WS_WUQ = WS_WINB + 2ull * 2560 * 2048 * 2;
constexpr size_t WS_WOUTB = WS_WUQ + 2ull * 3072 * 512 * 2;
constexpr size_t WS_WS16 = WS_WOUTB + 2ull * 2048 * 2048 * 2;
constexpr size_t WS_ACT = WS_WS16 + 2ull * 16 * 128 * 128 * 2;
constexpr size_t WA_H = WS_ACT;
constexpr size_t WA_P = WA_H + (size_t)T * 2048 * 2;
constexpr size_t WA_GVT = WA_P + (size_t)T * 4096 * 2;
constexpr size_t WA_STATS = WA_GVT + (size_t)T * 4096 * 2;
constexpr size_t WA_END = WA_STATS + (size_t)T * 32 * 2 * 4;
constexpr size_t WB_H = WS_ACT;
constexpr size_t WB_HKV = WB_H + (size_t)T * 2048 * 2;
constexpr size_t WB_Q = WS_ACT;
constexpr size_t WB_CKV = WB_HKV + (size_t)T * 2048 * 2;
constexpr size_t WB_CQ = WB_CKV + (size_t)T * 512 * 2;
constexpr size_t WB_KRAW = WB_CQ + (size_t)T * 512 * 2;
constexpr size_t WB_KROPE = WB_KRAW + (size_t)T * 64 * 4;
constexpr size_t WB_SSQKV = WB_KROPE + (size_t)T * 64 * 2;
constexpr size_t WB_SSQQ = WB_SSQKV + (size_t)T * 8 * 4;
constexpr size_t WB_Z = WB_SSQQ + (size_t)T * 8 * 4;
constexpr size_t WB_KN = WB_Z + (size_t)T * 2048 * 2;
constexpr size_t WB_VT = WB_KN + (size_t)T * 2048 * 2;
constexpr size_t WB_END = WB_VT + (size_t)T * 2048 * 2;
constexpr size_t WB_Y = WB_Q + (size_t)T * 3072 * 2;
static_assert(WB_Y + (size_t)T * 2048 * 2 == WB_KRAW, "Y overlay");
constexpr size_t WS_NEED = WA_END > WB_END ? WA_END : WB_END;
static_assert(WS_NEED <= (1ull << 30), "workspace");

constexpr int LDS_BYTES = 131072;

__device__ __forceinline__ unsigned cvt_pk_bf16(float lo, float hi) { unsigned r; asm volatile("v_cvt_pk_bf16_f32 %0, %1, %2" : "=v"(r) : "v"(lo), "v"(hi)); return r; }
__device__ __forceinline__ float bf2f(unsigned short v) { return __uint_as_float(((unsigned)v) << 16); }
__device__ __forceinline__ float bflo(unsigned w) { return __uint_as_float(w << 16); }
__device__ __forceinline__ float bfhi(unsigned w) { return __uint_as_float(w & 0xffff0000u); }
__device__ __forceinline__ float gelu_f(float x) {
    const float u = x * (1.0f + 0.044715f * x * x);
    const float e = __builtin_amdgcn_exp2f(-2.302208198f * u);
    return x * __builtin_amdgcn_rcpf(1.0f + e);
}
__device__ __forceinline__ float silu_f(float x) { const float e = __builtin_amdgcn_exp2f(-1.4426950408889634f * x); return x * __builtin_amdgcn_rcpf(1.0f + e); }
__device__ __forceinline__ u32x4 pack8f(const float* r) { u32x4 o = {cvt_pk_bf16(r[0], r[1]), cvt_pk_bf16(r[2], r[3]), cvt_pk_bf16(r[4], r[5]), cvt_pk_bf16(r[6], r[7])}; return o; }

template <class Tp> __device__ __forceinline__ Tp* uniform_ptr(Tp* p) {
    const unsigned long long v = (unsigned long long)p; const unsigned lo = __builtin_amdgcn_readfirstlane((unsigned)v), hi = __builtin_amdgcn_readfirstlane((unsigned)(v >> 32));
    return (Tp*)(GAS Tp*)(((unsigned long long)hi << 32) | lo);
}
__device__ __forceinline__ float x32_sum(float v) { auto rr = __builtin_amdgcn_permlane32_swap(__float_as_uint(v), __float_as_uint(v), false, false); return __uint_as_float(rr[0]) + __uint_as_float(rr[1]); }
__device__ __forceinline__ float x32_max(float v) { auto rr = __builtin_amdgcn_permlane32_swap(__float_as_uint(v), __float_as_uint(v), false, false); return fmaxf(__uint_as_float(rr[0]), __uint_as_float(rr[1])); }

__device__ __forceinline__ void grid_bar(unsigned* bar, const unsigned epoch, const int TID, const int BID) {
    __syncthreads();
    if (TID == 0) {
        const unsigned G = gridDim.x, g = (unsigned)BID & 7u;
        const unsigned cnt = (G + 7u - g) >> 3;
        const unsigned ngrp = G < 8u ? G : 8u;
        __builtin_amdgcn_fence(__ATOMIC_RELEASE, "agent");
        const unsigned old = __hip_atomic_fetch_add(bar + 64 * (1 + g), 1u, __ATOMIC_RELAXED, __HIP_MEMORY_SCOPE_AGENT);
        if (old + 1u == cnt * epoch) {
            __builtin_amdgcn_fence(__ATOMIC_ACQ_REL, "agent");
            __hip_atomic_fetch_add(bar, 1u, __ATOMIC_RELAXED, __HIP_MEMORY_SCOPE_AGENT);
        }
        while (__hip_atomic_load(bar, __ATOMIC_RELAXED, __HIP_MEMORY_SCOPE_AGENT) < ngrp * epoch) __builtin_amdgcn_s_sleep(1);
        __builtin_amdgcn_fence(__ATOMIC_ACQUIRE, "agent");
    }
    __syncthreads();
}

namespace pg8 {
constexpr int BM = 256, BK = 64, HALF = 128, HTB = HALF * BK * 2, STAGE_BYTES = 8 * HTB, NXCD = 8, WGM = 8;
__host__ __device__ __forceinline__ int lds_byte(int r, int c) { const int st = (r >> 4) * 2 + (c >> 5), rr = r & 15, cc = c & 31, ob = rr * 64 + cc * 2; return st * 1024 + (ob ^ (((ob >> 9) & 1) << 5)); }
__host__ __device__ __forceinline__ void stage_rc(int b, int& R, int& C) { const int st = b / 1024, sb = b % 1024, swz = sb ^ (((sb >> 9) & 1) << 5); R = (st >> 1) * 16 + swz / 64; C = (st & 1) * 32 + (swz % 64) / 2; }
__host__ __device__ __forceinline__ int perm32(int rho) { const int n = rho >> 4, i = rho & 15; return 8 * (i >> 2) + 4 * n + (i & 3); }
struct Unit { int pm, pn; };
struct Gemm { const bf16_t* A; const bf16_t* Bt; int M, N, K; int a_rs; size_t a_kstep; };
struct StaticOrder {
    int nM, nN, nwg, G, c, wgm;
    __host__ __device__ void init(int M, int N, int G_, int c_, int wgm_) { nM = M / BM; nN = N / BM; nwg = nM * nN; G = G_; c = c_; wgm = wgm_; }
    __host__ __device__ bool next(int i, Unit& u) const {
        const int L = i * G + c; if (L >= nwg) return false;
        int wgid = (int)L; { const int q = nwg / NXCD, r = nwg % NXCD, xcd = wgid % NXCD, off = wgid / NXCD; wgid = (xcd < r ? xcd * (q + 1) : r * (q + 1) + (xcd - r) * q) + off; }
        const int nig = wgm * nN, gid = wgid / nig, fm = gid * wgm, gsz = (nM - fm) < wgm ? (nM - fm) : wgm;
        u.pm = fm + ((wgid % nig) % gsz); u.pn = (wgid % nig) / gsz; return true;
    }
    __device__ __forceinline__ void a_ready(const Unit&) const {}
    __device__ __forceinline__ void done(const Unit&) const {}
};

template <class Epi, class Sched>
__device__ __forceinline__ void gemm_phase(const int TID, LAS unsigned char* lds, const Gemm g, const Sched& S, const Epi& E) {
    const int tid = TID, wid = __builtin_amdgcn_readfirstlane(tid >> 6), lane = tid & 63, wr = wid >> 2, wc = wid & 3, fr = lane & 15, fq = lane >> 4;
    const int K = g.K, nt = K / BK;
    unsigned voffA[2], voffB[2];
#pragma unroll
    for (int i = 0; i < 2; ++i) { int R, C; stage_rc(tid * 16 + i * 8192, R, C); const int Rb = Epi::PERM ? ((R & ~31) + perm32(R & 31)) : R;
        voffA[i] = (unsigned)(R * g.a_rs + C) * 2u; voffB[i] = (unsigned)(Rb * K + C) * 2u; }
    const size_t kstep = (size_t)(BK * 2), kstepA = g.a_kstep;
    const size_t hstep = (size_t)HALF * K * 2, hstepA = (size_t)HALF * g.a_rs * 2;
    const size_t tstep = 2 * hstep, tstepA = 2 * hstepA;
    const unsigned ldsw = (unsigned)wid * 1024u;
    const int aoff = lds_byte(wr * 64 + fr, fq * 8), boff = lds_byte(wc * 32 + fr, fq * 8);
#define PG8_SA(b, h) (((b) * 2 + (h)) * HTB)
#define PG8_SB(b, h) ((4 + (b) * 2 + (h)) * HTB)
#define PG8_STAGE(bufoff, gbase, voff) do { _Pragma("unroll") for (int _i = 0; _i < 2; ++_i) \
        __builtin_amdgcn_global_load_lds((const unsigned*)((const char*)(gbase) + (voff)[_i]), (LAS unsigned*)(lds + (bufoff) + ldsw + _i * 8192), 16, 0, 0); } while (0)
#define PG8_LDA(dst, b, h) do { _Pragma("unroll") for (int m = 0; m < 4; ++m) _Pragma("unroll") for (int k = 0; k < 2; ++k) dst[m][k] = *(const LAS bf16x8*)(lds + PG8_SA(b, h) + aoff + m * 2048 + k * 1024); } while (0)
#define PG8_LDB(dst, b, h) do { _Pragma("unroll") for (int n = 0; n < 2; ++n) _Pragma("unroll") for (int k = 0; k < 2; ++k) dst[n][k] = *(const LAS bf16x8*)(lds + PG8_SB(b, h) + boff + n * 2048 + k * 1024); } while (0)
#define PG8_MMA(ai, bj, At, Bt) do { __builtin_amdgcn_s_setprio(1); _Pragma("unroll") for (int m = 0; m < 4; ++m) _Pragma("unroll") for (int n = 0; n < 2; ++n) _Pragma("unroll") for (int k = 0; k < 2; ++k) \
        acc[ai][bj][m][n] = __builtin_amdgcn_mfma_f32_16x16x32_bf16(Bt[n][k], At[m][k], acc[ai][bj][m][n], 0, 0, 0); __builtin_amdgcn_s_setprio(0); } while (0)
#define PG8_WAIT_V(n) asm volatile("s_waitcnt vmcnt(" #n ")" ::: "memory")
#define PG8_WAIT_L(n) asm volatile("s_waitcnt lgkmcnt(" #n ")" ::: "memory")
#define PG8_BAR __builtin_amdgcn_s_barrier()
#define PG8_SCHED __builtin_amdgcn_sched_barrier(0)
    Unit cur, nxt; int ui = 0;
    if (!S.next(0, cur)) return;
    f32x4 acc[2][2][4][2];
#pragma unroll
    for (int a = 0; a < 2; ++a)
#pragma unroll
        for (int b = 0; b < 2; ++b)
#pragma unroll
            for (int m = 0; m < 4; ++m)
#pragma unroll
                for (int n = 0; n < 2; ++n) acc[a][b][m][n] = (f32x4){0.f, 0.f, 0.f, 0.f};
    bf16x8 At[4][2], B0[2][2], B1[2][2];
    const char* cA = (const char*)g.A + (size_t)cur.pm * tstepA; const char* cB = (const char*)g.Bt + (size_t)cur.pn * tstep;
    S.a_ready(cur);
    PG8_STAGE(PG8_SB(0, 0), cB, voffB); PG8_STAGE(PG8_SA(0, 0), cA, voffA); PG8_STAGE(PG8_SB(0, 1), cB + hstep, voffB); PG8_STAGE(PG8_SA(0, 1), cA + hstepA, voffA);
    if (wr == 1) PG8_BAR;
    PG8_WAIT_V(4); PG8_BAR;
    PG8_STAGE(PG8_SB(1, 0), cB + kstep, voffB); PG8_STAGE(PG8_SA(1, 0), cA + kstepA, voffA); PG8_STAGE(PG8_SB(1, 1), cB + hstep + kstep, voffB);
    PG8_WAIT_V(6); PG8_BAR;
    for (;;) {
        const bool has_next = S.next(ui + 1, nxt);
        const char* nA = has_next ? (const char*)g.A + (size_t)nxt.pm * tstepA : cA; const char* nB = has_next ? (const char*)g.Bt + (size_t)nxt.pn * tstep : cB;
        for (int t = 0; t < nt; t += 2) {
            const bool last = (t == nt - 2);
            const char* a1 = cA + (size_t)(t + 1) * kstepA;
            const char* a2 = last ? nA : cA + (size_t)(t + 2) * kstepA; const char* b2 = last ? nB : cB + (size_t)(t + 2) * kstep;
            const char* a3 = a2 + kstepA; const char* b3 = b2 + kstep;
            if (last && has_next) S.a_ready(nxt);
            PG8_LDB(B0, 0, 0); PG8_SCHED; PG8_LDA(At, 0, 0); PG8_STAGE(PG8_SA(1, 1), a1 + hstepA, voffA);
            PG8_WAIT_L(8); PG8_BAR; PG8_WAIT_L(0); PG8_MMA(0, 0, At, B0); PG8_BAR; PG8_SCHED;
            PG8_LDB(B1, 0, 1); PG8_STAGE(PG8_SB(0, 0), b2, voffB);
            PG8_BAR; PG8_WAIT_L(0); PG8_MMA(0, 1, At, B1); PG8_BAR;
            PG8_LDA(At, 0, 1); PG8_STAGE(PG8_SA(0, 0), a2, voffA);
            PG8_BAR; PG8_WAIT_L(0); PG8_MMA(1, 0, At, B0); PG8_BAR; PG8_SCHED;
            PG8_STAGE(PG8_SB(0, 1), b2 + hstep, voffB);
            PG8_WAIT_V(6); PG8_BAR; PG8_MMA(1, 1, At, B1); PG8_BAR;
            PG8_LDB(B0, 1, 0); PG8_SCHED; PG8_LDA(At, 1, 0); PG8_STAGE(PG8_SA(0, 1), a2 + hstepA, voffA);
            PG8_WAIT_L(8); PG8_BAR; PG8_WAIT_L(0); PG8_MMA(0, 0, At, B0); PG8_BAR; PG8_SCHED;
            PG8_LDB(B1, 1, 1); PG8_STAGE(PG8_SB(1, 0), b3, voffB);
            PG8_BAR; PG8_WAIT_L(0); PG8_MMA(0, 1, At, B1); PG8_BAR;
            PG8_LDA(At, 1, 1); PG8_STAGE(PG8_SA(1, 0), a3, voffA);
            PG8_BAR; PG8_WAIT_L(0); PG8_MMA(1, 0, At, B0); PG8_BAR; PG8_SCHED;
            PG8_STAGE(PG8_SB(1, 1), b3 + hstep, voffB);
            PG8_WAIT_V(6); PG8_BAR; PG8_MMA(1, 1, At, B1); PG8_BAR;
        }
        E(acc, cur, wr, wc, fr, fq);
        if (!has_next) break;
#pragma unroll
        for (int a = 0; a < 2; ++a)
#pragma unroll
            for (int b = 0; b < 2; ++b)
#pragma unroll
                for (int m = 0; m < 4; ++m)
#pragma unroll
                    for (int n = 0; n < 2; ++n) acc[a][b][m][n] = (f32x4){0.f, 0.f, 0.f, 0.f};
        cur = nxt; cA = nA; cB = nB; ++ui;
    }
    PG8_WAIT_V(0);
    if (wr == 0) PG8_BAR;
    PG8_BAR;
#undef PG8_SA
#undef PG8_SB
#undef PG8_STAGE
#undef PG8_LDA
#undef PG8_LDB
#undef PG8_MMA
#undef PG8_WAIT_V
#undef PG8_WAIT_L
#undef PG8_BAR
#undef PG8_SCHED
}
}
using pg8::Unit;

struct EpiUZ {
    static constexpr bool PERM = true;
    bf16_t* P;
    __device__ __forceinline__ void operator()(const f32x4 (&acc)[2][2][4][2], const Unit& u, int wr, int wc, int fr_, int fq_) const {
        int fr = fr_, fq = fq_; asm volatile("" : "+v"(fr), "+v"(fq));
        const int row0 = u.pm * 256 + wr * 64 + fr;
        const int col = u.pn * 128 + wc * 32 + 8 * fq;
#pragma unroll
        for (int ai = 0; ai < 2; ++ai)
#pragma unroll
            for (int m = 0; m < 4; ++m) {
                const size_t row = (size_t)(row0 + ai * 128 + m * 16);
                float r[8];
#pragma unroll
                for (int n = 0; n < 2; ++n)
#pragma unroll
                    for (int i = 0; i < 4; ++i) {
                        const float uu = acc[ai][0][m][n][i], zz = acc[ai][1][m][n][i];
                        const float eu = __builtin_amdgcn_exp2f(-2.302208198f * (uu * (1.0f + 0.044715f * uu * uu)));
                        const float ez = __builtin_amdgcn_exp2f(-1.4426950408889634f * zz);
                        r[4 * n + i] = (uu * zz) * __builtin_amdgcn_rcpf((1.0f + eu) * (1.0f + ez));
                    }
                *(u32x4*)(P + ((size_t)(col >> 6) * T + row) * 64 + (col & 63)) = pack8f(r);
            }
    }
};
struct EpiGVT {
    static constexpr bool PERM = true;
    bf16_t* GVT; float* stats;
    __device__ __forceinline__ void operator()(const f32x4 (&acc)[2][2][4][2], const Unit& u, int wr, int wc, int fr_, int fq_) const {
        int fr = fr_, fq = fq_; asm volatile("" : "+v"(fr), "+v"(fq));
        const int row0 = u.pm * 256 + wr * 64 + fr;
        const int tok0 = u.pn * 256 + wc * 32 + 8 * fq;
        float s[16], ss[16];
#pragma unroll
        for (int j = 0; j < 16; ++j) { s[j] = 0.f; ss[j] = 0.f; }
#pragma unroll
        for (int ai = 0; ai < 2; ++ai)
#pragma unroll
            for (int m = 0; m < 4; ++m) {
                const size_t row = (size_t)(row0 + ai * 128 + m * 16);
#pragma unroll
                for (int bj = 0; bj < 2; ++bj) {
                    float r[8];
#pragma unroll
                    for (int n = 0; n < 2; ++n)
#pragma unroll
                        for (int i = 0; i < 4; ++i) r[4 * n + i] = gelu_f(acc[ai][bj][m][n][i]);
                    const u32x4 o = pack8f(r);
#pragma unroll
                    for (int q = 0; q < 4; ++q) { const float a = bflo(o[q]), b = bfhi(o[q]); s[bj * 8 + 2 * q] += a; ss[bj * 8 + 2 * q] += a * a; s[bj * 8 + 2 * q + 1] += b; ss[bj * 8 + 2 * q + 1] += b * b; }
                    *(u32x4*)(GVT + row * T + tok0 + bj * 128) = o;
                }
            }
#pragma unroll
        for (int step = 0; step < 4; ++step) {
            const int msk = 8 >> step, cnt = 8 >> step;
            const bool up = (fr & msk) != 0;
#pragma unroll
            for (int j = 0; j < 8; ++j) {
                if (j < cnt) {
                    const float send_s = up ? s[j] : s[j + cnt], keep_s = up ? s[j + cnt] : s[j];
                    const float send_q = up ? ss[j] : ss[j + cnt], keep_q = up ? ss[j + cnt] : ss[j];
                    s[j] = keep_s + __shfl_xor(send_s, msk);
                    ss[j] = keep_q + __shfl_xor(send_q, msk);
                }
            }
        }
        {
            const int j = fr;
            const size_t tok = (size_t)(tok0 + 128 * (j >> 3) + (j & 7));
            f32x2 st = {s[0], ss[0]};
            *(f32x2*)(stats + (tok * 32 + u.pm * 2 + wr) * 2) = st;
        }
    }
};
struct EpiRes {
    static constexpr bool PERM = false;
    const float* xin; float* xout; const float* gate;
    int ldg;
    __device__ __forceinline__ void operator()(const f32x4 (&acc)[2][2][4][2], const Unit& u, int wr, int wc, int fr_, int fq_) const {
        int fr = fr_, fq = fq_; asm volatile("" : "+v"(fr), "+v"(fq));
        const int row0 = u.pm * 256 + wr * 64 + fr, col0 = u.pn * 256 + wc * 32 + 4 * fq;
        const float* gp = gate + (size_t)(u.pm >> 5) * ldg + col0;
        f32x4 gv[2][2];
#pragma unroll
        for (int bj = 0; bj < 2; ++bj)
#pragma unroll
            for (int n = 0; n < 2; ++n) gv[bj][n] = *(const f32x4*)(gp + bj * 128 + n * 16);
#pragma unroll
        for (int ai = 0; ai < 2; ++ai)
#pragma unroll
            for (int m = 0; m < 4; ++m) {
                const size_t off = (size_t)(row0 + ai * 128 + m * 16) * DM + col0;
#pragma unroll
                for (int bj = 0; bj < 2; ++bj)
#pragma unroll
                    for (int n = 0; n < 2; ++n) {
                        const f32x4 xo = *(const f32x4*)(xin + off + bj * 128 + n * 16);
                        *(f32x4*)(xout + off + bj * 128 + n * 16) = xo + gv[bj][n] * acc[ai][bj][m][n];
                    }
            }
    }
};
template <int MODE> struct EpiLat {
    static constexpr bool PERM = true;
    bf16_t* C; float* ssq; float* kr; bf16_t* Z;
    __device__ __forceinline__ void operator()(const f32x4 (&acc)[2][2][4][2], const Unit& u, int wr, int wc, int fr_, int fq_) const {
        int fr = fr_, fq = fq_; asm volatile("" : "+v"(fr), "+v"(fq));
        const int row0 = u.pm * 256 + wr * 64 + fr;
        if (u.pn < 2) {
#pragma unroll
            for (int ai = 0; ai < 2; ++ai)
#pragma unroll
                for (int m = 0; m < 4; ++m) {
                    const size_t row = (size_t)(row0 + ai * 128 + m * 16);
                    float ss = 0.f;
#pragma unroll
                    for (int bj = 0; bj < 2; ++bj) {
                        const int col = u.pn * 256 + bj * 128 + wc * 32 + 8 * fq;
                        float r[8];
#pragma unroll
                        for (int n = 0; n < 2; ++n)
#pragma unroll
                            for (int i = 0; i < 4; ++i) { r[4 * n + i] = acc[ai][bj][m][n][i]; ss += r[4 * n + i] * r[4 * n + i]; }
                        *(u32x4*)(C + row * 512 + col) = pack8f(r);
                    }
                    ss += __shfl_xor(ss, 16); ss += __shfl_xor(ss, 32);
                    if (fq == 0) ssq[row * 8 + u.pn * 4 + wc] = ss;
                }
        } else if (MODE == 0) {
            if (u.pn == 2 && wc < 2) {
#pragma unroll
                for (int ai = 0; ai < 2; ++ai)
#pragma unroll
                    for (int m = 0; m < 4; ++m) {
                        const size_t row = (size_t)(row0 + ai * 128 + m * 16);
                        *(f32x4*)(kr + row * 64 + wc * 32 + 8 * fq) = acc[ai][0][m][0];
                        *(f32x4*)(kr + row * 64 + wc * 32 + 8 * fq + 4) = acc[ai][0][m][1];
                    }
            }
        } else {
#pragma unroll
            for (int ai = 0; ai < 2; ++ai)
#pragma unroll
                for (int m = 0; m < 4; ++m) {
                    const size_t row = (size_t)(row0 + ai * 128 + m * 16);
#pragma unroll
                    for (int bj = 0; bj < 2; ++bj) {
                        const int col = (u.pn - 2) * 256 + bj * 128 + wc * 32 + 8 * fq;
                        float r[8];
#pragma unroll
                        for (int n = 0; n < 2; ++n)
#pragma unroll
                            for (int i = 0; i < 4; ++i) r[4 * n + i] = silu_f(acc[ai][bj][m][n][i]);
                        *(u32x4*)(Z + row * 2048 + col) = pack8f(r);
                    }
                }
        }
    }
};
struct EpiScaled {
    static constexpr bool PERM = true;
    bf16_t* O; int ldc; const float* ssq;
    __device__ __forceinline__ void operator()(const f32x4 (&acc)[2][2][4][2], const Unit& u, int wr, int wc, int fr_, int fq_) const {
        int fr = fr_, fq = fq_; asm volatile("" : "+v"(fr), "+v"(fq));
        const int row0 = u.pm * 256 + wr * 64 + fr;
#pragma unroll
        for (int ai = 0; ai < 2; ++ai)
#pragma unroll
            for (int m = 0; m < 4; ++m) {
                const size_t row = (size_t)(row0 + ai * 128 + m * 16);
                const f32x4 a = *(const f32x4*)(ssq + row * 8), b = *(const f32x4*)(ssq + row * 8 + 4);
                const float rs = rsqrtf(((a[0] + a[1] + a[2] + a[3] + b[0] + b[1] + b[2] + b[3]) + EPS * 512.0f) * (1.0f / 512.0f));
#pragma unroll
                for (int bj = 0; bj < 2; ++bj) {
                    const int col = u.pn * 256 + bj * 128 + wc * 32 + 8 * fq;
                    float r[8];
#pragma unroll
                    for (int n = 0; n < 2; ++n)
#pragma unroll
                        for (int i = 0; i < 4; ++i) r[4 * n + i] = acc[ai][bj][m][n][i] * rs;
                    *(u32x4*)(O + row * ldc + col) = pack8f(r);
                }
            }
    }
};
struct EpiVT {
    static constexpr bool PERM = false;
    bf16_t* VT; const float* ssq;
    __device__ __forceinline__ void operator()(const f32x4 (&acc)[2][2][4][2], const Unit& u, int wr, int wc, int fr_, int fq_) const {
        int fr = fr_, fq = fq_; asm volatile("" : "+v"(fr), "+v"(fq));
        const int row0 = u.pm * 256 + wr * 64 + fr;
        const int pg = ((fq & 1) << 1) | (fq >> 1);
#pragma unroll
        for (int bj = 0; bj < 2; ++bj)
#pragma unroll
            for (int n = 0; n < 2; ++n) {
                const int tb = u.pn * 256 + bj * 128 + wc * 32 + 16 * n;
                const int tok0 = tb + 4 * fq;
                f32x4 rs;
#pragma unroll
                for (int i = 0; i < 4; ++i) {
                    const f32x4 a = *(const f32x4*)(ssq + (size_t)(tok0 + i) * 8), b = *(const f32x4*)(ssq + (size_t)(tok0 + i) * 8 + 4);
                    rs[i] = rsqrtf(((a[0] + a[1] + a[2] + a[3] + b[0] + b[1] + b[2] + b[3]) + EPS * 512.0f) * (1.0f / 512.0f));
                }
                const int pos0 = tb + 4 * pg;
#pragma unroll
                for (int ai = 0; ai < 2; ++ai)
#pragma unroll
                    for (int m = 0; m < 4; ++m) {
                        const size_t row = (size_t)(row0 + ai * 128 + m * 16);
                        const f32x4 v = acc[ai][bj][m][n] * rs;
                        u32x2 o = {cvt_pk_bf16(v[0], v[1]), cvt_pk_bf16(v[2], v[3])};
                        *(u32x2*)(VT + row * T + pos0) = o;
                    }
            }
    }
};

template <class Epi> __device__ __forceinline__ void run_gemm(const int TID, const int BID, LAS unsigned char* lds, const bf16_t* A, const bf16_t* Bt, int M, int N, int K, const Epi& E, const bool a_blocked = false) {
    pg8::Gemm g{A, Bt, M, N, K, a_blocked ? 64 : K, a_blocked ? (size_t)M * 128 : (size_t)128}; pg8::StaticOrder S; S.init(M, N, (int)gridDim.x, (int)BID, 4);
    int tid_ = TID; asm volatile("" : "+v"(tid_));
    pg8::gemm_phase<Epi, pg8::StaticOrder>(tid_, lds, g, S, E);
}

struct Params {
    const float* in[25];
    float* out;
    unsigned char* ws;
    int ph_lo, ph_hi;
};
enum { I_X = 0, I_C, I_ADA_W, I_ADA_B, I_NORM_G, I_A_W_IN, I_A_LN_G, I_A_LN_B, I_A_W_S, I_A_B_S, I_A_W_OUT, I_KV_ADA_W, I_KV_ADA_B, I_KV_NORM_G, I_KV_W_DKV, I_KV_G_KVA,
       I_KV_W_UKV, I_KV_G_KN, I_KV_G_KR, I_B_W_IN, I_B_G_QA, I_B_W_UQ, I_B_G_QN, I_B_G_QR, I_B_W_OUT };

__device__ __forceinline__ void conv_tile(const int TID, unsigned char* shm, const float* src, int ldsrc, int srccol0, int K, int k0, bf16_t* dst, int n0, const float* scale) {
    float* tile = (float*)shm;
    const int tid = TID;
    {
        const int kk = tid >> 4, c4 = tid & 15;
        f32x4 v[8];
#pragma unroll
        for (int i = 0; i < 8; ++i) {
            v[i] = (f32x4){0.f, 0.f, 0.f, 0.f};
            if (srccol0 >= 0) v[i] = *(const f32x4*)(src + (size_t)(k0 + kk + 32 * i) * ldsrc + srccol0 + 4 * c4);
        }
#pragma unroll
        for (int i = 0; i < 8; ++i) { float* tp = tile + (kk + 32 * i) * 65 + 4 * c4; tp[0] = v[i][0]; tp[1] = v[i][1]; tp[2] = v[i][2]; tp[3] = v[i][3]; }
    }
    __syncthreads();
    {
        const int n = tid >> 3, k8 = tid & 7;
#pragma unroll
        for (int jb = 0; jb < 4; ++jb) {
            float r[8];
#pragma unroll
            for (int j = 0; j < 8; ++j) { r[j] = tile[(64 * jb + 8 * k8 + j) * 65 + n]; if (scale) r[j] *= scale[k0 + 64 * jb + 8 * k8 + j]; }
            *(u32x4*)(dst + (size_t)(n0 + n) * K + k0 + 64 * jb + 8 * k8) = pack8f(r);
        }
    }
    __syncthreads();
}

__device__ __forceinline__ void phase_prep(const int TID, const int BID, const Params& p, unsigned char* ws, unsigned char* shm) {
    const int tid = TID;
    {
        float* cosT = (float*)(ws + WS_COS); float* sinT = (float*)(ws + WS_SIN);
        for (int idx = BID * 512 + tid; idx < SEQ * 32; idx += gridDim.x * 512) {
            const int pos = idx >> 5, i = idx & 31;
            double f = 1.0; for (int q = 0; q < i; ++q) f *= 0.7498942093324559;
            const float invf = (float)f;
            const float ang = (float)pos * invf;
            const double ad = (double)ang;
            const double n = rint(ad * 0.15915494309189535);
            const double r = ad - n * 6.283185307179586;
            const double r2 = r * r;
            double s = 1.0, c = 1.0;
#pragma unroll 1
            for (int k = 14; k >= 1; --k) { s = 1.0 - s * r2 / (double)((2 * k) * (2 * k + 1)); c = 1.0 - c * r2 / (double)((2 * k - 1) * (2 * k)); }
            cosT[idx] = (float)c; sinT[idx] = (float)(r * s);
        }
    }
    if (BID < 224) {
        float* sc = (float*)shm;
        float* red = (float*)(shm + 32768);
        const float* cin = p.in[I_C];
        for (int i = tid; i < 4 * 2048; i += 512) sc[i] = silu_f(cin[i]);
        __syncthreads();
        const int item = BID;
        const float* W; const float* bias; float* out; int ldw, cb;
        if (item < 192) { const int l = item / 48; cb = item % 48; W = p.in[I_ADA_W] + (size_t)l * 2048 * 6144; ldw = 6144; bias = p.in[I_ADA_B] + l * 6144; out = (float*)(ws + WS_MOD) + (size_t)l * 4 * 6144; }
        else { cb = item - 192; W = p.in[I_KV_ADA_W]; ldw = 4096; bias = p.in[I_KV_ADA_B]; out = (float*)(ws + WS_KVMOD); }
        const int cgp = tid & 31, kg = tid >> 5;
        const float* wp = W + (size_t)(kg * 128) * ldw + cb * 128 + cgp * 4;
        f32x4 a0 = {0.f, 0.f, 0.f, 0.f}, a1 = a0, a2 = a0, a3 = a0;
#pragma unroll 8
        for (int k = 0; k < 128; ++k) {
            const f32x4 w = *(const f32x4*)(wp + (size_t)k * ldw);
            const int kk = kg * 128 + k;
            a0 += w * sc[kk]; a1 += w * sc[2048 + kk]; a2 += w * sc[4096 + kk]; a3 += w * sc[6144 + kk];
        }
        float* rp = red + ((size_t)kg * 128 + cgp * 4) * 4;
#pragma unroll
        for (int e = 0; e < 4; ++e) { rp[e * 4 + 0] = a0[e]; rp[e * 4 + 1] = a1[e]; rp[e * 4 + 2] = a2[e]; rp[e * 4 + 3] = a3[e]; }
        __syncthreads();
        {
            const int col = tid >> 2, b = tid & 3;
            float s = 0.f;
#pragma unroll
            for (int g = 0; g < 16; ++g) s += red[((size_t)g * 128 + col) * 4 + b];
            out[(size_t)b * ldw + cb * 128 + col] = s + bias[cb * 128 + col];
        }
        __syncthreads();
    }
    {
        const float* wsrc = p.in[I_A_W_S]; bf16_t* wdst = (bf16_t*)(ws + WS_WS16);
        for (int idx = BID * 512 + TID; idx < 2 * 16 * 128 * 128 / 4; idx += gridDim.x * 512) {
            const int e = idx * 4, s4 = e & 127, t = (e >> 7) & 127;
            f32x4 w = *(const f32x4*)(wsrc + e);
#pragma unroll
            for (int q = 0; q < 4; ++q) if (s4 + q > t) w[q] = 0.f;
            u32x2 o = {cvt_pk_bf16(w[0], w[1]), cvt_pk_bf16(w[2], w[3])};
            *(u32x2*)(wdst + e) = o;
        }
    }
    {
        constexpr int NJ = 13;
        const int ntile[NJ] = {1536, 1536, 512, 512, 96, 64, 64, 320, 320, 96, 96, 256, 256};
        int total = 0;
#pragma unroll
        for (int j = 0; j < NJ; ++j) total += ntile[j];
        for (int tix = BID; tix < total; tix += gridDim.x) {
            int j = 0, rem = tix;
#pragma unroll
            for (int q = 0; q < NJ; ++q) { if (j == q && rem >= ntile[q]) { rem -= ntile[q]; j = q + 1; } }
            const float* src; int ldsrc, K; bf16_t* dst; const float* scale = nullptr; int srccol0, n0, k0;
            if (j < 2) {
                K = 2048; ldsrc = 12288; src = p.in[I_A_W_IN] + (size_t)j * 2048 * 12288; dst = (bf16_t*)(ws + WS_WINA) + (size_t)j * 12288 * 2048;
                const int nt_ = rem / 8; k0 = (rem % 8) * 256; n0 = nt_ * 64;
                const int pn = n0 >> 8, jj = n0 & 255;
                srccol0 = pn < 32 ? (jj < 128 ? 128 * pn + jj : 8192 + 128 * pn + (jj - 128)) : 4096 + 256 * (pn - 32) + jj;
            } else if (j < 4) {
                const int l = j - 2; K = 4096; ldsrc = 2048; src = p.in[I_A_W_OUT] + (size_t)l * 4096 * 2048; dst = (bf16_t*)(ws + WS_WOUTA) + (size_t)l * 2048 * 4096;
                const int nt_ = rem / 16; k0 = (rem % 16) * 256; n0 = nt_ * 64; srccol0 = n0;
            } else if (j == 4) {
                K = 2048; ldsrc = 576; src = p.in[I_KV_W_DKV]; dst = (bf16_t*)(ws + WS_WDKV);
                const int nt_ = rem / 8; k0 = (rem % 8) * 256; n0 = nt_ * 64; srccol0 = n0 < 576 ? n0 : -1;
            } else if (j < 7) {
                K = 512; ldsrc = 4096; src = p.in[I_KV_W_UKV]; dst = (bf16_t*)(ws + (j == 5 ? WS_WKN : WS_WV)); scale = p.in[I_KV_G_KVA];
                const int nt_ = rem / 2; k0 = (rem % 2) * 256; n0 = nt_ * 64;
                srccol0 = (n0 >> 7) * 256 + (j == 6 ? 128 : 0) + (n0 & 127);
            } else if (j < 9) {
                const int l = j - 7; K = 2048; ldsrc = 2560; src = p.in[I_B_W_IN] + (size_t)l * 2048 * 2560; dst = (bf16_t*)(ws + WS_WINB) + (size_t)l * 2560 * 2048;
                const int nt_ = rem / 8; k0 = (rem % 8) * 256; n0 = nt_ * 64; srccol0 = n0;
            } else if (j < 11) {
                const int l = j - 9; K = 512; ldsrc = 3072; src = p.in[I_B_W_UQ] + (size_t)l * 512 * 3072; dst = (bf16_t*)(ws + WS_WUQ) + (size_t)l * 3072 * 512; scale = p.in[I_B_G_QA] + l * 512;
                const int nt_ = rem / 2; k0 = (rem % 2) * 256; n0 = nt_ * 64; srccol0 = n0;
            } else {
                const int l = j - 11; K = 2048; ldsrc = 2048; src = p.in[I_B_W_OUT] + (size_t)l * 2048 * 2048; dst = (bf16_t*)(ws + WS_WOUTB) + (size_t)l * 2048 * 2048;
                const int nt_ = rem / 8; k0 = (rem % 8) * 256; n0 = nt_ * 64; srccol0 = n0;
            }
            conv_tile(TID, shm, src, ldsrc, srccol0, K, k0, dst, n0, scale);
        }
    }
}

__device__ __forceinline__ void phase_norm(const int TID, const int BID, const float* x, const float* g1, const float* sh1, const float* sc1, int ld1, bf16_t* h1,
                           const float* g2, const float* sh2, const float* sc2, int ld2, bf16_t* h2) {
    const int lane = TID & 63, wid = TID >> 6;
    for (int row = BID * 8 + wid; row < T; row += gridDim.x * 8) {
        const int b = row >> 13;
        const f32x4* xr = (const f32x4*)(x + (size_t)row * DM);
        f32x4 v[8]; float ss = 0.f;
#pragma unroll
        for (int i = 0; i < 8; ++i) { v[i] = xr[lane + 64 * i]; ss += v[i][0] * v[i][0] + v[i][1] * v[i][1] + v[i][2] * v[i][2] + v[i][3] * v[i][3]; }
#pragma unroll
        for (int o = 32; o >= 1; o >>= 1) ss += __shfl_xor(ss, o);
        const float rs = rsqrtf((ss + EPS * 2048.0f) * (1.0f / 2048.0f));
#pragma unroll
        for (int i = 0; i < 8; ++i) {
            const int k = 4 * (lane + 64 * i);
            const f32x4 gg = *(const f32x4*)(g1 + k), sc = *(const f32x4*)(sc1 + (size_t)b * ld1 + k), sh = *(const f32x4*)(sh1 + (size_t)b * ld1 + k);
            const f32x4 o = (v[i] * rs) * gg * (sc + 1.0f) + sh;
            u32x2 w = {cvt_pk_bf16(o[0], o[1]), cvt_pk_bf16(o[2], o[3])};
            *(u32x2*)(h1 + (size_t)row * DM + k) = w;
        }
        if (h2) {
#pragma unroll
            for (int i = 0; i < 8; ++i) {
                const int k = 4 * (lane + 64 * i);
                const f32x4 gg = *(const f32x4*)(g2 + k), sc = *(const f32x4*)(sc2 + (size_t)b * ld2 + k), sh = *(const f32x4*)(sh2 + (size_t)b * ld2 + k);
                const f32x4 o = (v[i] * rs) * gg * (sc + 1.0f) + sh;
                u32x2 w = {cvt_pk_bf16(o[0], o[1]), cvt_pk_bf16(o[2], o[3])};
                *(u32x2*)(h2 + (size_t)row * DM + k) = w;
            }
        }
    }
}

__device__ __forceinline__ void phase_mix(const int TID, const int BID, unsigned char* shm, bf16_t* P, const bf16_t* GVT, const float* stats, const bf16_t* ws16, const float* b_s, const float* ln_g, const float* ln_b, const bool ident) {
    constexpr int LD = 136;
    bf16_t* VTl = (bf16_t*)shm;
    bf16_t* WsL = (bf16_t*)(shm + 256 * LD * 2);
    float* st = (float*)(shm + 256 * LD * 2 + 128 * LD * 2);
    const int tid = TID, lane = tid & 63, wid = tid >> 6, l15 = lane & 15, l4 = lane >> 4;
    for (int chunk = BID; chunk < T / 128; chunk += gridDim.x) {
        const int t0 = chunk * 128;
        __syncthreads();
        if (tid < 128) {
            const f32x4* sp = (const f32x4*)(stats + (size_t)(t0 + tid) * 64);
            float s = 0.f, ss = 0.f;
#pragma unroll
            for (int i = 0; i < 16; ++i) { const f32x4 v = sp[i]; s += v[0] + v[2]; ss += v[1] + v[3]; }
            const float mean = s * (1.0f / 4096.0f);
            const float var = ss * (1.0f / 4096.0f) - mean * mean;
            st[2 * tid] = mean; st[2 * tid + 1] = rsqrtf(fmaxf(var, 0.f) + EPS);
        }
        __syncthreads();
        for (int g = 0; g < 16; ++g) {
#pragma unroll
            for (int i = 0; i < 4; ++i) {
                const int id = tid + 512 * i, t = id >> 4, s8 = (id & 15) * 8;
                *(u32x4*)(WsL + t * LD + s8) = *(const u32x4*)(ws16 + ((size_t)g * 128 + t) * 128 + s8);
            }
#pragma unroll
            for (int i = 0; i < 8; ++i) {
                const int id = tid + 512 * i, c = id >> 4, s8 = (id & 15) * 8;
                const u32x4 raw = *(const u32x4*)(GVT + (size_t)(g * 256 + c) * T + t0 + s8);
                const float gg = ln_g[g * 256 + c], bb = ln_b[g * 256 + c];
                float r[8];
#pragma unroll
                for (int q = 0; q < 4; ++q) { r[2 * q] = bflo(raw[q]); r[2 * q + 1] = bfhi(raw[q]); }
#pragma unroll
                for (int q = 0; q < 4; ++q) {
                    const f32x4 mr = *(const f32x4*)(st + 2 * (s8 + 2 * q));
                    r[2 * q] = (r[2 * q] - mr[0]) * mr[1] * gg + bb;
                    r[2 * q + 1] = (r[2 * q + 1] - mr[2]) * mr[3] * gg + bb;
                }
                *(u32x4*)(VTl + c * LD + s8) = pack8f(r);
            }
            __syncthreads();
            f32x4 acc[2][8];
#pragma unroll
            for (int cb = 0; cb < 2; ++cb)
#pragma unroll
                for (int tb = 0; tb < 8; ++tb) acc[cb][tb] = (f32x4){0.f, 0.f, 0.f, 0.f};
#pragma unroll
            for (int ks = 0; ks < 4; ++ks) {
                bf16x8 vf[2];
#pragma unroll
                for (int cb = 0; cb < 2; ++cb) vf[cb] = *(const bf16x8*)(VTl + (wid * 32 + cb * 16 + l15) * LD + ks * 32 + l4 * 8);
#pragma unroll
                for (int tb = 0; tb < 8; ++tb) {
                    if (tb >= 2 * ks) {
                        const bf16x8 wf = *(const bf16x8*)(WsL + (tb * 16 + l15) * LD + ks * 32 + l4 * 8);
#pragma unroll
                        for (int cb = 0; cb < 2; ++cb) acc[cb][tb] = __builtin_amdgcn_mfma_f32_16x16x32_bf16(vf[cb], wf, acc[cb][tb], 0, 0, 0);
                    }
                }
            }
            __syncthreads();
            {
                bf16_t* OutL = (bf16_t*)shm;
#pragma unroll
                for (int tb = 0; tb < 8; ++tb) {
                    const int t = tb * 16 + l15;
                    const float bs = b_s[g * 128 + t];
#pragma unroll
                    for (int cb = 0; cb < 2; ++cb) {
                        const f32x4 a = acc[cb][tb];
                        u32x2 o = {cvt_pk_bf16(a[0] + bs, a[1] + bs), cvt_pk_bf16(a[2] + bs, a[3] + bs)};
                        *(u32x2*)(OutL + t * 264 + wid * 32 + cb * 16 + l4 * 4) = o;
                    }
                }
                __syncthreads();
#pragma unroll
                for (int i = 0; i < 8; ++i) {
                    const int id = tid + 512 * i, blk = id >> 10, t = (id >> 3) & 127, c8 = (id & 7) * 8;
                    bf16_t* pp = P + ((size_t)(g * 4 + blk) * T + t0 + t) * 64 + c8;
                    const u32x4 pv = *(const u32x4*)pp;
                    const u32x4 mv = *(const u32x4*)(OutL + t * 264 + blk * 64 + c8);
                    u32x4 o;
#pragma unroll
                    for (int q = 0; q < 4; ++q) o[q] = ident ? (pv[q] | (mv[q] & 0u)) : cvt_pk_bf16(bflo(pv[q]) * bflo(mv[q]), bfhi(pv[q]) * bfhi(mv[q]));
                    *(u32x4*)pp = o;
                }
            }
            __syncthreads();
        }
    }
}

__device__ __forceinline__ void phase_kpost(const int TID, const int BID, bf16_t* KN, const float* KRAW, bf16_t* KROPE, const float* g_kn, const float* g_kr, const float* cosT, const float* sinT, const bool ident) {
    const int lane = TID & 63, wid = TID >> 6;
    const int gw = BID * 8 + wid, nw = gridDim.x * 8;
    {
        const int sub = lane >> 4, l16 = lane & 15;
        const f32x4 ga = *(const f32x4*)(g_kn + l16 * 8), gb = *(const f32x4*)(g_kn + l16 * 8 + 4);
        const size_t nrows = (size_t)T * 16;
        for (size_t r0 = (size_t)gw * 4 + sub; r0 < nrows; r0 += (size_t)nw * 16) {
            u32x4 raw[4];
#pragma unroll
            for (int u = 0; u < 4; ++u) { const size_t r = r0 + (size_t)u * nw * 4; if (r < nrows) raw[u] = *(const u32x4*)(KN + r * 128 + l16 * 8); }
#pragma unroll
            for (int u = 0; u < 4; ++u) {
                const size_t r = r0 + (size_t)u * nw * 4;
                float v[8]; float ss = 0.f;
#pragma unroll
                for (int q = 0; q < 4; ++q) { v[2 * q] = bflo(raw[u][q]); v[2 * q + 1] = bfhi(raw[u][q]); ss += v[2 * q] * v[2 * q] + v[2 * q + 1] * v[2 * q + 1]; }
                ss += __shfl_xor(ss, 1); ss += __shfl_xor(ss, 2); ss += __shfl_xor(ss, 4); ss += __shfl_xor(ss, 8);
                const float rs = rsqrtf((ss + EPS * 128.0f) * (1.0f / 128.0f));
#pragma unroll
                for (int e = 0; e < 8; ++e) v[e] = v[e] * rs * (e < 4 ? ga[e & 3] : gb[e & 3]);
                if (r < nrows) *(u32x4*)(KN + r * 128 + l16 * 8) = ident ? raw[u] : pack8f(v);
            }
        }
    }
    {
        const float gk = g_kr[lane];
        for (int t0 = gw; t0 < T; t0 += nw * 4) {
            float xs[4];
#pragma unroll
            for (int u = 0; u < 4; ++u) { const int t = t0 + u * nw; xs[u] = t < T ? KRAW[(size_t)t * 64 + lane] : 0.f; }
#pragma unroll
            for (int u = 0; u < 4; ++u) {
                const int t = t0 + u * nw;
                const float x = xs[u];
                float ss = x * x;
#pragma unroll
                for (int o = 32; o >= 1; o >>= 1) ss += __shfl_xor(ss, o);
                const float y = x * rsqrtf((ss + EPS * 64.0f) * (1.0f / 64.0f)) * gk;
                const float other = __shfl_xor(y, 32);
                const int pos = t & (SEQ - 1), i = lane & 31;
                if (t < T) {
                    const float c = cosT[pos * 32 + i], s = sinT[pos * 32 + i];
                    const float o = lane < 32 ? (y * c - other * s) : (y * c + other * s);
                    KROPE[(size_t)t * 64 + lane] = (bf16_t)(cvt_pk_bf16(o, 0.f) & 0xffffu);
                }
            }
        }
    }
}

__device__ __forceinline__ void phase_attn(const int TID, const int BID, unsigned char* shm, const bf16_t* Q, const bf16_t* KN, const bf16_t* KR, const bf16_t* VT, const bf16_t* Zs, bf16_t* Y,
                                           const float* g_qn, const float* g_qr, const float* cosT, const float* sinT) {
    constexpr int KROWB = 400, VROWB = 144, KBYTES = 64 * KROWB, BUFB = KBYTES + 128 * VROWB;
    const int tid = TID, wid = __builtin_amdgcn_readfirstlane(tid >> 6), lane = tid & 63, lq = lane & 31, hi = lane >> 5;
    const int kn_r = tid >> 4, kn_c = tid & 15;
    const int kr_r = tid >> 3, kr_c = tid & 7;
    const int v_r = tid >> 3, v_c = tid & 7;
    const unsigned koff = kn_r * 2048 + kn_c * 8, roff = kr_r * 64 + kr_c * 8, voff = (unsigned)v_r * T + v_c * 8;
    const int kfrag = lq * KROWB + hi * 16;
    const int vfrag = KBYTES + lq * VROWB + hi * 16;
    for (int item = BID; item < 1024; item += gridDim.x) {
        const int bh = item >> 4, pr = item & 15, b = bh >> 4, h = bh & 15;
        const int tokb = b * SEQ;
        for (int half = 0; half < 2; ++half) {
            const int qb = half == 0 ? (31 - pr) : pr;
            const int q0 = qb * 256, nt = 4 * (qb + 1);
            int lqo = lq, hio = hi; asm volatile("" : "+v"(lqo), "+v"(hio));
            const int qrow = q0 + wid * 32 + lq;
            const int qrow_o = q0 + wid * 32 + lqo;
            bf16x8 qf[12];
            {
                const bf16_t* qp = Q + (size_t)(tokb + qrow_o) * 3072 + h * 192 + hio * 8;
#pragma unroll
                for (int ks = 0; ks < 12; ++ks) qf[ks] = *(const bf16x8*)(qp + ks * 16);
                float ssn = 0.f, ssr = 0.f;
#pragma unroll
                for (int ks = 0; ks < 12; ++ks)
#pragma unroll
                    for (int j = 0; j < 8; ++j) { const float v = bf2f((unsigned short)qf[ks][j]); if (ks < 8) ssn += v * v; else ssr += v * v; }
                ssn = x32_sum(ssn); ssr = x32_sum(ssr);
                const float rn = rsqrtf((ssn + EPS * 128.0f) * (1.0f / 128.0f)) * QSCALE;
                const float rr = rsqrtf((ssr + EPS * 64.0f) * (1.0f / 64.0f));
#pragma unroll
                for (int ks = 0; ks < 8; ++ks) {
                    const f32x4 ga = *(const f32x4*)(g_qn + ks * 16 + hio * 8), gb = *(const f32x4*)(g_qn + ks * 16 + hio * 8 + 4);
                    float r[8];
#pragma unroll
                    for (int j = 0; j < 8; ++j) r[j] = bf2f((unsigned short)qf[ks][j]) * rn * (j < 4 ? ga[j & 3] : gb[j & 3]);
                    const u32x4 o = pack8f(r);
                    qf[ks] = *(const bf16x8*)&o;
                }
#pragma unroll
                for (int kk = 0; kk < 2; ++kk) {
                    const int i0 = 16 * kk + 8 * hio;
                    float r1[8], r2[8];
#pragma unroll
                    for (int j = 0; j < 8; ++j) {
                        const float x1 = bf2f((unsigned short)qf[8 + kk][j]) * rr * g_qr[i0 + j];
                        const float x2 = bf2f((unsigned short)qf[10 + kk][j]) * rr * g_qr[32 + i0 + j];
                        const float c = cosT[qrow_o * 32 + i0 + j], s = sinT[qrow_o * 32 + i0 + j];
                        r1[j] = (x1 * c - x2 * s) * QSCALE; r2[j] = (x2 * c + x1 * s) * QSCALE;
                    }
                    const u32x4 o1 = pack8f(r1), o2 = pack8f(r2);
                    qf[8 + kk] = *(const bf16x8*)&o1; qf[10 + kk] = *(const bf16x8*)&o2;
                }
            }
            f32x16 O[4];
#pragma unroll
            for (int d = 0; d < 4; ++d)
#pragma unroll
                for (int r = 0; r < 16; ++r) O[d][r] = 0.f;
            float m_run = 0.f, l_run = 0.f; bool mz = true;
            u32x4 st0, st1, st2, st3, st4;
#define ATT_ISSUE_K(t_) do { const size_t tok0 = (size_t)tokb + (size_t)(t_) * 64; \
                const bf16_t* knb = uniform_ptr(KN + tok0 * 2048 + h * 128); const bf16_t* krb = uniform_ptr(KR + tok0 * 64); \
                st0 = *(const u32x4*)(knb + koff); \
                st1 = *(const u32x4*)(knb + koff + 32 * 2048); \
                st2 = *(const u32x4*)(krb + roff); } while (0)
#define ATT_ISSUE_V(t_) do { const size_t tok0 = (size_t)tokb + (size_t)(t_) * 64; \
                const bf16_t* vtb = uniform_ptr(VT + (size_t)(h * 128) * T + tok0); \
                st3 = *(const u32x4*)(vtb + voff); \
                st4 = *(const u32x4*)(vtb + voff + 64 * T); } while (0)
#define ATT_WRITE(buf_) do { unsigned char* bp = shm + (buf_) * BUFB; \
                *(u32x4*)(bp + kn_r * KROWB + kn_c * 16) = st0; \
                *(u32x4*)(bp + (kn_r + 32) * KROWB + kn_c * 16) = st1; \
                *(u32x4*)(bp + kr_r * KROWB + 256 + kr_c * 16) = st2; \
                *(u32x4*)(bp + KBYTES + v_r * VROWB + v_c * 16) = st3; \
                *(u32x4*)(bp + KBYTES + (v_r + 64) * VROWB + v_c * 16) = st4; } while (0)
            __syncthreads();
            ATT_ISSUE_K(0); ATT_ISSUE_V(0);
            ATT_WRITE(0);
            __syncthreads();
            for (int t = 0; t < nt; ++t) {
                const bool has_next = (t + 1 < nt);
                const int rel = t - (nt - 4);
                const bool active = rel <= (wid >> 1);
                const unsigned char* bp = shm + (t & 1) * BUFB;
                bf16x8 pf[4];
#define SB_() __builtin_amdgcn_sched_barrier(0)
#define LDKH_(dst, h_, ks0_) do { _Pragma("unroll") for (int j_ = 0; j_ < 4; ++j_) dst[j_] = *(const bf16x8*)(bp + kfrag + (h_) * 12800 + ((ks0_) + j_) * 32); } while (0)
#define MMH_(S_, src, ks0_) do { _Pragma("unroll") for (int j_ = 0; j_ < 4; ++j_) S_ = __builtin_amdgcn_mfma_f32_32x32x16_bf16(src[j_], qf[(ks0_) + j_], S_, 0, 0, 0); } while (0)
#define LDVK_(dst, kk_) do { _Pragma("unroll") for (int j_ = 0; j_ < 4; ++j_) dst[j_] = *(const bf16x8*)(bp + vfrag + j_ * 4608 + (kk_) * 32); } while (0)
#define MMVK_(src, kk_) do { _Pragma("unroll") for (int j_ = 0; j_ < 4; ++j_) O[j_] = __builtin_amdgcn_mfma_f32_32x32x16_bf16(src[j_], pf[kk_], O[j_], 0, 0, 0); } while (0)
#define EXPR_(S_, r0_, r1_) do { _Pragma("unroll") for (int r_ = (r0_); r_ < (r1_); ++r_) { S_[r_] = __builtin_amdgcn_exp2f(S_[r_]); ps += S_[r_]; } } while (0)
#define PACK_(S_, k0_) do { u32x4 a_ = {cvt_pk_bf16(S_[0], S_[1]), cvt_pk_bf16(S_[2], S_[3]), cvt_pk_bf16(S_[4], S_[5]), cvt_pk_bf16(S_[6], S_[7])}; \
                        u32x4 b_ = {cvt_pk_bf16(S_[8], S_[9]), cvt_pk_bf16(S_[10], S_[11]), cvt_pk_bf16(S_[12], S_[13]), cvt_pk_bf16(S_[14], S_[15])}; \
                        pf[k0_] = *(const bf16x8*)&a_; pf[(k0_) + 1] = *(const bf16x8*)&b_; } while (0)
#define HALFPRE_(S_, koff_, EXTRA_) do { \
                        if (rel >= 0) { const int dq = qrow - t * 64 - 4 * hi - (koff_); float ninf_; asm volatile("v_mov_b32 %0, 0xff800000" : "=v"(ninf_)); \
                            _Pragma("unroll") for (int r_ = 0; r_ < 16; ++r_) { const int c_ = (r_ & 3) + 8 * (r_ >> 2); if (c_ > dq) S_[r_] = ninf_; } } \
                        float mx = S_[0]; \
                        _Pragma("unroll") for (int r_ = 1; r_ < 16; ++r_) mx = fmaxf(mx, S_[r_]); \
                        mx = x32_max(mx); \
                        const bool first_ = (t == 0) && ((koff_) == 0); \
                        const bool viol = (mx > 12.0f) || (first_ && mx < -64.0f); \
                        const bool fast = mz && (__builtin_amdgcn_ballot_w64(viol) == 0ull); \
                        if (!fast) { \
                            mz = false; \
                            const float mn = first_ ? mx : fmaxf(m_run, mx); \
                            const float alpha = first_ ? 1.0f : __builtin_amdgcn_exp2f(m_run - mn); \
                            m_run = mn; l_run *= alpha; EXTRA_ \
                            _Pragma("unroll") for (int r_ = 0; r_ < 16; ++r_) S_[r_] -= mn; \
                            _Pragma("unroll") for (int d_ = 0; d_ < 4; ++d_) _Pragma("unroll") for (int r_ = 0; r_ < 16; ++r_) O[d_][r_] *= alpha; \
                        } } while (0)
                f32x16 S1;
                float ps = 0.f;
                bf16x8 fc[4];
                if (active) {
                    f32x16 S0;
#pragma unroll
                    for (int r = 0; r < 16; ++r) { S0[r] = 0.f; S1[r] = 0.f; }
                    bf16x8 fa[4], fb[4];
                    LDKH_(fa, 0, 0); SB_();
                    LDKH_(fb, 0, 4); SB_(); MMH_(S0, fa, 0); SB_();
                    LDKH_(fa, 0, 8); SB_(); MMH_(S0, fb, 4); SB_();
                    LDKH_(fb, 1, 0); SB_(); MMH_(S0, fa, 8); SB_();
                    LDKH_(fa, 1, 4); SB_(); MMH_(S1, fb, 0); HALFPRE_(S0, 0, ); SB_();
                    LDKH_(fb, 1, 8); SB_(); MMH_(S1, fa, 4); EXPR_(S0, 0, 8); SB_();
                    LDVK_(fc, 0); SB_(); MMH_(S1, fb, 8); EXPR_(S0, 8, 16); SB_();
                    PACK_(S0, 0);
                }
                if (has_next) { ATT_ISSUE_K(t + 1); ATT_ISSUE_V(t + 1); }
                if (active) {
                    bf16x8 fb[4];
#define RESC_P0_ { ps *= alpha; { u32x4 w_ = *(const u32x4*)&pf[1]; \
                        _Pragma("unroll") for (int q_ = 0; q_ < 4; ++q_) w_[q_] = cvt_pk_bf16(bflo(w_[q_]) * alpha, bfhi(w_[q_]) * alpha); pf[1] = *(const bf16x8*)&w_; } }
                    LDVK_(fb, 1); SB_(); MMVK_(fc, 0); HALFPRE_(S1, 32, RESC_P0_); SB_();
#undef RESC_P0_
                    LDVK_(fc, 2); SB_(); MMVK_(fb, 1); EXPR_(S1, 0, 16); SB_();
                    PACK_(S1, 2);
                    l_run += ps;
                    LDVK_(fb, 3); SB_(); MMVK_(fc, 2); SB_();
                    MMVK_(fb, 3); SB_();
                }
#undef SB_
#undef LDKH_
#undef MMH_
#undef LDVK_
#undef MMVK_
#undef EXPR_
#undef PACK_
#undef HALFPRE_
                if (has_next) ATT_WRITE((t + 1) & 1);
                __syncthreads();
            }
#undef ATT_ISSUE_K
#undef ATT_ISSUE_V
#undef ATT_WRITE
            const float lt = x32_sum(l_run);
            const float inv = 1.0f / lt;
            int lqe = lq, hie = hi; asm volatile("" : "+v"(lqe), "+v"(hie));
            const size_t yoff = (size_t)(tokb + q0 + wid * 32 + lqe) * 2048 + h * 128 + 4 * hie;
            const bf16_t* zp = Zs + yoff; bf16_t* yp = Y + yoff;
#pragma unroll
            for (int db = 0; db < 4; ++db)
#pragma unroll
                for (int g4 = 0; g4 < 4; ++g4) {
                    bf16_t* pp = yp + db * 32 + g4 * 8;
                    const u32x2 zv = *(const u32x2*)(zp + db * 32 + g4 * 8);
                    u32x2 o = {cvt_pk_bf16(O[db][4 * g4 + 0] * inv * bflo(zv[0]), O[db][4 * g4 + 1] * inv * bfhi(zv[0])),
                               cvt_pk_bf16(O[db][4 * g4 + 2] * inv * bflo(zv[1]), O[db][4 * g4 + 3] * inv * bfhi(zv[1]))};
                    *(u32x2*)pp = o;
                }
        }
    }
}

enum { PH_PREP = 0, PH_NORM_A0, PH_AIN0, PH_MIX0, PH_AOUT0, PH_NORM_A1, PH_AIN1, PH_MIX1, PH_AOUT1, PH_NORM_KV, PH_DKV_BIN0, PH_UKV_UQ0, PH_KPOST, PH_ATTN0, PH_BOUT0,
       PH_NORM_B1, PH_BIN1, PH_UQ1, PH_ATTN1, PH_BOUT1, NPH };
#if REP_GEMM == 2
#define RG_(x) x, x,
#else
#define RG_(x) x,
#endif
#if REP_AIN == 2
#define RI_(x) x, x,
#else
#define RI_(x) x,
#endif
#if REP_MIX == 2
#define RM_(x) x, (x) | 0x80,
#else
#define RM_(x) x,
#endif
#if REP_ATTN == 2
#define RA_(x) x, x,
#else
#define RA_(x) x,
#endif
#if REP_LIGHT == 2
#define RL_(x) x, x,
#else
#define RL_(x) x,
#endif
__device__ const int g_seq[] = { RL_(PH_PREP) RL_(PH_NORM_A0) RI_(PH_AIN0) RM_(PH_MIX0) RG_(PH_AOUT0) RL_(PH_NORM_A1) RI_(PH_AIN1) RM_(PH_MIX1) PH_AOUT1, RL_(PH_NORM_KV) RG_(PH_DKV_BIN0) RG_(PH_UKV_UQ0)
                                           RM_(PH_KPOST) RA_(PH_ATTN0) PH_BOUT0, RL_(PH_NORM_B1) RG_(PH_BIN1) RG_(PH_UQ1) RA_(PH_ATTN1) PH_BOUT1 };
constexpr int NSEQ = (int)(sizeof(g_seq) / sizeof(int));

__global__ void __launch_bounds__(512, 2) mega(Params p) {
    extern __shared__ __attribute__((aligned(16))) unsigned char shm[];
    LAS unsigned char* lds = (LAS unsigned char*)shm;
    const int wid_s = __builtin_amdgcn_readfirstlane((int)(threadIdx.x >> 6));
    for (int pi = p.ph_lo; pi < p.ph_hi; ++pi) {
        const int phv = g_seq[pi]; const int ph = phv & 0x7f; const bool ident = (phv & 0x80) != 0;
        int lane_; asm volatile("v_mbcnt_lo_u32_b32 %0, -1, 0\n\tv_mbcnt_hi_u32_b32 %0, -1, %0" : "=v"(lane_));
        int TID = wid_s * 64 + lane_, BID = blockIdx.x; unsigned long long zoff_ = 0; asm volatile("" : "+s"(zoff_)); unsigned char* ws = p.ws + zoff_;
        asm volatile("" : "+v"(TID), "+s"(BID));
        const float* mod = (const float*)(ws + WS_MOD);
        const float* kvmod = (const float*)(ws + WS_KVMOD);
        const float* cosT = (const float*)(ws + WS_COS);
        const float* sinT = (const float*)(ws + WS_SIN);
        switch (ph) {
#if PHSEL & 1
        case PH_PREP: phase_prep(TID, BID, p, ws, shm); break;
#endif
#if PHSEL & 2
        case PH_NORM_A0: case PH_NORM_A1: case PH_NORM_B1: {
            const int l = ph == PH_NORM_A0 ? 0 : (ph == PH_NORM_A1 ? 1 : 3);
            const float* x = l == 0 ? p.in[I_X] : p.out;
            const float* m = mod + (size_t)l * 4 * 6144;
            phase_norm(TID, BID, x, p.in[I_NORM_G] + l * DM, m, m + 2048, 6144, (bf16_t*)(ws + WA_H), nullptr, nullptr, nullptr, 0, nullptr);
        } break;
#endif
#if PHSEL & 4
        case PH_NORM_KV: {
            const float* m = mod + (size_t)2 * 4 * 6144;
            phase_norm(TID, BID, p.out, p.in[I_NORM_G] + 2 * DM, m, m + 2048, 6144, (bf16_t*)(ws + WB_H), p.in[I_KV_NORM_G], kvmod, kvmod + 2048, 4096, (bf16_t*)(ws + WB_HKV));
        } break;
#endif
#if PHSEL & 8
        case PH_AIN0: case PH_AIN1: {
            const int l = ph == PH_AIN0 ? 0 : 1;
            const bf16_t* W = (const bf16_t*)(ws + WS_WINA) + (size_t)l * 12288 * 2048;
            EpiUZ E{(bf16_t*)(ws + WA_P)};
            run_gemm(TID, BID, lds, (const bf16_t*)(ws + WA_H), W, T, 8192, 2048, E);
            EpiGVT E2{(bf16_t*)(ws + WA_GVT), (float*)(ws + WA_STATS)};
            run_gemm(TID, BID, lds, W + (size_t)8192 * 2048, (const bf16_t*)(ws + WA_H), 4096, T, 2048, E2);
        } break;
#endif
#if PHSEL & 16
        case PH_MIX0: case PH_MIX1: {
            const int l = ph == PH_MIX0 ? 0 : 1;
            phase_mix(TID, BID, shm, (bf16_t*)(ws + WA_P), (const bf16_t*)(ws + WA_GVT), (const float*)(ws + WA_STATS), (const bf16_t*)(ws + WS_WS16) + (size_t)l * 16 * 128 * 128, p.in[I_A_B_S] + l * 16 * 128,
                      p.in[I_A_LN_G] + l * GMW, p.in[I_A_LN_B] + l * GMW, ident);
        } break;
#endif
#if PHSEL & 32
        case PH_AOUT0: case PH_AOUT1: case PH_BOUT0: case PH_BOUT1: {
            const int l = ph == PH_AOUT0 ? 0 : (ph == PH_AOUT1 ? 1 : (ph == PH_BOUT0 ? 2 : 3));
            const float* xin = l == 0 ? p.in[I_X] : p.out;
            EpiRes E{xin, p.out, mod + (size_t)l * 4 * 6144 + 4096, 6144};
            const bf16_t* A = l < 2 ? (const bf16_t*)(ws + WA_P) : (const bf16_t*)(ws + WB_Y);
            const bf16_t* Bt = l < 2 ? (const bf16_t*)(ws + WS_WOUTA) + (size_t)l * 2048 * 4096 : (const bf16_t*)(ws + WS_WOUTB) + (size_t)(l - 2) * 2048 * 2048;
            run_gemm(TID, BID, lds, A, Bt, T, 2048, l < 2 ? 4096 : 2048, E, l < 2);
        } break;
#endif
#if PHSEL & 64
        case PH_DKV_BIN0: case PH_BIN1: {
            if (ph == PH_DKV_BIN0) {
                EpiLat<0> E{(bf16_t*)(ws + WB_CKV), (float*)(ws + WB_SSQKV), (float*)(ws + WB_KRAW), nullptr};
                run_gemm(TID, BID, lds, (const bf16_t*)(ws + WB_HKV), (const bf16_t*)(ws + WS_WDKV), T, 768, 2048, E);
            }
            const int j = ph == PH_DKV_BIN0 ? 0 : 1;
            EpiLat<1> E{(bf16_t*)(ws + WB_CQ), (float*)(ws + WB_SSQQ), nullptr, (bf16_t*)(ws + WB_Z)};
            run_gemm(TID, BID, lds, (const bf16_t*)(ws + WB_H), (const bf16_t*)(ws + WS_WINB) + (size_t)j * 2560 * 2048, T, 2560, 2048, E);
        } break;
#endif
#if PHSEL & 128
        case PH_UKV_UQ0: case PH_UQ1: {
            if (ph == PH_UKV_UQ0) {
                EpiScaled E{(bf16_t*)(ws + WB_KN), 2048, (const float*)(ws + WB_SSQKV)};
                run_gemm(TID, BID, lds, (const bf16_t*)(ws + WB_CKV), (const bf16_t*)(ws + WS_WKN), T, 2048, 512, E);
                EpiVT E2{(bf16_t*)(ws + WB_VT), (const float*)(ws + WB_SSQKV)};
                run_gemm(TID, BID, lds, (const bf16_t*)(ws + WS_WV), (const bf16_t*)(ws + WB_CKV), 2048, T, 512, E2);
            }
            const int j = ph == PH_UKV_UQ0 ? 0 : 1;
            EpiScaled E{(bf16_t*)(ws + WB_Q), 3072, (const float*)(ws + WB_SSQQ)};
            run_gemm(TID, BID, lds, (const bf16_t*)(ws + WB_CQ), (const bf16_t*)(ws + WS_WUQ) + (size_t)j * 3072 * 512, T, 3072, 512, E);
        } break;
#endif
#if PHSEL & 256
        case PH_KPOST:
            phase_kpost(TID, BID, (bf16_t*)(ws + WB_KN), (const float*)(ws + WB_KRAW), (bf16_t*)(ws + WB_KROPE), p.in[I_KV_G_KN], p.in[I_KV_G_KR], cosT, sinT, ident);
            break;
#endif
#if PHSEL & 512
        case PH_ATTN0: case PH_ATTN1: {
            const int j = ph == PH_ATTN0 ? 0 : 1;
            phase_attn(TID, BID, shm, (const bf16_t*)(ws + WB_Q), (const bf16_t*)(ws + WB_KN), (const bf16_t*)(ws + WB_KROPE), (const bf16_t*)(ws + WB_VT), (const bf16_t*)(ws + WB_Z), (bf16_t*)(ws + WB_Y),
                       p.in[I_B_G_QN] + j * 128, p.in[I_B_G_QR] + j * 64, cosT, sinT);
        } break;
#endif
        default: break;
        }
        if (pi + 1 < p.ph_hi) {
            if (pi == p.ph_lo) cg::this_grid().sync();
            else grid_bar((unsigned*)(p.ws + WS_BAR), (unsigned)(pi - p.ph_lo), TID, BID);
        }
    }
}

extern "C" void kernel_launch(void* const* d_in, const int* in_sizes, int n_in, void* d_out, int out_size, void* d_ws, size_t ws_size, hipStream_t stream) {
    static int grid = 0;
    if (grid == 0) {
        if (n_in != 25 || ws_size < WS_NEED) { fprintf(stderr, "kernel_launch: unexpected n_in %d / ws %zu (need %zu)\n", n_in, ws_size, (size_t)WS_NEED); grid = -1; return; }
        int dev = 0, cus = 0, per_cu = 0;
        hipGetDevice(&dev);
        hipDeviceGetAttribute(&cus, hipDeviceAttributeMultiprocessorCount, dev);
        if (hipFuncSetAttribute((const void*)mega, hipFuncAttributeMaxDynamicSharedMemorySize, LDS_BYTES) != hipSuccess) { fprintf(stderr, "kernel_launch: hipFuncSetAttribute failed\n"); grid = -1; return; }
        if (hipOccupancyMaxActiveBlocksPerMultiprocessor(&per_cu, (const void*)mega, 512, LDS_BYTES) != hipSuccess || per_cu < 1) { fprintf(stderr, "kernel_launch: occupancy query gave %d\n", per_cu); per_cu = 1; }
        (void)hipGetLastError();
        grid = cus * per_cu;
    }
    if (grid < 0) return;
    Params p{};
    for (int i = 0; i < 25; ++i) p.in[i] = (const float*)d_in[i];
    p.out = (float*)d_out; p.ws = (unsigned char*)d_ws;
#if MK_SINGLE
    p.ph_lo = 0; p.ph_hi = NSEQ;
    if (hipMemsetAsync((char*)d_ws + WS_BAR, 0, 4096, stream) != hipSuccess) { fprintf(stderr, "kernel_launch: memset of the barrier words failed\n"); return; }
    void* args[] = {&p};
    hipError_t e = hipLaunchCooperativeKernel((const void*)mega, dim3(grid), dim3(512), args, LDS_BYTES, stream);
    if (e != hipSuccess) fprintf(stderr, "cooperative launch failed: %s (grid %d)\n", hipGetErrorString(e), grid);
#else
    for (int ph = 0; ph < NSEQ; ++ph) {
        p.ph_lo = ph; p.ph_hi = ph + 1;
        hipLaunchKernelGGL(mega, dim3(grid), dim3(512), LDS_BYTES, stream, p);
    }
#endif
}
```

```cpp
#include <hip/hip_runtime.h>
#include <hip/hip_cooperative_groups.h>
#include <cstdio>
#include <cstdint>
namespace cg = cooperative_groups;

#ifndef PHSEL
#define PHSEL 0xFFFF
#endif
#ifndef REP_ATTN
#define REP_ATTN 1
#endif
#ifndef REP_MIX
#define REP_MIX 1
#endif
#ifndef REP_AIN
#define REP_AIN 1
#endif
#ifndef REP_GEMM
#define REP_GEMM 1
#endif
#ifndef REP_LIGHT
#define REP_LIGHT 1
#endif
#ifndef MK_SINGLE
#define MK_SINGLE 1
#endif

typedef unsigned short bf16_t;
typedef short bf16x8 __attribute__((ext_vector_type(8)));
typedef float f32x2 __attribute__((ext_vector_type(2)));
typedef float f32x4 __attribute__((ext_vector_type(4)));
typedef float f32x16 __attribute__((ext_vector_type(16)));
typedef unsigned u32x4 __attribute__((ext_vector_type(4)));
typedef unsigned u32x2 __attribute__((ext_vector_type(2)));
#define LAS __attribute__((address_space(3)))
#define GAS __attribute__((address_space(1)))

constexpr int T = 32768, DM = 2048, SEQ = 8192, NBATCH = 4;
constexpr int GMW = 4096;
constexpr float EPS = 1e-6f;
constexpr float QSCALE = 0.07216878364870322f * 1.4426950408889634f;

constexpr size_t WS_BAR = 0;
constexpr size_t WS_MOD = 4096;
constexpr size_t WS_KVMOD = WS_MOD + 4ull * 4 * 6144 * 4;
constexpr size_t WS_COS = WS_KVMOD + 4ull * 4096 * 4;
constexpr size_t WS_SIN = WS_COS + 8192ull * 32 * 4;
constexpr size_t WS_WINA = WS_SIN + 8192ull * 32 * 4;
constexpr size_t WS_WOUTA = WS_WINA + 2ull * 12288 * 2048 * 2;
constexpr size_t WS_WDKV = WS_WOUTA + 2ull * 2048 * 4096 * 2;
constexpr size_t WS_WKN = WS_WDKV + 768ull * 2048 * 2;
constexpr size_t WS_WV = WS_WKN + 2048ull * 512 * 2;
constexpr size_t WS_WINB = WS_WV + 2048ull * 512 * 2;
constexpr size_t WS_WUQ = WS_WINB + 2ull * 2560 * 2048 * 2;
constexpr size_t WS_WOUTB = WS_WUQ + 2ull * 3072 * 512 * 2;
constexpr size_t WS_WS16 = WS_WOUTB + 2ull * 2048 * 2048 * 2;
constexpr size_t WS_ACT = WS_WS16 + 2ull * 16 * 128 * 128 * 2;
constexpr size_t WA_H = WS_ACT;
constexpr size_t WA_P = WA_H + (size_t)T * 2048 * 2;
constexpr size_t WA_GVT = WA_P + (size_t)T * 4096 * 2;
constexpr size_t WA_STATS = WA_GVT + (size_t)T * 4096 * 2;
constexpr size_t WA_END = WA_STATS + (size_t)T * 32 * 2 * 4;
constexpr size_t WB_H = WS_ACT;
constexpr size_t WB_HKV = WB_H + (size_t)T * 2048 * 2;
constexpr size_t WB_Q = WS_ACT;
constexpr size_t WB_CKV = WB_HKV + (size_t)T * 2048 * 2;
constexpr size_t WB_CQ = WB_CKV + (size_t)T * 512 * 2;
constexpr size_t WB_KRAW = WB_CQ + (size_t)T * 512 * 2;
constexpr size_t WB_KROPE = WB_KRAW + (size_t)T * 64 * 4;
constexpr size_t WB_SSQKV = WB_KROPE + (size_t)T * 64 * 2;
constexpr size_t WB_SSQQ = WB_SSQKV + (size_t)T * 8 * 4;
constexpr size_t WB_Z = WB_SSQQ + (size_t)T * 8 * 4;
constexpr size_t WB_KN = WB_Z + (size_t)T * 2048 * 2;
constexpr size_t WB_VT = WB_KN + (size_t)T * 2048 * 2;
constexpr size_t WB_END = WB_VT + (size_t)T * 2048 * 2;
constexpr size_t WB_Y = WB_Q + (size_t)T * 3072 * 2;
static_assert(WB_Y + (size_t)T * 2048 * 2 == WB_KRAW, "Y overlay");
constexpr size_t WS_NEED = WA_END > WB_END ? WA_END : WB_END;
static_assert(WS_NEED <= (1ull << 30), "workspace");

constexpr int LDS_BYTES = 131072;

__device__ __forceinline__ unsigned cvt_pk_bf16(float lo, float hi) { unsigned r; asm volatile("v_cvt_pk_bf16_f32 %0, %1, %2" : "=v"(r) : "v"(lo), "v"(hi)); return r; }
__device__ __forceinline__ float bf2f(unsigned short v) { return __uint_as_float(((unsigned)v) << 16); }
__device__ __forceinline__ float bflo(unsigned w) { return __uint_as_float(w << 16); }
__device__ __forceinline__ float bfhi(unsigned w) { return __uint_as_float(w & 0xffff0000u); }
__device__ __forceinline__ float gelu_f(float x) {
    const float u = x * (1.0f + 0.044715f * x * x);
    const float e = __builtin_amdgcn_exp2f(-2.302208198f * u);
    return x * __builtin_amdgcn_rcpf(1.0f + e);
}
__device__ __forceinline__ float silu_f(float x) { const float e = __builtin_amdgcn_exp2f(-1.4426950408889634f * x); return x * __builtin_amdgcn_rcpf(1.0f + e); }
__device__ __forceinline__ u32x4 pack8f(const float* r) { u32x4 o = {cvt_pk_bf16(r[0], r[1]), cvt_pk_bf16(r[2], r[3]), cvt_pk_bf16(r[4], r[5]), cvt_pk_bf16(r[6], r[7])}; return o; }

template <class Tp> __device__ __forceinline__ Tp* uniform_ptr(Tp* p) {
    const unsigned long long v = (unsigned long long)p; const unsigned lo = __builtin_amdgcn_readfirstlane((unsigned)v), hi = __builtin_amdgcn_readfirstlane((unsigned)(v >> 32));
    return (Tp*)(GAS Tp*)(((unsigned long long)hi << 32) | lo);
}
__device__ __forceinline__ float x32_sum(float v) { auto rr = __builtin_amdgcn_permlane32_swap(__float_as_uint(v), __float_as_uint(v), false, false); return __uint_as_float(rr[0]) + __uint_as_float(rr[1]); }
__device__ __forceinline__ float x32_max(float v) { auto rr = __builtin_amdgcn_permlane32_swap(__float_as_uint(v), __float_as_uint(v), false, false); return fmaxf(__uint_as_float(rr[0]), __uint_as_float(rr[1])); }

__device__ __forceinline__ void grid_bar(unsigned* bar, const unsigned epoch, const int TID, const int BID) {
    __syncthreads();
    if (TID == 0) {
        const unsigned G = gridDim.x, g = (unsigned)BID & 7u;
        const unsigned cnt = (G + 7u - g) >> 3;
        const unsigned ngrp = G < 8u ? G : 8u;
        __builtin_amdgcn_fence(__ATOMIC_RELEASE, "agent");
        const unsigned old = __hip_atomic_fetch_add(bar + 64 * (1 + g), 1u, __ATOMIC_RELAXED, __HIP_MEMORY_SCOPE_AGENT);
        if (old + 1u == cnt * epoch) {
            __builtin_amdgcn_fence(__ATOMIC_ACQ_REL, "agent");
            __hip_atomic_fetch_add(bar, 1u, __ATOMIC_RELAXED, __HIP_MEMORY_SCOPE_AGENT);
        }
        while (__hip_atomic_load(bar, __ATOMIC_RELAXED, __HIP_MEMORY_SCOPE_AGENT) < ngrp * epoch) __builtin_amdgcn_s_sleep(1);
        __builtin_amdgcn_fence(__ATOMIC_ACQUIRE, "agent");
    }
    __syncthreads();
}

namespace pg8 {
constexpr int BM = 256, BK = 64, HALF = 128, HTB = HALF * BK * 2, STAGE_BYTES = 8 * HTB, NXCD = 8, WGM = 8;
__host__ __device__ __forceinline__ int lds_byte(int r, int c) { const int st = (r >> 4) * 2 + (c >> 5), rr = r & 15, cc = c & 31, ob = rr * 64 + cc * 2; return st * 1024 + (ob ^ (((ob >> 9) & 1) << 5)); }
__host__ __device__ __forceinline__ void stage_rc(int b, int& R, int& C) { const int st = b / 1024, sb = b % 1024, swz = sb ^ (((sb >> 9) & 1) << 5); R = (st >> 1) * 16 + swz / 64; C = (st & 1) * 32 + (swz % 64) / 2; }
__host__ __device__ __forceinline__ int perm32(int rho) { const int n = rho >> 4, i = rho & 15; return 8 * (i >> 2) + 4 * n + (i & 3); }
struct Unit { int pm, pn; };
struct Gemm { const bf16_t* A; const bf16_t* Bt; int M, N, K; int a_rs; size_t a_kstep; };
struct StaticOrder {
    int nM, nN, nwg, G, c, wgm;
    __host__ __device__ void init(int M, int N, int G_, int c_, int wgm_) { nM = M / BM; nN = N / BM; nwg = nM * nN; G = G_; c = c_; wgm = wgm_; }
    __host__ __device__ bool next(int i, Unit& u) const {
        const int L = i * G + c; if (L >= nwg) return false;
        int wgid = (int)L; { const int q = nwg / NXCD, r = nwg % NXCD, xcd = wgid % NXCD, off = wgid / NXCD; wgid = (xcd < r ? xcd * (q + 1) : r * (q + 1) + (xcd - r) * q) + off; }
        const int nig = wgm * nN, gid = wgid / nig, fm = gid * wgm, gsz = (nM - fm) < wgm ? (nM - fm) : wgm;
        u.pm = fm + ((wgid % nig) % gsz); u.pn = (wgid % nig) / gsz; return true;
    }
    __device__ __forceinline__ void a_ready(const Unit&) const {}
    __device__ __forceinline__ void done(const Unit&) const {}
};

template <class Epi, class Sched>
__device__ __forceinline__ void gemm_phase(const int TID, LAS unsigned char* lds, const Gemm g, const Sched& S, const Epi& E) {
    const int tid = TID, wid = __builtin_amdgcn_readfirstlane(tid >> 6), lane = tid & 63, wr = wid >> 2, wc = wid & 3, fr = lane & 15, fq = lane >> 4;
    const int K = g.K, nt = K / BK;
    unsigned voffA[2], voffB[2];
#pragma unroll
    for (int i = 0; i < 2; ++i) { int R, C; stage_rc(tid * 16 + i * 8192, R, C); const int Rb = Epi::PERM ? ((R & ~31) + perm32(R & 31)) : R;
        voffA[i] = (unsigned)(R * g.a_rs + C) * 2u; voffB[i] = (unsigned)(Rb * K + C) * 2u; }
    const size_t kstep = (size_t)(BK * 2), kstepA = g.a_kstep;
    const size_t hstep = (size_t)HALF * K * 2, hstepA = (size_t)HALF * g.a_rs * 2;
    const size_t tstep = 2 * hstep, tstepA = 2 * hstepA;
    const unsigned ldsw = (unsigned)wid * 1024u;
    const int aoff = lds_byte(wr * 64 + fr, fq * 8), boff = lds_byte(wc * 32 + fr, fq * 8);
#define PG8_SA(b, h) (((b) * 2 + (h)) * HTB)
#define PG8_SB(b, h) ((4 + (b) * 2 + (h)) * HTB)
#define PG8_STAGE(bufoff, gbase, voff) do { _Pragma("unroll") for (int _i = 0; _i < 2; ++_i) \
        __builtin_amdgcn_global_load_lds((const unsigned*)((const char*)(gbase) + (voff)[_i]), (LAS unsigned*)(lds + (bufoff) + ldsw + _i * 8192), 16, 0, 0); } while (0)
#define PG8_LDA(dst, b, h) do { _Pragma("unroll") for (int m = 0; m < 4; ++m) _Pragma("unroll") for (int k = 0; k < 2; ++k) dst[m][k] = *(const LAS bf16x8*)(lds + PG8_SA(b, h) + aoff + m * 2048 + k * 1024); } while (0)
#define PG8_LDB(dst, b, h) do { _Pragma("unroll") for (int n = 0; n < 2; ++n) _Pragma("unroll") for (int k = 0; k < 2; ++k) dst[n][k] = *(const LAS bf16x8*)(lds + PG8_SB(b, h) + boff + n * 2048 + k * 1024); } while (0)
#define PG8_MMA(ai, bj, At, Bt) do { __builtin_amdgcn_s_setprio(1); _Pragma("unroll") for (int m = 0; m < 4; ++m) _Pragma("unroll") for (int n = 0; n < 2; ++n) _Pragma("unroll") for (int k = 0; k < 2; ++k) \
        acc[ai][bj][m][n] = __builtin_amdgcn_mfma_f32_16x16x32_bf16(Bt[n][k], At[m][k], acc[ai][bj][m][n], 0, 0, 0); __builtin_amdgcn_s_setprio(0); } while (0)
#define PG8_WAIT_V(n) asm volatile("s_waitcnt vmcnt(" #n ")" ::: "memory")
#define PG8_WAIT_L(n) asm volatile("s_waitcnt lgkmcnt(" #n ")" ::: "memory")
#define PG8_BAR __builtin_amdgcn_s_barrier()
#define PG8_SCHED __builtin_amdgcn_sched_barrier(0)
    Unit cur, nxt; int ui = 0;
    if (!S.next(0, cur)) return;
    f32x4 acc[2][2][4][2];
#pragma unroll
    for (int a = 0; a < 2; ++a)
#pragma unroll
        for (int b = 0; b < 2; ++b)
#pragma unroll
            for (int m = 0; m < 4; ++m)
#pragma unroll
                for (int n = 0; n < 2; ++n) acc[a][b][m][n] = (f32x4){0.f, 0.f, 0.f, 0.f};
    bf16x8 At[4][2], B0[2][2], B1[2][2];
    const char* cA = (const char*)g.A + (size_t)cur.pm * tstepA; const char* cB = (const char*)g.Bt + (size_t)cur.pn * tstep;
    S.a_ready(cur);
    PG8_STAGE(PG8_SB(0, 0), cB, voffB); PG8_STAGE(PG8_SA(0, 0), cA, voffA); PG8_STAGE(PG8_SB(0, 1), cB + hstep, voffB); PG8_STAGE(PG8_SA(0, 1), cA + hstepA, voffA);
    if (wr == 1) PG8_BAR;
    PG8_WAIT_V(4); PG8_BAR;
    PG8_STAGE(PG8_SB(1, 0), cB + kstep, voffB); PG8_STAGE(PG8_SA(1, 0), cA + kstepA, voffA); PG8_STAGE(PG8_SB(1, 1), cB + hstep + kstep, voffB);
    PG8_WAIT_V(6); PG8_BAR;
    for (;;) {
        const bool has_next = S.next(ui + 1, nxt);
        const char* nA = has_next ? (const char*)g.A + (size_t)nxt.pm * tstepA : cA; const char* nB = has_next ? (const char*)g.Bt + (size_t)nxt.pn * tstep : cB;
        for (int t = 0; t < nt; t += 2) {
            const bool last = (t == nt - 2);
            const char* a1 = cA + (size_t)(t + 1) * kstepA;
            const char* a2 = last ? nA : cA + (size_t)(t + 2) * kstepA; const char* b2 = last ? nB : cB + (size_t)(t + 2) * kstep;
            const char* a3 = a2 + kstepA; const char* b3 = b2 + kstep;
            if (last && has_next) S.a_ready(nxt);
            PG8_LDB(B0, 0, 0); PG8_SCHED; PG8_LDA(At, 0, 0); PG8_STAGE(PG8_SA(1, 1), a1 + hstepA, voffA);
            PG8_WAIT_L(8); PG8_BAR; PG8_WAIT_L(0); PG8_MMA(0, 0, At, B0); PG8_BAR; PG8_SCHED;
            PG8_LDB(B1, 0, 1); PG8_STAGE(PG8_SB(0, 0), b2, voffB);
            PG8_BAR; PG8_WAIT_L(0); PG8_MMA(0, 1, At, B1); PG8_BAR;
            PG8_LDA(At, 0, 1); PG8_STAGE(PG8_SA(0, 0), a2, voffA);
            PG8_BAR; PG8_WAIT_L(0); PG8_MMA(1, 0, At, B0); PG8_BAR; PG8_SCHED;
            PG8_STAGE(PG8_SB(0, 1), b2 + hstep, voffB);
            PG8_WAIT_V(6); PG8_BAR; PG8_MMA(1, 1, At, B1); PG8_BAR;
            PG8_LDB(B0, 1, 0); PG8_SCHED; PG8_LDA(At, 1, 0); PG8_STAGE(PG8_SA(0, 1), a2 + hstepA, voffA);
            PG8_WAIT_L(8); PG8_BAR; PG8_WAIT_L(0); PG8_MMA(0, 0, At, B0); PG8_BAR; PG8_SCHED;
            PG8_LDB(B1, 1, 1); PG8_STAGE(PG8_SB(1, 0), b3, voffB);
            PG8_BAR; PG8_WAIT_L(0); PG8_MMA(0, 1, At, B1); PG8_BAR;
            PG8_LDA(At, 1, 1); PG8_STAGE(PG8_SA(1, 0), a3, voffA);
            PG8_BAR; PG8_WAIT_L(0); PG8_MMA(1, 0, At, B0); PG8_BAR; PG8_SCHED;
            PG8_STAGE(PG8_SB(1, 1), b3 + hstep, voffB);
            PG8_WAIT_V(6); PG8_BAR; PG8_MMA(1, 1, At, B1); PG8_BAR;
        }
        E(acc, cur, wr, wc, fr, fq);
        if (!has_next) break;
#pragma unroll
        for (int a = 0; a < 2; ++a)
#pragma unroll
            for (int b = 0; b < 2; ++b)
#pragma unroll
                for (int m = 0; m < 4; ++m)
#pragma unroll
                    for (int n = 0; n < 2; ++n) acc[a][b][m][n] = (f32x4){0.f, 0.f, 0.f, 0.f};
        cur = nxt; cA = nA; cB = nB; ++ui;
    }
    PG8_WAIT_V(0);
    if (wr == 0) PG8_BAR;
    PG8_BAR;
#undef PG8_SA
#undef PG8_SB
#undef PG8_STAGE
#undef PG8_LDA
#undef PG8_LDB
#undef PG8_MMA
#undef PG8_WAIT_V
#undef PG8_WAIT_L
#undef PG8_BAR
#undef PG8_SCHED
}
}
using pg8::Unit;

struct EpiUZ {
    static constexpr bool PERM = true;
    bf16_t* P;
    __device__ __forceinline__ void operator()(const f32x4 (&acc)[2][2][4][2], const Unit& u, int wr, int wc, int fr_, int fq_) const {
        int fr = fr_, fq = fq_; asm volatile("" : "+v"(fr), "+v"(fq));
        const int row0 = u.pm * 256 + wr * 64 + fr;
        const int col = u.pn * 128 + wc * 32 + 8 * fq;
#pragma unroll
        for (int ai = 0; ai < 2; ++ai)
#pragma unroll
            for (int m = 0; m < 4; ++m) {
                const size_t row = (size_t)(row0 + ai * 128 + m * 16);
                float r[8];
#pragma unroll
                for (int n = 0; n < 2; ++n)
#pragma unroll
                    for (int i = 0; i < 4; ++i) {
                        const float uu = acc[ai][0][m][n][i], zz = acc[ai][1][m][n][i];
                        const float eu = __builtin_amdgcn_exp2f(-2.302208198f * (uu * (1.0f + 0.044715f * uu * uu)));
                        const float ez = __builtin_amdgcn_exp2f(-1.4426950408889634f * zz);
                        r[4 * n + i] = (uu * zz) * __builtin_amdgcn_rcpf((1.0f + eu) * (1.0f + ez));
                    }
                *(u32x4*)(P + ((size_t)(col >> 6) * T + row) * 64 + (col & 63)) = pack8f(r);
            }
    }
};
struct EpiGVT {
    static constexpr bool PERM = true;
    bf16_t* GVT; float* stats;
    __device__ __forceinline__ void operator()(const f32x4 (&acc)[2][2][4][2], const Unit& u, int wr, int wc, int fr_, int fq_) const {
        int fr = fr_, fq = fq_; asm volatile("" : "+v"(fr), "+v"(fq));
        const int row0 = u.pm * 256 + wr * 64 + fr;
        const int tok0 = u.pn * 256 + wc * 32 + 8 * fq;
        float s[16], ss[16];
#pragma unroll
        for (int j = 0; j < 16; ++j) { s[j] = 0.f; ss[j] = 0.f; }
#pragma unroll
        for (int ai = 0; ai < 2; ++ai)
#pragma unroll
            for (int m = 0; m < 4; ++m) {
                const size_t row = (size_t)(row0 + ai * 128 + m * 16);
#pragma unroll
                for (int bj = 0; bj < 2; ++bj) {
                    float r[8];
#pragma unroll
                    for (int n = 0; n < 2; ++n)
#pragma unroll
                        for (int i = 0; i < 4; ++i) r[4 * n + i] = gelu_f(acc[ai][bj][m][n][i]);
                    const u32x4 o = pack8f(r);
#pragma unroll
                    for (int q = 0; q < 4; ++q) { const float a = bflo(o[q]), b = bfhi(o[q]); s[bj * 8 + 2 * q] += a; ss[bj * 8 + 2 * q] += a * a; s[bj * 8 + 2 * q + 1] += b; ss[bj * 8 + 2 * q + 1] += b * b; }
                    *(u32x4*)(GVT + row * T + tok0 + bj * 128) = o;
                }
            }
#pragma unroll
        for (int step = 0; step < 4; ++step) {
            const int msk = 8 >> step, cnt = 8 >> step;
            const bool up = (fr & msk) != 0;
#pragma unroll
            for (int j = 0; j < 8; ++j) {
                if (j < cnt) {
                    const float send_s = up ? s[j] : s[j + cnt], keep_s = up ? s[j + cnt] : s[j];
                    const float send_q = up ? ss[j] : ss[j + cnt], keep_q = up ? ss[j + cnt] : ss[j];
                    s[j] = keep_s + __shfl_xor(send_s, msk);
                    ss[j] = keep_q + __shfl_xor(send_q, msk);
                }
            }
        }
        {
            const int j = fr;
            const size_t tok = (size_t)(tok0 + 128 * (j >> 3) + (j & 7));
            f32x2 st = {s[0], ss[0]};
            *(f32x2*)(stats + (tok * 32 + u.pm * 2 + wr) * 2) = st;
        }
    }
};
struct EpiRes {
    static constexpr bool PERM = false;
    const float* xin; float* xout; const float* gate;
    int ldg;
    __device__ __forceinline__ void operator()(const f32x4 (&acc)[2][2][4][2], const Unit& u, int wr, int wc, int fr_, int fq_) const {
        int fr = fr_, fq = fq_; asm volatile("" : "+v"(fr), "+v"(fq));
        const int row0 = u.pm * 256 + wr * 64 + fr, col0 = u.pn * 256 + wc * 32 + 4 * fq;
        const float* gp = gate + (size_t)(u.pm >> 5) * ldg + col0;
        f32x4 gv[2][2];
#pragma unroll
        for (int bj = 0; bj < 2; ++bj)
#pragma unroll
            for (int n = 0; n < 2; ++n) gv[bj][n] = *(const f32x4*)(gp + bj * 128 + n * 16);
#pragma unroll
        for (int ai = 0; ai < 2; ++ai)
#pragma unroll
            for (int m = 0; m < 4; ++m) {
                const size_t off = (size_t)(row0 + ai * 128 + m * 16) * DM + col0;
#pragma unroll
                for (int bj = 0; bj < 2; ++bj)
#pragma unroll
                    for (int n = 0; n < 2; ++n) {
                        const f32x4 xo = *(const f32x4*)(xin + off + bj * 128 + n * 16);
                        *(f32x4*)(xout + off + bj * 128 + n * 16) = xo + gv[bj][n] * acc[ai][bj][m][n];
                    }
            }
    }
};
template <int MODE> struct EpiLat {
    static constexpr bool PERM = true;
    bf16_t* C; float* ssq; float* kr; bf16_t* Z;
    __device__ __forceinline__ void operator()(const f32x4 (&acc)[2][2][4][2], const Unit& u, int wr, int wc, int fr_, int fq_) const {
        int fr = fr_, fq = fq_; asm volatile("" : "+v"(fr), "+v"(fq));
        const int row0 = u.pm * 256 + wr * 64 + fr;
        if (u.pn < 2) {
#pragma unroll
            for (int ai = 0; ai < 2; ++ai)
#pragma unroll
                for (int m = 0; m < 4; ++m) {
                    const size_t row = (size_t)(row0 + ai * 128 + m * 16);
                    float ss = 0.f;
#pragma unroll
                    for (int bj = 0; bj < 2; ++bj) {
                        const int col = u.pn * 256 + bj * 128 + wc * 32 + 8 * fq;
                        float r[8];
#pragma unroll
                        for (int n = 0; n < 2; ++n)
#pragma unroll
                            for (int i = 0; i < 4; ++i) { r[4 * n + i] = acc[ai][bj][m][n][i]; ss += r[4 * n + i] * r[4 * n + i]; }
                        *(u32x4*)(C + row * 512 + col) = pack8f(r);
                    }
                    ss += __shfl_xor(ss, 16); ss += __shfl_xor(ss, 32);
                    if (fq == 0) ssq[row * 8 + u.pn * 4 + wc] = ss;
                }
        } else if (MODE == 0) {
            if (u.pn == 2 && wc < 2) {
#pragma unroll
                for (int ai = 0; ai < 2; ++ai)
#pragma unroll
                    for (int m = 0; m < 4; ++m) {
                        const size_t row = (size_t)(row0 + ai * 128 + m * 16);
                        *(f32x4*)(kr + row * 64 + wc * 32 + 8 * fq) = acc[ai][0][m][0];
                        *(f32x4*)(kr + row * 64 + wc * 32 + 8 * fq + 4) = acc[ai][0][m][1];
                    }
            }
        } else {
#pragma unroll
            for (int ai = 0; ai < 2; ++ai)
#pragma unroll
                for (int m = 0; m < 4; ++m) {
                    const size_t row = (size_t)(row0 + ai * 128 + m * 16);
#pragma unroll
                    for (int bj = 0; bj < 2; ++bj) {
                        const int col = (u.pn - 2) * 256 + bj * 128 + wc * 32 + 8 * fq;
                        float r[8];
#pragma unroll
                        for (int n = 0; n < 2; ++n)
#pragma unroll
                            for (int i = 0; i < 4; ++i) r[4 * n + i] = silu_f(acc[ai][bj][m][n][i]);
                        *(u32x4*)(Z + row * 2048 + col) = pack8f(r);
                    }
                }
        }
    }
};
struct EpiScaled {
    static constexpr bool PERM = true;
    bf16_t* O; int ldc; const float* ssq;
    __device__ __forceinline__ void operator()(const f32x4 (&acc)[2][2][4][2], const Unit& u, int wr, int wc, int fr_, int fq_) const {
        int fr = fr_, fq = fq_; asm volatile("" : "+v"(fr), "+v"(fq));
        const int row0 = u.pm * 256 + wr * 64 + fr;
#pragma unroll
        for (int ai = 0; ai < 2; ++ai)
#pragma unroll
            for (int m = 0; m < 4; ++m) {
                const size_t row = (size_t)(row0 + ai * 128 + m * 16);
                const f32x4 a = *(const f32x4*)(ssq + row * 8), b = *(const f32x4*)(ssq + row * 8 + 4);
                const float rs = rsqrtf(((a[0] + a[1] + a[2] + a[3] + b[0] + b[1] + b[2] + b[3]) + EPS * 512.0f) * (1.0f / 512.0f));
#pragma unroll
                for (int bj = 0; bj < 2; ++bj) {
                    const int col = u.pn * 256 + bj * 128 + wc * 32 + 8 * fq;
                    float r[8];
#pragma unroll
                    for (int n = 0; n < 2; ++n)
#pragma unroll
                        for (int i = 0; i < 4; ++i) r[4 * n + i] = acc[ai][bj][m][n][i] * rs;
                    *(u32x4*)(O + row * ldc + col) = pack8f(r);
                }
            }
    }
};
struct EpiVT {
    static constexpr bool PERM = false;
    bf16_t* VT; const float* ssq;
    __device__ __forceinline__ void operator()(const f32x4 (&acc)[2][2][4][2], const Unit& u, int wr, int wc, int fr_, int fq_) const {
        int fr = fr_, fq = fq_; asm volatile("" : "+v"(fr), "+v"(fq));
        const int row0 = u.pm * 256 + wr * 64 + fr;
        const int pg = ((fq & 1) << 1) | (fq >> 1);
#pragma unroll
        for (int bj = 0; bj < 2; ++bj)
#pragma unroll
            for (int n = 0; n < 2; ++n) {
                const int tb = u.pn * 256 + bj * 128 + wc * 32 + 16 * n;
                const int tok0 = tb + 4 * fq;
                f32x4 rs;
#pragma unroll
                for (int i = 0; i < 4; ++i) {
                    const f32x4 a = *(const f32x4*)(ssq + (size_t)(tok0 + i) * 8), b = *(const f32x4*)(ssq + (size_t)(tok0 + i) * 8 + 4);
                    rs[i] = rsqrtf(((a[0] + a[1] + a[2] + a[3] + b[0] + b[1] + b[2] + b[3]) + EPS * 512.0f) * (1.0f / 512.0f));
                }
                const int pos0 = tb + 4 * pg;
#pragma unroll
                for (int ai = 0; ai < 2; ++ai)
#pragma unroll
                    for (int m = 0; m < 4; ++m) {
                        const size_t row = (size_t)(row0 + ai * 128 + m * 16);
                        const f32x4 v = acc[ai][bj][m][n] * rs;
                        u32x2 o = {cvt_pk_bf16(v[0], v[1]), cvt_pk_bf16(v[2], v[3])};
                        *(u32x2*)(VT + row * T + pos0) = o;
                    }
            }
    }
};

template <class Epi> __device__ __forceinline__ void run_gemm(const int TID, const int BID, LAS unsigned char* lds, const bf16_t* A, const bf16_t* Bt, int M, int N, int K, const Epi& E, const bool a_blocked = false) {
    pg8::Gemm g{A, Bt, M, N, K, a_blocked ? 64 : K, a_blocked ? (size_t)M * 128 : (size_t)128}; pg8::StaticOrder S; S.init(M, N, (int)gridDim.x, (int)BID, 4);
    int tid_ = TID; asm volatile("" : "+v"(tid_));
    pg8::gemm_phase<Epi, pg8::StaticOrder>(tid_, lds, g, S, E);
}

struct Params {
    const float* in[25];
    float* out;
    unsigned char* ws;
    int ph_lo, ph_hi;
};
enum { I_X = 0, I_C, I_ADA_W, I_ADA_B, I_NORM_G, I_A_W_IN, I_A_LN_G, I_A_LN_B, I_A_W_S, I_A_B_S, I_A_W_OUT, I_KV_ADA_W, I_KV_ADA_B, I_KV_NORM_G, I_KV_W_DKV, I_KV_G_KVA,
       I_KV_W_UKV, I_KV_G_KN, I_KV_G_KR, I_B_W_IN, I_B_G_QA, I_B_W_UQ, I_B_G_QN, I_B_G_QR, I_B_W_OUT };

__device__ __forceinline__ void conv_tile(const int TID, unsigned char* shm, const float* src, int ldsrc, int srccol0, int K, int k0, bf16_t* dst, int n0, const float* scale) {
    float* tile = (float*)shm;
    const int tid = TID;
    {
        const int kk = tid >> 4, c4 = tid & 15;
        f32x4 v[8];
#pragma unroll
        for (int i = 0; i < 8; ++i) {
            v[i] = (f32x4){0.f, 0.f, 0.f, 0.f};
            if (srccol0 >= 0) v[i] = *(const f32x4*)(src + (size_t)(k0 + kk + 32 * i) * ldsrc + srccol0 + 4 * c4);
        }
#pragma unroll
        for (int i = 0; i < 8; ++i) { float* tp = tile + (kk + 32 * i) * 65 + 4 * c4; tp[0] = v[i][0]; tp[1] = v[i][1]; tp[2] = v[i][2]; tp[3] = v[i][3]; }
    }
    __syncthreads();
    {
        const int n = tid >> 3, k8 = tid & 7;
#pragma unroll
        for (int jb = 0; jb < 4; ++jb) {
            float r[8];
#pragma unroll
            for (int j = 0; j < 8; ++j) { r[j] = tile[(64 * jb + 8 * k8 + j) * 65 + n]; if (scale) r[j] *= scale[k0 + 64 * jb + 8 * k8 + j]; }
            *(u32x4*)(dst + (size_t)(n0 + n) * K + k0 + 64 * jb + 8 * k8) = pack8f(r);
        }
    }
    __syncthreads();
}

__device__ __forceinline__ void phase_prep(const int TID, const int BID, const Params& p, unsigned char* ws, unsigned char* shm) {
    const int tid = TID;
    {
        float* cosT = (float*)(ws + WS_COS); float* sinT = (float*)(ws + WS_SIN);
        for (int idx = BID * 512 + tid; idx < SEQ * 32; idx += gridDim.x * 512) {
            const int pos = idx >> 5, i = idx & 31;
            double f = 1.0; for (int q = 0; q < i; ++q) f *= 0.7498942093324559;
            const float invf = (float)f;
            const float ang = (float)pos * invf;
            const double ad = (double)ang;
            const double n = rint(ad * 0.15915494309189535);
            const double r = ad - n * 6.283185307179586;
            const double r2 = r * r;
            double s = 1.0, c = 1.0;
#pragma unroll 1
            for (int k = 14; k >= 1; --k) { s = 1.0 - s * r2 / (double)((2 * k) * (2 * k + 1)); c = 1.0 - c * r2 / (double)((2 * k - 1) * (2 * k)); }
            cosT[idx] = (float)c; sinT[idx] = (float)(r * s);
        }
    }
    if (BID < 224) {
        float* sc = (float*)shm;
        float* red = (float*)(shm + 32768);
        const float* cin = p.in[I_C];
        for (int i = tid; i < 4 * 2048; i += 512) sc[i] = silu_f(cin[i]);
        __syncthreads();
        const int item = BID;
        const float* W; const float* bias; float* out; int ldw, cb;
        if (item < 192) { const int l = item / 48; cb = item % 48; W = p.in[I_ADA_W] + (size_t)l * 2048 * 6144; ldw = 6144; bias = p.in[I_ADA_B] + l * 6144; out = (float*)(ws + WS_MOD) + (size_t)l * 4 * 6144; }
        else { cb = item - 192; W = p.in[I_KV_ADA_W]; ldw = 4096; bias = p.in[I_KV_ADA_B]; out = (float*)(ws + WS_KVMOD); }
        const int cgp = tid & 31, kg = tid >> 5;
        const float* wp = W + (size_t)(kg * 128) * ldw + cb * 128 + cgp * 4;
        f32x4 a0 = {0.f, 0.f, 0.f, 0.f}, a1 = a0, a2 = a0, a3 = a0;
#pragma unroll 8
        for (int k = 0; k < 128; ++k) {
            const f32x4 w = *(const f32x4*)(wp + (size_t)k * ldw);
            const int kk = kg * 128 + k;
            a0 += w * sc[kk]; a1 += w * sc[2048 + kk]; a2 += w * sc[4096 + kk]; a3 += w * sc[6144 + kk];
        }
        float* rp = red + ((size_t)kg * 128 + cgp * 4) * 4;
#pragma unroll
        for (int e = 0; e < 4; ++e) { rp[e * 4 + 0] = a0[e]; rp[e * 4 + 1] = a1[e]; rp[e * 4 + 2] = a2[e]; rp[e * 4 + 3] = a3[e]; }
        __syncthreads();
        {
            const int col = tid >> 2, b = tid & 3;
            float s = 0.f;
#pragma unroll
            for (int g = 0; g < 16; ++g) s += red[((size_t)g * 128 + col) * 4 + b];
            out[(size_t)b * ldw + cb * 128 + col] = s + bias[cb * 128 + col];
        }
        __syncthreads();
    }
    {
        const float* wsrc = p.in[I_A_W_S]; bf16_t* wdst = (bf16_t*)(ws + WS_WS16);
        for (int idx = BID * 512 + TID; idx < 2 * 16 * 128 * 128 / 4; idx += gridDim.x * 512) {
            const int e = idx * 4, s4 = e & 127, t = (e >> 7) & 127;
            f32x4 w = *(const f32x4*)(wsrc + e);
#pragma unroll
            for (int q = 0; q < 4; ++q) if (s4 + q > t) w[q] = 0.f;
            u32x2 o = {cvt_pk_bf16(w[0], w[1]), cvt_pk_bf16(w[2], w[3])};
            *(u32x2*)(wdst + e) = o;
        }
    }
    {
        constexpr int NJ = 13;
        const int ntile[NJ] = {1536, 1536, 512, 512, 96, 64, 64, 320, 320, 96, 96, 256, 256};
        int total = 0;
#pragma unroll
        for (int j = 0; j < NJ; ++j) total += ntile[j];
        for (int tix = BID; tix < total; tix += gridDim.x) {
            int j = 0, rem = tix;
#pragma unroll
            for (int q = 0; q < NJ; ++q) { if (j == q && rem >= ntile[q]) { rem -= ntile[q]; j = q + 1; } }
            const float* src; int ldsrc, K; bf16_t* dst; const float* scale = nullptr; int srccol0, n0, k0;
            if (j < 2) {
                K = 2048; ldsrc = 12288; src = p.in[I_A_W_IN] + (size_t)j * 2048 * 12288; dst = (bf16_t*)(ws + WS_WINA) + (size_t)j * 12288 * 2048;
                const int nt_ = rem / 8; k0 = (rem % 8) * 256; n0 = nt_ * 64;
                const int pn = n0 >> 8, jj = n0 & 255;
                srccol0 = pn < 32 ? (jj < 128 ? 128 * pn + jj : 8192 + 128 * pn + (jj - 128)) : 4096 + 256 * (pn - 32) + jj;
            } else if (j < 4) {
                const int l = j - 2; K = 4096; ldsrc = 2048; src = p.in[I_A_W_OUT] + (size_t)l * 4096 * 2048; dst = (bf16_t*)(ws + WS_WOUTA) + (size_t)l * 2048 * 4096;
                const int nt_ = rem / 16; k0 = (rem % 16) * 256; n0 = nt_ * 64; srccol0 = n0;
            } else if (j == 4) {
                K = 2048; ldsrc = 576; src = p.in[I_KV_W_DKV]; dst = (bf16_t*)(ws + WS_WDKV);
                const int nt_ = rem / 8; k0 = (rem % 8) * 256; n0 = nt_ * 64; srccol0 = n0 < 576 ? n0 : -1;
            } else if (j < 7) {
                K = 512; ldsrc = 4096; src = p.in[I_KV_W_UKV]; dst = (bf16_t*)(ws + (j == 5 ? WS_WKN : WS_WV)); scale = p.in[I_KV_G_KVA];
                const int nt_ = rem / 2; k0 = (rem % 2) * 256; n0 = nt_ * 64;
                srccol0 = (n0 >> 7) * 256 + (j == 6 ? 128 : 0) + (n0 & 127);
            } else if (j < 9) {
                const int l = j - 7; K = 2048; ldsrc = 2560; src = p.in[I_B_W_IN] + (size_t)l * 2048 * 2560; dst = (bf16_t*)(ws + WS_WINB) + (size_t)l * 2560 * 2048;
                const int nt_ = rem / 8; k0 = (rem % 8) * 256; n0 = nt_ * 64; srccol0 = n0;
            } else if (j < 11) {
                const int l = j - 9; K = 512; ldsrc = 3072; src = p.in[I_B_W_UQ] + (size_t)l * 512 * 3072; dst = (bf16_t*)(ws + WS_WUQ) + (size_t)l * 3072 * 512; scale = p.in[I_B_G_QA] + l * 512;
                const int nt_ = rem / 2; k0 = (rem % 2) * 256; n0 = nt_ * 64; srccol0 = n0;
            } else {
                const int l = j - 11; K = 2048; ldsrc = 2048; src = p.in[I_B_W_OUT] + (size_t)l * 2048 * 2048; dst = (bf16_t*)(ws + WS_WOUTB) + (size_t)l * 2048 * 2048;
                const int nt_ = rem / 8; k0 = (rem % 8) * 256; n0 = nt_ * 64; srccol0 = n0;
            }
            conv_tile(TID, shm, src, ldsrc, srccol0, K, k0, dst, n0, scale);
        }
    }
}

__device__ __forceinline__ void phase_norm(const int TID, const int BID, const float* x, const float* g1, const float* sh1, const float* sc1, int ld1, bf16_t* h1,
                           const float* g2, const float* sh2, const float* sc2, int ld2, bf16_t* h2) {
    const int lane = TID & 63, wid = TID >> 6;
    for (int row = BID * 8 + wid; row < T; row += gridDim.x * 8) {
        const int b = row >> 13;
        const f32x4* xr = (const f32x4*)(x + (size_t)row * DM);
        f32x4 v[8]; float ss = 0.f;
#pragma unroll
        for (int i = 0; i < 8; ++i) { v[i] = xr[lane + 64 * i]; ss += v[i][0] * v[i][0] + v[i][1] * v[i][1] + v[i][2] * v[i][2] + v[i][3] * v[i][3]; }
#pragma unroll
        for (int o = 32; o >= 1; o >>= 1) ss += __shfl_xor(ss, o);
        const float rs = rsqrtf((ss + EPS * 2048.0f) * (1.0f / 2048.0f));
#pragma unroll
        for (int i = 0; i < 8; ++i) {
            const int k = 4 * (lane + 64 * i);
            const f32x4 gg = *(const f32x4*)(g1 + k), sc = *(const f32x4*)(sc1 + (size_t)b * ld1 + k), sh = *(const f32x4*)(sh1 + (size_t)b * ld1 + k);
            const f32x4 o = (v[i] * rs) * gg * (sc + 1.0f) + sh;
            u32x2 w = {cvt_pk_bf16(o[0], o[1]), cvt_pk_bf16(o[2], o[3])};
            *(u32x2*)(h1 + (size_t)row * DM + k) = w;
        }
        if (h2) {
#pragma unroll
            for (int i = 0; i < 8; ++i) {
                const int k = 4 * (lane + 64 * i);
                const f32x4 gg = *(const f32x4*)(g2 + k), sc = *(const f32x4*)(sc2 + (size_t)b * ld2 + k), sh = *(const f32x4*)(sh2 + (size_t)b * ld2 + k);
                const f32x4 o = (v[i] * rs) * gg * (sc + 1.0f) + sh;
                u32x2 w = {cvt_pk_bf16(o[0], o[1]), cvt_pk_bf16(o[2], o[3])};
                *(u32x2*)(h2 + (size_t)row * DM + k) = w;
            }
        }
    }
}

__device__ __forceinline__ void phase_mix(const int TID, const int BID, unsigned char* shm, bf16_t* P, const bf16_t* GVT, const float* stats, const bf16_t* ws16, const float* b_s, const float* ln_g, const float* ln_b, const bool ident) {
    constexpr int LD = 136;
    bf16_t* VTl = (bf16_t*)shm;
    bf16_t* WsL = (bf16_t*)(shm + 256 * LD * 2);
    float* st = (float*)(shm + 256 * LD * 2 + 128 * LD * 2);
    const int tid = TID, lane = tid & 63, wid = tid >> 6, l15 = lane & 15, l4 = lane >> 4;
    for (int chunk = BID; chunk < T / 128; chunk += gridDim.x) {
        const int t0 = chunk * 128;
        __syncthreads();
        if (tid < 128) {
            const f32x4* sp = (const f32x4*)(stats + (size_t)(t0 + tid) * 64);
            float s = 0.f, ss = 0.f;
#pragma unroll
            for (int i = 0; i < 16; ++i) { const f32x4 v = sp[i]; s += v[0] + v[2]; ss += v[1] + v[3]; }
            const float mean = s * (1.0f / 4096.0f);
            const float var = ss * (1.0f / 4096.0f) - mean * mean;
            st[2 * tid] = mean; st[2 * tid + 1] = rsqrtf(fmaxf(var, 0.f) + EPS);
        }
        __syncthreads();
        for (int g = 0; g < 16; ++g) {
#pragma unroll
            for (int i = 0; i < 4; ++i) {
                const int id = tid + 512 * i, t = id >> 4, s8 = (id & 15) * 8;
                *(u32x4*)(WsL + t * LD + s8) = *(const u32x4*)(ws16 + ((size_t)g * 128 + t) * 128 + s8);
            }
#pragma unroll
            for (int i = 0; i < 8; ++i) {
                const int id = tid + 512 * i, c = id >> 4, s8 = (id & 15) * 8;
                const u32x4 raw = *(const u32x4*)(GVT + (size_t)(g * 256 + c) * T + t0 + s8);
                const float gg = ln_g[g * 256 + c], bb = ln_b[g * 256 + c];
                float r[8];
#pragma unroll
                for (int q = 0; q < 4; ++q) { r[2 * q] = bflo(raw[q]); r[2 * q + 1] = bfhi(raw[q]); }
#pragma unroll
                for (int q = 0; q < 4; ++q) {
                    const f32x4 mr = *(const f32x4*)(st + 2 * (s8 + 2 * q));
                    r[2 * q] = (r[2 * q] - mr[0]) * mr[1] * gg + bb;
                    r[2 * q + 1] = (r[2 * q + 1] - mr[2]) * mr[3] * gg + bb;
                }
                *(u32x4*)(VTl + c * LD + s8) = pack8f(r);
            }
            __syncthreads();
            f32x4 acc[2][8];
#pragma unroll
            for (int cb = 0; cb < 2; ++cb)
#pragma unroll
                for (int tb = 0; tb < 8; ++tb) acc[cb][tb] = (f32x4){0.f, 0.f, 0.f, 0.f};
#pragma unroll
            for (int ks = 0; ks < 4; ++ks) {
                bf16x8 vf[2];
#pragma unroll
                for (int cb = 0; cb < 2; ++cb) vf[cb] = *(const bf16x8*)(VTl + (wid * 32 + cb * 16 + l15) * LD + ks * 32 + l4 * 8);
#pragma unroll
                for (int tb = 0; tb < 8; ++tb) {
                    if (tb >= 2 * ks) {
                        const bf16x8 wf = *(const bf16x8*)(WsL + (tb * 16 + l15) * LD + ks * 32 + l4 * 8);
#pragma unroll
                        for (int cb = 0; cb < 2; ++cb) acc[cb][tb] = __builtin_amdgcn_mfma_f32_16x16x32_bf16(vf[cb], wf, acc[cb][tb], 0, 0, 0);
                    }
                }
            }
            __syncthreads();
            {
                bf16_t* OutL = (bf16_t*)shm;
#pragma unroll
                for (int tb = 0; tb < 8; ++tb) {
                    const int t = tb * 16 + l15;
                    const float bs = b_s[g * 128 + t];
#pragma unroll
                    for (int cb = 0; cb < 2; ++cb) {
                        const f32x4 a = acc[cb][tb];
                        u32x2 o = {cvt_pk_bf16(a[0] + bs, a[1] + bs), cvt_pk_bf16(a[2] + bs, a[3] + bs)};
                        *(u32x2*)(OutL + t * 264 + wid * 32 + cb * 16 + l4 * 4) = o;
                    }
                }
                __syncthreads();
#pragma unroll
                for (int i = 0; i < 8; ++i) {
                    const int id = tid + 512 * i, blk = id >> 10, t = (id >> 3) & 127, c8 = (id & 7) * 8;
                    bf16_t* pp = P + ((size_t)(g * 4 + blk) * T + t0 + t) * 64 + c8;
                    const u32x4 pv = *(const u32x4*)pp;
                    const u32x4 mv = *(const u32x4*)(OutL + t * 264 + blk * 64 + c8);
                    u32x4 o;
#pragma unroll
                    for (int q = 0; q < 4; ++q) o[q] = ident ? (pv[q] | (mv[q] & 0u)) : cvt_pk_bf16(bflo(pv[q]) * bflo(mv[q]), bfhi(pv[q]) * bfhi(mv[q]));
                    *(u32x4*)pp = o;
                }
            }
            __syncthreads();
        }
    }
}

__device__ __forceinline__ void phase_kpost(const int TID, const int BID, bf16_t* KN, const float* KRAW, bf16_t* KROPE, const float* g_kn, const float* g_kr, const float* cosT, const float* sinT, const bool ident) {
    const int lane = TID & 63, wid = TID >> 6;
    const int gw = BID * 8 + wid, nw = gridDim.x * 8;
    {
        const int sub = lane >> 4, l16 = lane & 15;
        const f32x4 ga = *(const f32x4*)(g_kn + l16 * 8), gb = *(const f32x4*)(g_kn + l16 * 8 + 4);
        const size_t nrows = (size_t)T * 16;
        for (size_t r0 = (size_t)gw * 4 + sub; r0 < nrows; r0 += (size_t)nw * 16) {
            u32x4 raw[4];
#pragma unroll
            for (int u = 0; u < 4; ++u) { const size_t r = r0 + (size_t)u * nw * 4; if (r < nrows) raw[u] = *(const u32x4*)(KN + r * 128 + l16 * 8); }
#pragma unroll
            for (int u = 0; u < 4; ++u) {
                const size_t r = r0 + (size_t)u * nw * 4;
                float v[8]; float ss = 0.f;
#pragma unroll
                for (int q = 0; q < 4; ++q) { v[2 * q] = bflo(raw[u][q]); v[2 * q + 1] = bfhi(raw[u][q]); ss += v[2 * q] * v[2 * q] + v[2 * q + 1] * v[2 * q + 1]; }
                ss += __shfl_xor(ss, 1); ss += __shfl_xor(ss, 2); ss += __shfl_xor(ss, 4); ss += __shfl_xor(ss, 8);
                const float rs = rsqrtf((ss + EPS * 128.0f) * (1.0f / 128.0f));
#pragma unroll
                for (int e = 0; e < 8; ++e) v[e] = v[e] * rs * (e < 4 ? ga[e & 3] : gb[e & 3]);
                if (r < nrows) *(u32x4*)(KN + r * 128 + l16 * 8) = ident ? raw[u] : pack8f(v);
            }
        }
    }
    {
        const float gk = g_kr[lane];
        for (int t0 = gw; t0 < T; t0 += nw * 4) {
            float xs[4];
#pragma unroll
            for (int u = 0; u < 4; ++u) { const int t = t0 + u * nw; xs[u] = t < T ? KRAW[(size_t)t * 64 + lane] : 0.f; }
#pragma unroll
            for (int u = 0; u < 4; ++u) {
                const int t = t0 + u * nw;
                const float x = xs[u];
                float ss = x * x;
#pragma unroll
                for (int o = 32; o >= 1; o >>= 1) ss += __shfl_xor(ss, o);
                const float y = x * rsqrtf((ss + EPS * 64.0f) * (1.0f / 64.0f)) * gk;
                const float other = __shfl_xor(y, 32);
                const int pos = t & (SEQ - 1), i = lane & 31;
                if (t < T) {
                    const float c = cosT[pos * 32 + i], s = sinT[pos * 32 + i];
                    const float o = lane < 32 ? (y * c - other * s) : (y * c + other * s);
                    KROPE[(size_t)t * 64 + lane] = (bf16_t)(cvt_pk_bf16(o, 0.f) & 0xffffu);
                }
            }
        }
    }
}

__device__ __forceinline__ void phase_attn(const int TID, const int BID, unsigned char* shm, const bf16_t* Q, const bf16_t* KN, const bf16_t* KR, const bf16_t* VT, const bf16_t* Zs, bf16_t* Y,
                                           const float* g_qn, const float* g_qr, const float* cosT, const float* sinT) {
    constexpr int KBYTES = 64 * 384, VBYTES = 128 * 128, VBASE = 3 * KBYTES;
    const int tid = TID, wid = __builtin_amdgcn_readfirstlane(tid >> 6), lane = tid & 63, lq = lane & 31, hi = lane >> 5;
    unsigned ksrc[3]; bool krope[3]; unsigned vsrc[2];
#pragma unroll
    for (int i = 0; i < 3; ++i) {
        const int p = (wid * 3 + i) * 64 + lane, r = p / 24, cs = p - r * 24;
        const int c = (cs & ~7) | ((cs & 7) ^ ((r >> 1) & 7));
        krope[i] = c >= 16;
        ksrc[i] = krope[i] ? (unsigned)(r * 64 + (c - 16) * 8) : (unsigned)(r * 2048 + c * 8);
    }
#pragma unroll
    for (int i = 0; i < 2; ++i) {
        const int p = (wid * 2 + i) * 64 + lane, r = p >> 3, cs = p & 7;
        const int c = cs ^ ((r >> 1) & 7);
        vsrc[i] = (unsigned)r * T + c * 8;
    }
    int kfr[4], vfr[4];
    {
        const int x = (lq >> 1) & 7;
#pragma unroll
        for (int j = 0; j < 4; ++j) { kfr[j] = lq * 384 + 16 * ((2 * j + hi) ^ x); vfr[j] = lq * 128 + 16 * ((2 * j + hi) ^ x); }
    }
    LAS unsigned char* ldsb = (LAS unsigned char*)shm;
    for (int item = BID; item < 1024; item += gridDim.x) {
        const int bh = item >> 4, pr = item & 15, b = bh >> 4, h = bh & 15;
        const int tokb = b * SEQ;
        for (int half = 0; half < 2; ++half) {
            const int qb = half == 0 ? (31 - pr) : pr;
            const int q0 = qb * 256, nt = 4 * (qb + 1);
            int lqo = lq, hio = hi; asm volatile("" : "+v"(lqo), "+v"(hio));
            const int qrow = q0 + wid * 32 + lq;
            const int qrow_o = q0 + wid * 32 + lqo;
            bf16x8 qf[12];
            {
                const bf16_t* qp = Q + (size_t)(tokb + qrow_o) * 3072 + h * 192 + hio * 8;
#pragma unroll
                for (int ks = 0; ks < 12; ++ks) qf[ks] = *(const bf16x8*)(qp + ks * 16);
                float ssn = 0.f, ssr = 0.f;
#pragma unroll
                for (int ks = 0; ks < 12; ++ks)
#pragma unroll
                    for (int j = 0; j < 8; ++j) { const float v = bf2f((unsigned short)qf[ks][j]); if (ks < 8) ssn += v * v; else ssr += v * v; }
                ssn = x32_sum(ssn); ssr = x32_sum(ssr);
                const float rn = rsqrtf((ssn + EPS * 128.0f) * (1.0f / 128.0f)) * QSCALE;
                const float rr = rsqrtf((ssr + EPS * 64.0f) * (1.0f / 64.0f));
#pragma unroll
                for (int ks = 0; ks < 8; ++ks) {
                    const f32x4 ga = *(const f32x4*)(g_qn + ks * 16 + hio * 8), gb = *(const f32x4*)(g_qn + ks * 16 + hio * 8 + 4);
                    float r[8];
#pragma unroll
                    for (int j = 0; j < 8; ++j) r[j] = bf2f((unsigned short)qf[ks][j]) * rn * (j < 4 ? ga[j & 3] : gb[j & 3]);
                    const u32x4 o = pack8f(r);
                    qf[ks] = *(const bf16x8*)&o;
                }
#pragma unroll
                for (int kk = 0; kk < 2; ++kk) {
                    const int i0 = 16 * kk + 8 * hio;
                    float r1[8], r2[8];
#pragma unroll
                    for (int j = 0; j < 8; ++j) {
                        const float x1 = bf2f((unsigned short)qf[8 + kk][j]) * rr * g_qr[i0 + j];
                        const float x2 = bf2f((unsigned short)qf[10 + kk][j]) * rr * g_qr[32 + i0 + j];
                        const float c = cosT[qrow_o * 32 + i0 + j], s = sinT[qrow_o * 32 + i0 + j];
                        r1[j] = (x1 * c - x2 * s) * QSCALE; r2[j] = (x2 * c + x1 * s) * QSCALE;
                    }
                    const u32x4 o1 = pack8f(r1), o2 = pack8f(r2);
                    qf[8 + kk] = *(const bf16x8*)&o1; qf[10 + kk] = *(const bf16x8*)&o2;
                }
            }
            f32x16 O[4];
#pragma unroll
            for (int d = 0; d < 4; ++d)
#pragma unroll
                for (int r = 0; r < 16; ++r) O[d][r] = 0.f;
            float m_run = 0.f, l_run = 0.f; bool mz = true;
#define ATT_DMA(t_, buf_) do { const size_t tok0 = (size_t)tokb + (size_t)(t_) * 64; \
                const bf16_t* knb = uniform_ptr(KN + tok0 * 2048 + h * 128); const bf16_t* krb = uniform_ptr(KR + tok0 * 64); const bf16_t* vtb = uniform_ptr(VT + (size_t)(h * 128) * T + tok0); \
                _Pragma("unroll") for (int i_ = 0; i_ < 3; ++i_) { const bf16_t* g_ = (krope[i_] ? krb : knb) + ksrc[i_]; \
                    __builtin_amdgcn_global_load_lds((const unsigned*)g_, (LAS unsigned*)(ldsb + (buf_) * KBYTES + (wid * 3 + i_) * 1024), 16, 0, 0); } \
                _Pragma("unroll") for (int i_ = 0; i_ < 2; ++i_) { const bf16_t* g_ = vtb + vsrc[i_]; \
                    __builtin_amdgcn_global_load_lds((const unsigned*)g_, (LAS unsigned*)(ldsb + VBASE + (buf_) * VBYTES + (wid * 2 + i_) * 1024), 16, 0, 0); } } while (0)
#define SB_() __builtin_amdgcn_sched_barrier(0)
#define LDKG_(ks_) do { f[0] = *(const bf16x8*)(kpn + kfr[(ks_) & 3] + ((ks_) / 4) * 128); f[1] = *(const bf16x8*)(kpn + kfr[(ks_) & 3] + 12288 + ((ks_) / 4) * 128); } while (0)
#define MMKG_(Sa_, Sb_, ks_) do { Sa_ = __builtin_amdgcn_mfma_f32_32x32x16_bf16(f[0], qf[ks_], Sa_, 0, 0, 0); Sb_ = __builtin_amdgcn_mfma_f32_32x32x16_bf16(f[1], qf[ks_], Sb_, 0, 0, 0); } while (0)
#define LDVK_(dst, kk_) do { _Pragma("unroll") for (int j_ = 0; j_ < 4; ++j_) dst[j_] = *(const bf16x8*)(vp + vfr[kk_] + j_ * 4096); } while (0)
#define MMVK_(src, kk_) do { _Pragma("unroll") for (int j_ = 0; j_ < 4; ++j_) O[j_] = __builtin_amdgcn_mfma_f32_32x32x16_bf16(src[j_], pf[kk_], O[j_], 0, 0, 0); } while (0)
#define LDV2_(dst, kk_, dp_) do { dst[0] = *(const bf16x8*)(vp + vfr[kk_] + (2 * (dp_)) * 4096); dst[1] = *(const bf16x8*)(vp + vfr[kk_] + (2 * (dp_) + 1) * 4096); } while (0)
#define MMV2_(src, kk_, dp_) do { O[2 * (dp_)] = __builtin_amdgcn_mfma_f32_32x32x16_bf16(src[0], pf[kk_], O[2 * (dp_)], 0, 0, 0); O[2 * (dp_) + 1] = __builtin_amdgcn_mfma_f32_32x32x16_bf16(src[1], pf[kk_], O[2 * (dp_) + 1], 0, 0, 0); } while (0)
#define EXPR_(S_, r0_, r1_) do { _Pragma("unroll") for (int r_ = (r0_); r_ < (r1_); ++r_) { S_[r_] = __builtin_amdgcn_exp2f(S_[r_]); ps += S_[r_]; } } while (0)
#define ATT_STEP(Sc0_, Sc1_, Sn0_, Sn1_) do { \
                const int rel = t - (nt - 4); \
                if (t + 2 < nt) ATT_DMA(t + 2, kb2); \
                if (rel <= (wid >> 1)) { \
                    const unsigned char* kpn = shm + kb1 * KBYTES; const unsigned char* vp = shm + VBASE + kb0 * VBYTES; \
                    bf16x8 f[2]; float ps = 0.f; \
                    _Pragma("unroll") for (int r_ = 0; r_ < 16; ++r_) { Sn0_[r_] = 0.f; Sn1_[r_] = 0.f; } \
                    LDKG_(0); SB_(); \
                    MMKG_(Sn0_, Sn1_, 0); LDKG_(1); \
                    if (rel >= 0) { const int dq = qrow - t * 64 - 4 * hi; float ninf_; asm volatile("v_mov_b32 %0, 0xff800000" : "=v"(ninf_)); \
                        _Pragma("unroll") for (int r_ = 0; r_ < 16; ++r_) { const int c_ = (r_ & 3) + 8 * (r_ >> 2); if (c_ > dq) Sc0_[r_] = ninf_; if (c_ + 32 > dq) Sc1_[r_] = ninf_; } } \
                    SB_(); \
                    MMKG_(Sn0_, Sn1_, 1); LDKG_(2); \
                    float mx = fmaxf(Sc0_[0], Sc1_[0]); \
                    _Pragma("unroll") for (int r_ = 1; r_ < 16; ++r_) mx = fmaxf(mx, fmaxf(Sc0_[r_], Sc1_[r_])); \
                    SB_(); \
                    MMKG_(Sn0_, Sn1_, 2); LDKG_(3); \
                    mx = x32_max(mx); \
                    const bool fast = mz && (__builtin_amdgcn_ballot_w64((mx > 12.0f) || (t == 0 && mx < -64.0f)) == 0ull); \
                    if (!fast) { \
                        mz = false; \
                        const float mn = (t == 0) ? mx : fmaxf(m_run, mx); \
                        const float alpha = (t == 0) ? 1.0f : __builtin_amdgcn_exp2f(m_run - mn); \
                        m_run = mn; l_run *= alpha; \
                        _Pragma("unroll") for (int r_ = 0; r_ < 16; ++r_) { Sc0_[r_] -= mn; Sc1_[r_] -= mn; } \
                        _Pragma("unroll") for (int d_ = 0; d_ < 4; ++d_) _Pragma("unroll") for (int r_ = 0; r_ < 16; ++r_) O[d_][r_] *= alpha; \
                    } \
                    SB_(); \
                    MMKG_(Sn0_, Sn1_, 3); LDKG_(4); EXPR_(Sc0_, 0, 4); SB_(); \
                    MMKG_(Sn0_, Sn1_, 4); LDKG_(5); EXPR_(Sc0_, 4, 8); SB_(); \
                    MMKG_(Sn0_, Sn1_, 5); LDKG_(6); EXPR_(Sc0_, 8, 12); SB_(); \
                    MMKG_(Sn0_, Sn1_, 6); LDKG_(7); EXPR_(Sc0_, 12, 16); SB_(); \
                    MMKG_(Sn0_, Sn1_, 7); LDKG_(8); EXPR_(Sc1_, 0, 4); SB_(); \
                    MMKG_(Sn0_, Sn1_, 8); LDKG_(9); EXPR_(Sc1_, 4, 8); SB_(); \
                    MMKG_(Sn0_, Sn1_, 9); LDKG_(10); EXPR_(Sc1_, 8, 12); SB_(); \
                    MMKG_(Sn0_, Sn1_, 10); LDKG_(11); EXPR_(Sc1_, 12, 16); SB_(); \
                    bf16x8 pf[4]; \
                    MMKG_(Sn0_, Sn1_, 11); \
                    { u32x4 a_ = {cvt_pk_bf16(Sc0_[0], Sc0_[1]), cvt_pk_bf16(Sc0_[2], Sc0_[3]), cvt_pk_bf16(Sc0_[4], Sc0_[5]), cvt_pk_bf16(Sc0_[6], Sc0_[7])}; \
                      u32x4 b_ = {cvt_pk_bf16(Sc0_[8], Sc0_[9]), cvt_pk_bf16(Sc0_[10], Sc0_[11]), cvt_pk_bf16(Sc0_[12], Sc0_[13]), cvt_pk_bf16(Sc0_[14], Sc0_[15])}; \
                      u32x4 c_ = {cvt_pk_bf16(Sc1_[0], Sc1_[1]), cvt_pk_bf16(Sc1_[2], Sc1_[3]), cvt_pk_bf16(Sc1_[4], Sc1_[5]), cvt_pk_bf16(Sc1_[6], Sc1_[7])}; \
                      u32x4 d_ = {cvt_pk_bf16(Sc1_[8], Sc1_[9]), cvt_pk_bf16(Sc1_[10], Sc1_[11]), cvt_pk_bf16(Sc1_[12], Sc1_[13]), cvt_pk_bf16(Sc1_[14], Sc1_[15])}; \
                      pf[0] = *(const bf16x8*)&a_; pf[1] = *(const bf16x8*)&b_; pf[2] = *(const bf16x8*)&c_; pf[3] = *(const bf16x8*)&d_; } \
                    l_run += ps; \
                    SB_(); \
                    bf16x8 va[2], vb[2]; \
                    LDV2_(va, 0, 0); SB_(); \
                    LDV2_(vb, 0, 1); SB_(); MMV2_(va, 0, 0); SB_(); \
                    LDV2_(va, 1, 0); SB_(); MMV2_(vb, 0, 1); SB_(); \
                    LDV2_(vb, 1, 1); SB_(); MMV2_(va, 1, 0); SB_(); \
                    LDV2_(va, 2, 0); SB_(); MMV2_(vb, 1, 1); SB_(); \
                    LDV2_(vb, 2, 1); SB_(); MMV2_(va, 2, 0); SB_(); \
                    LDV2_(va, 3, 0); SB_(); MMV2_(vb, 2, 1); SB_(); \
                    LDV2_(vb, 3, 1); SB_(); MMV2_(va, 3, 0); SB_(); \
                    MMV2_(vb, 3, 1); SB_(); \
                } \
                asm volatile("s_waitcnt vmcnt(0)" ::: "memory"); \
                __syncthreads(); \
                { const int k_ = kb0; kb0 = kb1; kb1 = kb2; kb2 = k_; } \
                ++t; } while (0)
            __syncthreads();
            ATT_DMA(0, 0); ATT_DMA(1, 1);
            asm volatile("s_waitcnt vmcnt(0)" ::: "memory");
            __syncthreads();
            f32x16 SA0, SA1, SB0, SB1;
            int kb0 = 0, kb1 = 1, kb2 = 2, t = 0;
            {
                const unsigned char* kpn = shm;
                bf16x8 f[2];
#pragma unroll
                for (int r = 0; r < 16; ++r) { SA0[r] = 0.f; SA1[r] = 0.f; }
#pragma unroll
                for (int ks = 0; ks < 12; ++ks) { LDKG_(ks); MMKG_(SA0, SA1, ks); }
            }
            while (t < nt) {
                ATT_STEP(SA0, SA1, SB0, SB1);
                ATT_STEP(SB0, SB1, SA0, SA1);
            }
#undef ATT_STEP
#undef SB_
#undef LDKG_
#undef MMKG_
#undef LDVK_
#undef MMVK_
#undef LDV2_
#undef MMV2_
#undef EXPR_
#undef ATT_DMA
            const float lt = x32_sum(l_run);
            const float inv = 1.0f / lt;
            int lqe = lq, hie = hi; asm volatile("" : "+v"(lqe), "+v"(hie));
            const size_t yoff = (size_t)(tokb + q0 + wid * 32 + lqe) * 2048 + h * 128 + 4 * hie;
            const bf16_t* zp = Zs + yoff; bf16_t* yp = Y + yoff;
#pragma unroll
            for (int db = 0; db < 4; ++db)
#pragma unroll
                for (int g4 = 0; g4 < 4; ++g4) {
                    bf16_t* pp = yp + db * 32 + g4 * 8;
                    const u32x2 zv = *(const u32x2*)(zp + db * 32 + g4 * 8);
                    u32x2 o = {cvt_pk_bf16(O[db][4 * g4 + 0] * inv * bflo(zv[0]), O[db][4 * g4 + 1] * inv * bfhi(zv[0])),
                               cvt_pk_bf16(O[db][4 * g4 + 2] * inv * bflo(zv[1]), O[db][4 * g4 + 3] * inv * bfhi(zv[1]))};
                    *(u32x2*)pp = o;
                }
        }
    }
}

enum { PH_PREP = 0, PH_NORM_A0, PH_AIN0, PH_MIX0, PH_AOUT0, PH_NORM_A1, PH_AIN1, PH_MIX1, PH_AOUT1, PH_NORM_KV, PH_DKV_BIN0, PH_UKV_UQ0, PH_KPOST, PH_ATTN0, PH_BOUT0,
       PH_NORM_B1, PH_BIN1, PH_UQ1, PH_ATTN1, PH_BOUT1, NPH };
#if REP_GEMM == 2
#define RG_(x) x, x,
#else
#define RG_(x) x,
#endif
#if REP_AIN == 2
#define RI_(x) x, x,
#else
#define RI_(x) x,
#endif
#if REP_MIX == 2
#define RM_(x) x, (x) | 0x80,
#else
#define RM_(x) x,
#endif
#if REP_ATTN == 2
#define RA_(x) x, x,
#else
#define RA_(x) x,
#endif
#if REP_LIGHT == 2
#define RL_(x) x, x,
#else
#define RL_(x) x,
#endif
__device__ const int g_seq[] = { RL_(PH_PREP) RL_(PH_NORM_A0) RI_(PH_AIN0) RM_(PH_MIX0) RG_(PH_AOUT0) RL_(PH_NORM_A1) RI_(PH_AIN1) RM_(PH_MIX1) PH_AOUT1, RL_(PH_NORM_KV) RG_(PH_DKV_BIN0) RG_(PH_UKV_UQ0)
                                           RM_(PH_KPOST) RA_(PH_ATTN0) PH_BOUT0, RL_(PH_NORM_B1) RG_(PH_BIN1) RG_(PH_UQ1) RA_(PH_ATTN1) PH_BOUT1 };
constexpr int NSEQ = (int)(sizeof(g_seq) / sizeof(int));

__global__ void __launch_bounds__(512, 2) mega(Params p) {
    extern __shared__ __attribute__((aligned(16))) unsigned char shm[];
    LAS unsigned char* lds = (LAS unsigned char*)shm;
    const int wid_s = __builtin_amdgcn_readfirstlane((int)(threadIdx.x >> 6));
    for (int pi = p.ph_lo; pi < p.ph_hi; ++pi) {
        const int phv = g_seq[pi]; const int ph = phv & 0x7f; const bool ident = (phv & 0x80) != 0;
        int lane_; asm volatile("v_mbcnt_lo_u32_b32 %0, -1, 0\n\tv_mbcnt_hi_u32_b32 %0, -1, %0" : "=v"(lane_));
        int TID = wid_s * 64 + lane_, BID = blockIdx.x; unsigned long long zoff_ = 0; asm volatile("" : "+s"(zoff_)); unsigned char* ws = p.ws + zoff_;
        asm volatile("" : "+v"(TID), "+s"(BID));
        const float* mod = (const float*)(ws + WS_MOD);
        const float* kvmod = (const float*)(ws + WS_KVMOD);
        const float* cosT = (const float*)(ws + WS_COS);
        const float* sinT = (const float*)(ws + WS_SIN);
        switch (ph) {
#if PHSEL & 1
        case PH_PREP: phase_prep(TID, BID, p, ws, shm); break;
#endif
#if PHSEL & 2
        case PH_NORM_A0: case PH_NORM_A1: case PH_NORM_B1: {
            const int l = ph == PH_NORM_A0 ? 0 : (ph == PH_NORM_A1 ? 1 : 3);
            const float* x = l == 0 ? p.in[I_X] : p.out;
            const float* m = mod + (size_t)l * 4 * 6144;
            phase_norm(TID, BID, x, p.in[I_NORM_G] + l * DM, m, m + 2048, 6144, (bf16_t*)(ws + WA_H), nullptr, nullptr, nullptr, 0, nullptr);
        } break;
#endif
#if PHSEL & 4
        case PH_NORM_KV: {
            const float* m = mod + (size_t)2 * 4 * 6144;
            phase_norm(TID, BID, p.out, p.in[I_NORM_G] + 2 * DM, m, m + 2048, 6144, (bf16_t*)(ws + WB_H), p.in[I_KV_NORM_G], kvmod, kvmod + 2048, 4096, (bf16_t*)(ws + WB_HKV));
        } break;
#endif
#if PHSEL & 8
        case PH_AIN0: case PH_AIN1: {
            const int l = ph == PH_AIN0 ? 0 : 1;
            const bf16_t* W = (const bf16_t*)(ws + WS_WINA) + (size_t)l * 12288 * 2048;
            EpiUZ E{(bf16_t*)(ws + WA_P)};
            run_gemm(TID, BID, lds, (const bf16_t*)(ws + WA_H), W, T, 8192, 2048, E);
            EpiGVT E2{(bf16_t*)(ws + WA_GVT), (float*)(ws + WA_STATS)};
            run_gemm(TID, BID, lds, W + (size_t)8192 * 2048, (const bf16_t*)(ws + WA_H), 4096, T, 2048, E2);
        } break;
#endif
#if PHSEL & 16
        case PH_MIX0: case PH_MIX1: {
            const int l = ph == PH_MIX0 ? 0 : 1;
            phase_mix(TID, BID, shm, (bf16_t*)(ws + WA_P), (const bf16_t*)(ws + WA_GVT), (const float*)(ws + WA_STATS), (const bf16_t*)(ws + WS_WS16) + (size_t)l * 16 * 128 * 128, p.in[I_A_B_S] + l * 16 * 128,
                      p.in[I_A_LN_G] + l * GMW, p.in[I_A_LN_B] + l * GMW, ident);
        } break;
#endif
#if PHSEL & 32
        case PH_AOUT0: case PH_AOUT1: case PH_BOUT0: case PH_BOUT1: {
            const int l = ph == PH_AOUT0 ? 0 : (ph == PH_AOUT1 ? 1 : (ph == PH_BOUT0 ? 2 : 3));
            const float* xin = l == 0 ? p.in[I_X] : p.out;
            EpiRes E{xin, p.out, mod + (size_t)l * 4 * 6144 + 4096, 6144};
            const bf16_t* A = l < 2 ? (const bf16_t*)(ws + WA_P) : (const bf16_t*)(ws + WB_Y);
            const bf16_t* Bt = l < 2 ? (const bf16_t*)(ws + WS_WOUTA) + (size_t)l * 2048 * 4096 : (const bf16_t*)(ws + WS_WOUTB) + (size_t)(l - 2) * 2048 * 2048;
            run_gemm(TID, BID, lds, A, Bt, T, 2048, l < 2 ? 4096 : 2048, E, l < 2);
        } break;
#endif
#if PHSEL & 64
        case PH_DKV_BIN0: case PH_BIN1: {
            if (ph == PH_DKV_BIN0) {
                EpiLat<0> E{(bf16_t*)(ws + WB_CKV), (float*)(ws + WB_SSQKV), (float*)(ws + WB_KRAW), nullptr};
                run_gemm(TID, BID, lds, (const bf16_t*)(ws + WB_HKV), (const bf16_t*)(ws + WS_WDKV), T, 768, 2048, E);
            }
            const int j = ph == PH_DKV_BIN0 ? 0 : 1;
            EpiLat<1> E{(bf16_t*)(ws + WB_CQ), (float*)(ws + WB_SSQQ), nullptr, (bf16_t*)(ws + WB_Z)};
            run_gemm(TID, BID, lds, (const bf16_t*)(ws + WB_H), (const bf16_t*)(ws + WS_WINB) + (size_t)j * 2560 * 2048, T, 2560, 2048, E);
        } break;
#endif
#if PHSEL & 128
        case PH_UKV_UQ0: case PH_UQ1: {
            if (ph == PH_UKV_UQ0) {
                EpiScaled E{(bf16_t*)(ws + WB_KN), 2048, (const float*)(ws + WB_SSQKV)};
                run_gemm(TID, BID, lds, (const bf16_t*)(ws + WB_CKV), (const bf16_t*)(ws + WS_WKN), T, 2048, 512, E);
                EpiVT E2{(bf16_t*)(ws + WB_VT), (const float*)(ws + WB_SSQKV)};
                run_gemm(TID, BID, lds, (const bf16_t*)(ws + WS_WV), (const bf16_t*)(ws + WB_CKV), 2048, T, 512, E2);
            }
            const int j = ph == PH_UKV_UQ0 ? 0 : 1;
            EpiScaled E{(bf16_t*)(ws + WB_Q), 3072, (const float*)(ws + WB_SSQQ)};
            run_gemm(TID, BID, lds, (const bf16_t*)(ws + WB_CQ), (const bf16_t*)(ws + WS_WUQ) + (size_t)j * 3072 * 512, T, 3072, 512, E);
        } break;
#endif
#if PHSEL & 256
        case PH_KPOST:
            phase_kpost(TID, BID, (bf16_t*)(ws + WB_KN), (const float*)(ws + WB_KRAW), (bf16_t*)(ws + WB_KROPE), p.in[I_KV_G_KN], p.in[I_KV_G_KR], cosT, sinT, ident);
            break;
#endif
#if PHSEL & 512
        case PH_ATTN0: case PH_ATTN1: {
            const int j = ph == PH_ATTN0 ? 0 : 1;
            phase_attn(TID, BID, shm, (const bf16_t*)(ws + WB_Q), (const bf16_t*)(ws + WB_KN), (const bf16_t*)(ws + WB_KROPE), (const bf16_t*)(ws + WB_VT), (const bf16_t*)(ws + WB_Z), (bf16_t*)(ws + WB_Y),
                       p.in[I_B_G_QN] + j * 128, p.in[I_B_G_QR] + j * 64, cosT, sinT);
        } break;
#endif
        default: break;
        }
        if (pi + 1 < p.ph_hi) {
            if (pi == p.ph_lo) cg::this_grid().sync();
            else grid_bar((unsigned*)(p.ws + WS_BAR), (unsigned)(pi - p.ph_lo), TID, BID);
        }
    }
}

extern "C" void kernel_launch(void* const* d_in, const int* in_sizes, int n_in, void* d_out, int out_size, void* d_ws, size_t ws_size, hipStream_t stream) {
    static int grid = 0;
    if (grid == 0) {
        if (n_in != 25 || ws_size < WS_NEED) { fprintf(stderr, "kernel_launch: unexpected n_in %d / ws %zu (need %zu)\n", n_in, ws_size, (size_t)WS_NEED); grid = -1; return; }
        int dev = 0, cus = 0, per_cu = 0;
        hipGetDevice(&dev);
        hipDeviceGetAttribute(&cus, hipDeviceAttributeMultiprocessorCount, dev);
        if (hipFuncSetAttribute((const void*)mega, hipFuncAttributeMaxDynamicSharedMemorySize, LDS_BYTES) != hipSuccess) { fprintf(stderr, "kernel_launch: hipFuncSetAttribute failed\n"); grid = -1; return; }
        if (hipOccupancyMaxActiveBlocksPerMultiprocessor(&per_cu, (const void*)mega, 512, LDS_BYTES) != hipSuccess || per_cu < 1) { fprintf(stderr, "kernel_launch: occupancy query gave %d\n", per_cu); per_cu = 1; }
        (void)hipGetLastError();
        grid = cus * per_cu;
    }
    if (grid < 0) return;
    Params p{};
    for (int i = 0; i < 25; ++i) p.in[i] = (const float*)d_in[i];
    p.out = (float*)d_out; p.ws = (unsigned char*)d_ws;
#if MK_SINGLE
    p.ph_lo = 0; p.ph_hi = NSEQ;
    if (hipMemsetAsync((char*)d_ws + WS_BAR, 0, 4096, stream) != hipSuccess) { fprintf(stderr, "kernel_launch: memset of the barrier words failed\n"); return; }
    void* args[] = {&p};
    hipError_t e = hipLaunchCooperativeKernel((const void*)mega, dim3(grid), dim3(512), args, LDS_BYTES, stream);
    if (e != hipSuccess) fprintf(stderr, "cooperative launch failed: %s (grid %d)\n", hipGetErrorString(e), grid);
#else
    for (int ph = 0; ph < NSEQ; ++ph) {
        p.ph_lo = ph; p.ph_hi = ph + 1;
        hipLaunchKernelGGL(mega, dim3(grid), dim3(512), LDS_BYTES, stream, p);
    }
#endif
}
```

```cpp
#include <hip/hip_runtime.h>
#include <hip/hip_cooperative_groups.h>
#include <cstdio>
#include <cstdint>
namespace cg = cooperative_groups;

#ifndef PHSEL
#define PHSEL 0xFFFF
#endif
#ifndef REP_ATTN
#define REP_ATTN 1
#endif
#ifndef REP_MIX
#define REP_MIX 1
#endif
#ifndef REP_AIN
#define REP_AIN 1
#endif
#ifndef REP_GEMM
#define REP_GEMM 1
#endif
#ifndef REP_LIGHT
#define REP_LIGHT 1
#endif
#ifndef MK_SINGLE
#define MK_SINGLE 1
#endif

typedef unsigned short bf16_t;
typedef short bf16x8 __attribute__((ext_vector_type(8)));
typedef float f32x2 __attribute__((ext_vector_type(2)));
typedef float f32x4 __attribute__((ext_vector_type(4)));
typedef float f32x16 __attribute__((ext_vector_type(16)));
typedef unsigned u32x4 __attribute__((ext_vector_type(4)));
typedef unsigned u32x2 __attribute__((ext_vector_type(2)));
#define LAS __attribute__((address_space(3)))
#define GAS __attribute__((address_space(1)))

constexpr int T = 32768, DM = 2048, SEQ = 8192, NBATCH = 4;
constexpr int GMW = 4096;
constexpr float EPS = 1e-6f;
constexpr float QSCALE = 0.07216878364870322f * 1.4426950408889634f;

constexpr size_t WS_BAR = 0;
constexpr size_t WS_MOD = 4096;
constexpr size_t WS_KVMOD = WS_MOD + 4ull * 4 * 6144 * 4;
constexpr size_t WS_COS = WS_KVMOD + 4ull * 4096 * 4;
constexpr size_t WS_SIN = WS_COS + 8192ull * 32 * 4;
constexpr size_t WS_WINA = WS_SIN + 8192ull * 32 * 4;
constexpr size_t WS_WOUTA = WS_WINA + 2ull * 12288 * 2048 * 2;
constexpr size_t WS_WDKV = WS_WOUTA + 2ull * 2048 * 4096 * 2;
constexpr size_t WS_WKN = WS_WDKV + 768ull * 2048 * 2;
constexpr size_t WS_WV = WS_WKN + 2048ull * 512 * 2;
constexpr size_t WS_WINB = WS_WV + 2048ull * 512 * 2;
constexpr size_t WS_WUQ = WS_WINB + 2ull * 2560 * 2048 * 2;
constexpr size_t WS_WOUTB = WS_WUQ + 2ull * 3072 * 512 * 2;
constexpr size_t WS_WS16 = WS_WOUTB + 2ull * 2048 * 2048 * 2;
constexpr size_t WS_ACT = WS_WS16 + 2ull * 16 * 128 * 128 * 2;
constexpr size_t WA_H = WS_ACT;
constexpr size_t WA_P = WA_H + (size_t)T * 2048 * 2;
constexpr size_t WA_GVT = WA_P + (size_t)T * 4096 * 2;
constexpr size_t WA_STATS = WA_GVT + (size_t)T * 4096 * 2;
constexpr size_t WA_END = WA_STATS + (size_t)T * 32 * 2 * 4;
constexpr size_t WB_H = WS_ACT;
constexpr size_t WB_HKV = WB_H + (size_t)T * 2048 * 2;
constexpr size_t WB_Q = WS_ACT;
constexpr size_t WB_CKV = WB_HKV + (size_t)T * 2048 * 2;
constexpr size_t WB_CQ = WB_CKV + (size_t)T * 512 * 2;
constexpr size_t WB_KRAW = WB_CQ + (size_t)T * 512 * 2;
constexpr size_t WB_KROPE = WB_KRAW + (size_t)T * 64 * 4;
constexpr size_t WB_SSQKV = WB_KROPE + (size_t)T * 64 * 2;
constexpr size_t WB_SSQQ = WB_SSQKV + (size_t)T * 8 * 4;
constexpr size_t WB_Z = WB_SSQQ + (size_t)T * 8 * 4;
constexpr size_t WB_KN = WB_Z + (size_t)T * 2048 * 2;
constexpr size_t WB_VT = WB_KN + (size_t)T * 2048 * 2;
constexpr size_t WB_END = WB_VT + (size_t)T * 2048 * 2;
constexpr size_t WB_Y = WB_Q + (size_t)T * 3072 * 2;
static_assert(WB_Y + (size_t)T * 2048 * 2 == WB_KRAW, "Y overlay");
constexpr size_t WS_NEED = WA_END > WB_END ? WA_END : WB_END;
static_assert(WS_NEED <= (1ull << 30), "workspace");

constexpr int LDS_BYTES = 139264;

__device__ __forceinline__ unsigned cvt_pk_bf16(float lo, float hi) { unsigned r; asm volatile("v_cvt_pk_bf16_f32 %0, %1, %2" : "=v"(r) : "v"(lo), "v"(hi)); return r; }
__device__ __forceinline__ float bf2f(unsigned short v) { return __uint_as_float(((unsigned)v) << 16); }
__device__ __forceinline__ float bflo(unsigned w) { return __uint_as_float(w << 16); }
__device__ __forceinline__ float bfhi(unsigned w) { return __uint_as_float(w & 0xffff0000u); }
__device__ __forceinline__ float gelu_f(float x) {
    const float u = x * (1.0f + 0.044715f * x * x);
    const float e = __builtin_amdgcn_exp2f(-2.302208198f * u);
    return x * __builtin_amdgcn_rcpf(1.0f + e);
}
__device__ __forceinline__ float silu_f(float x) { const float e = __builtin_amdgcn_exp2f(-1.4426950408889634f * x); return x * __builtin_amdgcn_rcpf(1.0f + e); }
__device__ __forceinline__ u32x4 pack8f(const float* r) { u32x4 o = {cvt_pk_bf16(r[0], r[1]), cvt_pk_bf16(r[2], r[3]), cvt_pk_bf16(r[4], r[5]), cvt_pk_bf16(r[6], r[7])}; return o; }

template <class Tp> __device__ __forceinline__ Tp* uniform_ptr(Tp* p) {
    const unsigned long long v = (unsigned long long)p; const unsigned lo = __builtin_amdgcn_readfirstlane((unsigned)v), hi = __builtin_amdgcn_readfirstlane((unsigned)(v >> 32));
    return (Tp*)(GAS Tp*)(((unsigned long long)hi << 32) | lo);
}
__device__ __forceinline__ float x32_sum(float v) { auto rr = __builtin_amdgcn_permlane32_swap(__float_as_uint(v), __float_as_uint(v), false, false); return __uint_as_float(rr[0]) + __uint_as_float(rr[1]); }
__device__ __forceinline__ float x32_max(float v) { auto rr = __builtin_amdgcn_permlane32_swap(__float_as_uint(v), __float_as_uint(v), false, false); return fmaxf(__uint_as_float(rr[0]), __uint_as_float(rr[1])); }

__device__ __forceinline__ void grid_bar(unsigned* bar, const unsigned epoch, const int TID, const int BID) {
    __syncthreads();
    if (TID == 0) {
        const unsigned G = gridDim.x, g = (unsigned)BID & 7u;
        const unsigned cnt = (G + 7u - g) >> 3;
        const unsigned ngrp = G < 8u ? G : 8u;
        __builtin_amdgcn_fence(__ATOMIC_RELEASE, "agent");
        const unsigned old = __hip_atomic_fetch_add(bar + 64 * (1 + g), 1u, __ATOMIC_RELAXED, __HIP_MEMORY_SCOPE_AGENT);
        if (old + 1u == cnt * epoch) {
            __builtin_amdgcn_fence(__ATOMIC_ACQ_REL, "agent");
            __hip_atomic_fetch_add(bar, 1u, __ATOMIC_RELAXED, __HIP_MEMORY_SCOPE_AGENT);
        }
        while (__hip_atomic_load(bar, __ATOMIC_RELAXED, __HIP_MEMORY_SCOPE_AGENT) < ngrp * epoch) __builtin_amdgcn_s_sleep(1);
        __builtin_amdgcn_fence(__ATOMIC_ACQUIRE, "agent");
    }
    __syncthreads();
}

namespace pg8 {
constexpr int BM = 256, BK = 64, HALF = 128, HTB = HALF * BK * 2, STAGE_BYTES = 8 * HTB, NXCD = 8, WGM = 8;
__host__ __device__ __forceinline__ int lds_byte(int r, int c) { const int st = (r >> 4) * 2 + (c >> 5), rr = r & 15, cc = c & 31, ob = rr * 64 + cc * 2; return st * 1024 + (ob ^ (((ob >> 9) & 1) << 5)); }
__host__ __device__ __forceinline__ void stage_rc(int b, int& R, int& C) { const int st = b / 1024, sb = b % 1024, swz = sb ^ (((sb >> 9) & 1) << 5); R = (st >> 1) * 16 + swz / 64; C = (st & 1) * 32 + (swz % 64) / 2; }
__host__ __device__ __forceinline__ int perm32(int rho) { const int n = rho >> 4, i = rho & 15; return 8 * (i >> 2) + 4 * n + (i & 3); }
struct Unit { int pm, pn; };
struct Gemm { const bf16_t* A; const bf16_t* Bt; int M, N, K; int a_rs; size_t a_kstep; };
struct StaticOrder {
    int nM, nN, nwg, G, c, wgm;
    __host__ __device__ void init(int M, int N, int G_, int c_, int wgm_) { nM = M / BM; nN = N / BM; nwg = nM * nN; G = G_; c = c_; wgm = wgm_; }
    __host__ __device__ bool next(int i, Unit& u) const {
        const int L = i * G + c; if (L >= nwg) return false;
        int wgid = (int)L; { const int q = nwg / NXCD, r = nwg % NXCD, xcd = wgid % NXCD, off = wgid / NXCD; wgid = (xcd < r ? xcd * (q + 1) : r * (q + 1) + (xcd - r) * q) + off; }
        const int nig = wgm * nN, gid = wgid / nig, fm = gid * wgm, gsz = (nM - fm) < wgm ? (nM - fm) : wgm;
        u.pm = fm + ((wgid % nig) % gsz); u.pn = (wgid % nig) / gsz; return true;
    }
    __device__ __forceinline__ void a_ready(const Unit&) const {}
    __device__ __forceinline__ void done(const Unit&) const {}
};

template <class Epi, class Sched>
__device__ __forceinline__ void gemm_phase(const int TID, LAS unsigned char* lds, const Gemm g, const Sched& S, const Epi& E) {
    const int tid = TID, wid = __builtin_amdgcn_readfirstlane(tid >> 6), lane = tid & 63, wr = wid >> 2, wc = wid & 3, fr = lane & 15, fq = lane >> 4;
    const int K = g.K, nt = K / BK;
    unsigned voffA[2], voffB[2];
#pragma unroll
    for (int i = 0; i < 2; ++i) { int R, C; stage_rc(tid * 16 + i * 8192, R, C); const int Rb = Epi::PERM ? ((R & ~31) + perm32(R & 31)) : R;
        voffA[i] = (unsigned)(R * g.a_rs + C) * 2u; voffB[i] = (unsigned)(Rb * K + C) * 2u; }
    const size_t kstep = (size_t)(BK * 2), kstepA = g.a_kstep;
    const size_t hstep = (size_t)HALF * K * 2, hstepA = (size_t)HALF * g.a_rs * 2;
    const size_t tstep = 2 * hstep, tstepA = 2 * hstepA;
    const unsigned ldsw = (unsigned)wid * 1024u;
    const int aoff = lds_byte(wr * 64 + fr, fq * 8), boff = lds_byte(wc * 32 + fr, fq * 8);
#define PG8_SA(b, h) (((b) * 2 + (h)) * HTB)
#define PG8_SB(b, h) ((4 + (b) * 2 + (h)) * HTB)
#define PG8_STAGE(bufoff, gbase, voff) do { _Pragma("unroll") for (int _i = 0; _i < 2; ++_i) \
        __builtin_amdgcn_global_load_lds((const unsigned*)((const char*)(gbase) + (voff)[_i]), (LAS unsigned*)(lds + (bufoff) + ldsw + _i * 8192), 16, 0, 0); } while (0)
#define PG8_LDA(dst, b, h) do { _Pragma("unroll") for (int m = 0; m < 4; ++m) _Pragma("unroll") for (int k = 0; k < 2; ++k) dst[m][k] = *(const LAS bf16x8*)(lds + PG8_SA(b, h) + aoff + m * 2048 + k * 1024); } while (0)
#define PG8_LDB(dst, b, h) do { _Pragma("unroll") for (int n = 0; n < 2; ++n) _Pragma("unroll") for (int k = 0; k < 2; ++k) dst[n][k] = *(const LAS bf16x8*)(lds + PG8_SB(b, h) + boff + n * 2048 + k * 1024); } while (0)
#define PG8_MMA(ai, bj, At, Bt) do { __builtin_amdgcn_s_setprio(1); _Pragma("unroll") for (int m = 0; m < 4; ++m) _Pragma("unroll") for (int n = 0; n < 2; ++n) _Pragma("unroll") for (int k = 0; k < 2; ++k) \
        acc[ai][bj][m][n] = __builtin_amdgcn_mfma_f32_16x16x32_bf16(Bt[n][k], At[m][k], acc[ai][bj][m][n], 0, 0, 0); __builtin_amdgcn_s_setprio(0); } while (0)
#define PG8_WAIT_V(n) asm volatile("s_waitcnt vmcnt(" #n ")" ::: "memory")
#define PG8_WAIT_L(n) asm volatile("s_waitcnt lgkmcnt(" #n ")" ::: "memory")
#define PG8_BAR __builtin_amdgcn_s_barrier()
#define PG8_SCHED __builtin_amdgcn_sched_barrier(0)
    Unit cur, nxt; int ui = 0;
    if (!S.next(0, cur)) return;
    f32x4 acc[2][2][4][2];
#pragma unroll
    for (int a = 0; a < 2; ++a)
#pragma unroll
        for (int b = 0; b < 2; ++b)
#pragma unroll
            for (int m = 0; m < 4; ++m)
#pragma unroll
                for (int n = 0; n < 2; ++n) acc[a][b][m][n] = (f32x4){0.f, 0.f, 0.f, 0.f};
    bf16x8 At[4][2], B0[2][2], B1[2][2];
    const char* cA = (const char*)g.A + (size_t)cur.pm * tstepA; const char* cB = (const char*)g.Bt + (size_t)cur.pn * tstep;
    S.a_ready(cur);
    PG8_STAGE(PG8_SB(0, 0), cB, voffB); PG8_STAGE(PG8_SA(0, 0), cA, voffA); PG8_STAGE(PG8_SB(0, 1), cB + hstep, voffB); PG8_STAGE(PG8_SA(0, 1), cA + hstepA, voffA);
    if (wr == 1) PG8_BAR;
    PG8_WAIT_V(4); PG8_BAR;
    PG8_STAGE(PG8_SB(1, 0), cB + kstep, voffB); PG8_STAGE(PG8_SA(1, 0), cA + kstepA, voffA); PG8_STAGE(PG8_SB(1, 1), cB + hstep + kstep, voffB);
    PG8_WAIT_V(6); PG8_BAR;
    for (;;) {
        const bool has_next = S.next(ui + 1, nxt);
        const char* nA = has_next ? (const char*)g.A + (size_t)nxt.pm * tstepA : cA; const char* nB = has_next ? (const char*)g.Bt + (size_t)nxt.pn * tstep : cB;
        for (int t = 0; t < nt; t += 2) {
            const bool last = (t == nt - 2);
            const char* a1 = cA + (size_t)(t + 1) * kstepA;
            const char* a2 = last ? nA : cA + (size_t)(t + 2) * kstepA; const char* b2 = last ? nB : cB + (size_t)(t + 2) * kstep;
            const char* a3 = a2 + kstepA; const char* b3 = b2 + kstep;
            if (last && has_next) S.a_ready(nxt);
            PG8_LDB(B0, 0, 0); PG8_SCHED; PG8_LDA(At, 0, 0); PG8_STAGE(PG8_SA(1, 1), a1 + hstepA, voffA);
            PG8_WAIT_L(8); PG8_BAR; PG8_WAIT_L(0); PG8_MMA(0, 0, At, B0); PG8_BAR; PG8_SCHED;
            PG8_LDB(B1, 0, 1); PG8_STAGE(PG8_SB(0, 0), b2, voffB);
            PG8_BAR; PG8_WAIT_L(0); PG8_MMA(0, 1, At, B1); PG8_BAR;
            PG8_LDA(At, 0, 1); PG8_STAGE(PG8_SA(0, 0), a2, voffA);
            PG8_BAR; PG8_WAIT_L(0); PG8_MMA(1, 0, At, B0); PG8_BAR; PG8_SCHED;
            PG8_STAGE(PG8_SB(0, 1), b2 + hstep, voffB);
            PG8_WAIT_V(6); PG8_BAR; PG8_MMA(1, 1, At, B1); PG8_BAR;
            PG8_LDB(B0, 1, 0); PG8_SCHED; PG8_LDA(At, 1, 0); PG8_STAGE(PG8_SA(0, 1), a2 + hstepA, voffA);
            PG8_WAIT_L(8); PG8_BAR; PG8_WAIT_L(0); PG8_MMA(0, 0, At, B0); PG8_BAR; PG8_SCHED;
            PG8_LDB(B1, 1, 1); PG8_STAGE(PG8_SB(1, 0), b3, voffB);
            PG8_BAR; PG8_WAIT_L(0); PG8_MMA(0, 1, At, B1); PG8_BAR;
            PG8_LDA(At, 1, 1); PG8_STAGE(PG8_SA(1, 0), a3, voffA);
            PG8_BAR; PG8_WAIT_L(0); PG8_MMA(1, 0, At, B0); PG8_BAR; PG8_SCHED;
            PG8_STAGE(PG8_SB(1, 1), b3 + hstep, voffB);
            PG8_WAIT_V(6); PG8_BAR; PG8_MMA(1, 1, At, B1); PG8_BAR;
        }
        E(acc, cur, wr, wc, fr, fq);
        if (!has_next) break;
#pragma unroll
        for (int a = 0; a < 2; ++a)
#pragma unroll
            for (int b = 0; b < 2; ++b)
#pragma unroll
                for (int m = 0; m < 4; ++m)
#pragma unroll
                    for (int n = 0; n < 2; ++n) acc[a][b][m][n] = (f32x4){0.f, 0.f, 0.f, 0.f};
        cur = nxt; cA = nA; cB = nB; ++ui;
    }
    PG8_WAIT_V(0);
    if (wr == 0) PG8_BAR;
    PG8_BAR;
#undef PG8_SA
#undef PG8_SB
#undef PG8_STAGE
#undef PG8_LDA
#undef PG8_LDB
#undef PG8_MMA
#undef PG8_WAIT_V
#undef PG8_WAIT_L
#undef PG8_BAR
#undef PG8_SCHED
}
}
using pg8::Unit;

struct EpiUZ {
    static constexpr bool PERM = true;
    bf16_t* P;
    __device__ __forceinline__ void operator()(const f32x4 (&acc)[2][2][4][2], const Unit& u, int wr, int wc, int fr_, int fq_) const {
        int fr = fr_, fq = fq_; asm volatile("" : "+v"(fr), "+v"(fq));
        const int row0 = u.pm * 256 + wr * 64 + fr;
        const int col = u.pn * 128 + wc * 32 + 8 * fq;
#pragma unroll
        for (int ai = 0; ai < 2; ++ai)
#pragma unroll
            for (int m = 0; m < 4; ++m) {
                const size_t row = (size_t)(row0 + ai * 128 + m * 16);
                float r[8];
#pragma unroll
                for (int n = 0; n < 2; ++n)
#pragma unroll
                    for (int i = 0; i < 4; ++i) {
                        const float uu = acc[ai][0][m][n][i], zz = acc[ai][1][m][n][i];
                        const float eu = __builtin_amdgcn_exp2f(-2.302208198f * (uu * (1.0f + 0.044715f * uu * uu)));
                        const float ez = __builtin_amdgcn_exp2f(-1.4426950408889634f * zz);
                        r[4 * n + i] = (uu * zz) * __builtin_amdgcn_rcpf((1.0f + eu) * (1.0f + ez));
                    }
                *(u32x4*)(P + ((size_t)(col >> 6) * T + row) * 64 + (col & 63)) = pack8f(r);
            }
    }
};
struct EpiGVT {
    static constexpr bool PERM = true;
    bf16_t* GVT; float* stats;
    __device__ __forceinline__ void operator()(const f32x4 (&acc)[2][2][4][2], const Unit& u, int wr, int wc, int fr_, int fq_) const {
        int fr = fr_, fq = fq_; asm volatile("" : "+v"(fr), "+v"(fq));
        const int row0 = u.pm * 256 + wr * 64 + fr;
        const int tok0 = u.pn * 256 + wc * 32 + 8 * fq;
        float s[16], ss[16];
#pragma unroll
        for (int j = 0; j < 16; ++j) { s[j] = 0.f; ss[j] = 0.f; }
#pragma unroll
        for (int ai = 0; ai < 2; ++ai)
#pragma unroll
            for (int m = 0; m < 4; ++m) {
                const size_t row = (size_t)(row0 + ai * 128 + m * 16);
#pragma unroll
                for (int bj = 0; bj < 2; ++bj) {
                    float r[8];
#pragma unroll
                    for (int n = 0; n < 2; ++n)
#pragma unroll
                        for (int i = 0; i < 4; ++i) r[4 * n + i] = gelu_f(acc[ai][bj][m][n][i]);
                    const u32x4 o = pack8f(r);
#pragma unroll
                    for (int q = 0; q < 4; ++q) { const float a = bflo(o[q]), b = bfhi(o[q]); s[bj * 8 + 2 * q] += a; ss[bj * 8 + 2 * q] += a * a; s[bj * 8 + 2 * q + 1] += b; ss[bj * 8 + 2 * q + 1] += b * b; }
                    *(u32x4*)(GVT + row * T + tok0 + bj * 128) = o;
                }
            }
#pragma unroll
        for (int step = 0; step < 4; ++step) {
            const int msk = 8 >> step, cnt = 8 >> step;
            const bool up = (fr & msk) != 0;
#pragma unroll
            for (int j = 0; j < 8; ++j) {
                if (j < cnt) {
                    const float send_s = up ? s[j] : s[j + cnt], keep_s = up ? s[j + cnt] : s[j];
                    const float send_q = up ? ss[j] : ss[j + cnt], keep_q = up ? ss[j + cnt] : ss[j];
                    s[j] = keep_s + __shfl_xor(send_s, msk);
                    ss[j] = keep_q + __shfl_xor(send_q, msk);
                }
            }
        }
        {
            const int j = fr;
            const size_t tok = (size_t)(tok0 + 128 * (j >> 3) + (j & 7));
            f32x2 st = {s[0], ss[0]};
            *(f32x2*)(stats + (tok * 32 + u.pm * 2 + wr) * 2) = st;
        }
    }
};
struct EpiRes {
    static constexpr bool PERM = false;
    const float* xin; float* xout; const float* gate;
    int ldg;
    __device__ __forceinline__ void operator()(const f32x4 (&acc)[2][2][4][2], const Unit& u, int wr, int wc, int fr_, int fq_) const {
        int fr = fr_, fq = fq_; asm volatile("" : "+v"(fr), "+v"(fq));
        const int row0 = u.pm * 256 + wr * 64 + fr, col0 = u.pn * 256 + wc * 32 + 4 * fq;
        const float* gp = gate + (size_t)(u.pm >> 5) * ldg + col0;
        f32x4 gv[2][2];
#pragma unroll
        for (int bj = 0; bj < 2; ++bj)
#pragma unroll
            for (int n = 0; n < 2; ++n) gv[bj][n] = *(const f32x4*)(gp + bj * 128 + n * 16);
#pragma unroll
        for (int ai = 0; ai < 2; ++ai)
#pragma unroll
            for (int m = 0; m < 4; ++m) {
                const size_t off = (size_t)(row0 + ai * 128 + m * 16) * DM + col0;
#pragma unroll
                for (int bj = 0; bj < 2; ++bj)
#pragma unroll
                    for (int n = 0; n < 2; ++n) {
                        const f32x4 xo = *(const f32x4*)(xin + off + bj * 128 + n * 16);
                        *(f32x4*)(xout + off + bj * 128 + n * 16) = xo + gv[bj][n] * acc[ai][bj][m][n];
                    }
            }
    }
};
template <int MODE> struct EpiLat {
    static constexpr bool PERM = true;
    bf16_t* C; float* ssq; float* kr; bf16_t* Z;
    __device__ __forceinline__ void operator()(const f32x4 (&acc)[2][2][4][2], const Unit& u, int wr, int wc, int fr_, int fq_) const {
        int fr = fr_, fq = fq_; asm volatile("" : "+v"(fr), "+v"(fq));
        const int row0 = u.pm * 256 + wr * 64 + fr;
        if (u.pn < 2) {
#pragma unroll
            for (int ai = 0; ai < 2; ++ai)
#pragma unroll
                for (int m = 0; m < 4; ++m) {
                    const size_t row = (size_t)(row0 + ai * 128 + m * 16);
                    float ss = 0.f;
#pragma unroll
                    for (int bj = 0; bj < 2; ++bj) {
                        const int col = u.pn * 256 + bj * 128 + wc * 32 + 8 * fq;
                        float r[8];
#pragma unroll
                        for (int n = 0; n < 2; ++n)
#pragma unroll
                            for (int i = 0; i < 4; ++i) { r[4 * n + i] = acc[ai][bj][m][n][i]; ss += r[4 * n + i] * r[4 * n + i]; }
                        *(u32x4*)(C + row * 512 + col) = pack8f(r);
                    }
                    ss += __shfl_xor(ss, 16); ss += __shfl_xor(ss, 32);
                    if (fq == 0) ssq[row * 8 + u.pn * 4 + wc] = ss;
                }
        } else if (MODE == 0) {
            if (u.pn == 2 && wc < 2) {
#pragma unroll
                for (int ai = 0; ai < 2; ++ai)
#pragma unroll
                    for (int m = 0; m < 4; ++m) {
                        const size_t row = (size_t)(row0 + ai * 128 + m * 16);
                        *(f32x4*)(kr + row * 64 + wc * 32 + 8 * fq) = acc[ai][0][m][0];
                        *(f32x4*)(kr + row * 64 + wc * 32 + 8 * fq + 4) = acc[ai][0][m][1];
                    }
            }
        } else {
#pragma unroll
            for (int ai = 0; ai < 2; ++ai)
#pragma unroll
                for (int m = 0; m < 4; ++m) {
                    const size_t row = (size_t)(row0 + ai * 128 + m * 16);
#pragma unroll
                    for (int bj = 0; bj < 2; ++bj) {
                        const int col = (u.pn - 2) * 256 + bj * 128 + wc * 32 + 8 * fq;
                        float r[8];
#pragma unroll
                        for (int n = 0; n < 2; ++n)
#pragma unroll
                            for (int i = 0; i < 4; ++i) r[4 * n + i] = silu_f(acc[ai][bj][m][n][i]);
                        *(u32x4*)(Z + row * 2048 + col) = pack8f(r);
                    }
                }
        }
    }
};
struct EpiScaled {
    static constexpr bool PERM = true;
    bf16_t* O; int ldc; const float* ssq;
    __device__ __forceinline__ void operator()(const f32x4 (&acc)[2][2][4][2], const Unit& u, int wr, int wc, int fr_, int fq_) const {
        int fr = fr_, fq = fq_; asm volatile("" : "+v"(fr), "+v"(fq));
        const int row0 = u.pm * 256 + wr * 64 + fr;
#pragma unroll
        for (int ai = 0; ai < 2; ++ai)
#pragma unroll
            for (int m = 0; m < 4; ++m) {
                const size_t row = (size_t)(row0 + ai * 128 + m * 16);
                const f32x4 a = *(const f32x4*)(ssq + row * 8), b = *(const f32x4*)(ssq + row * 8 + 4);
                const float rs = rsqrtf(((a[0] + a[1] + a[2] + a[3] + b[0] + b[1] + b[2] + b[3]) + EPS * 512.0f) * (1.0f / 512.0f));
#pragma unroll
                for (int bj = 0; bj < 2; ++bj) {
                    const int col = u.pn * 256 + bj * 128 + wc * 32 + 8 * fq;
                    float r[8];
#pragma unroll
                    for (int n = 0; n < 2; ++n)
#pragma unroll
                        for (int i = 0; i < 4; ++i) r[4 * n + i] = acc[ai][bj][m][n][i] * rs;
                    *(u32x4*)(O + row * ldc + col) = pack8f(r);
                }
            }
    }
};
struct EpiVT {
    static constexpr bool PERM = false;
    bf16_t* VT; const float* ssq;
    __device__ __forceinline__ void operator()(const f32x4 (&acc)[2][2][4][2], const Unit& u, int wr, int wc, int fr_, int fq_) const {
        int fr = fr_, fq = fq_; asm volatile("" : "+v"(fr), "+v"(fq));
        const int row0 = u.pm * 256 + wr * 64 + fr;
        const int pg = ((fq & 1) << 1) | (fq >> 1);
#pragma unroll
        for (int bj = 0; bj < 2; ++bj)
#pragma unroll
            for (int n = 0; n < 2; ++n) {
                const int tb = u.pn * 256 + bj * 128 + wc * 32 + 16 * n;
                const int tok0 = tb + 4 * fq;
                f32x4 rs;
#pragma unroll
                for (int i = 0; i < 4; ++i) {
                    const f32x4 a = *(const f32x4*)(ssq + (size_t)(tok0 + i) * 8), b = *(const f32x4*)(ssq + (size_t)(tok0 + i) * 8 + 4);
                    rs[i] = rsqrtf(((a[0] + a[1] + a[2] + a[3] + b[0] + b[1] + b[2] + b[3]) + EPS * 512.0f) * (1.0f / 512.0f));
                }
                const int pos0 = tb + 4 * pg;
#pragma unroll
                for (int ai = 0; ai < 2; ++ai)
#pragma unroll
                    for (int m = 0; m < 4; ++m) {
                        const size_t row = (size_t)(row0 + ai * 128 + m * 16);
                        const f32x4 v = acc[ai][bj][m][n] * rs;
                        u32x2 o = {cvt_pk_bf16(v[0], v[1]), cvt_pk_bf16(v[2], v[3])};
                        *(u32x2*)(VT + row * T + pos0) = o;
                    }
            }
    }
};

template <class Epi> __device__ __forceinline__ void run_gemm(const int TID, const int BID, LAS unsigned char* lds, const bf16_t* A, const bf16_t* Bt, int M, int N, int K, const Epi& E, const bool a_blocked = false) {
    pg8::Gemm g{A, Bt, M, N, K, a_blocked ? 64 : K, a_blocked ? (size_t)M * 128 : (size_t)128}; pg8::StaticOrder S; S.init(M, N, (int)gridDim.x, (int)BID, 4);
    int tid_ = TID; asm volatile("" : "+v"(tid_));
    pg8::gemm_phase<Epi, pg8::StaticOrder>(tid_, lds, g, S, E);
}

struct Params {
    const float* in[25];
    float* out;
    unsigned char* ws;
    int ph_lo, ph_hi;
};
enum { I_X = 0, I_C, I_ADA_W, I_ADA_B, I_NORM_G, I_A_W_IN, I_A_LN_G, I_A_LN_B, I_A_W_S, I_A_B_S, I_A_W_OUT, I_KV_ADA_W, I_KV_ADA_B, I_KV_NORM_G, I_KV_W_DKV, I_KV_G_KVA,
       I_KV_W_UKV, I_KV_G_KN, I_KV_G_KR, I_B_W_IN, I_B_G_QA, I_B_W_UQ, I_B_G_QN, I_B_G_QR, I_B_W_OUT };

__device__ __forceinline__ void conv_tile(const int TID, unsigned char* shm, const float* src, int ldsrc, int srccol0, int K, int k0, bf16_t* dst, int n0, const float* scale) {
    float* tile = (float*)shm;
    const int tid = TID;
    {
        const int kk = tid >> 4, c4 = tid & 15;
        f32x4 v[8];
#pragma unroll
        for (int i = 0; i < 8; ++i) {
            v[i] = (f32x4){0.f, 0.f, 0.f, 0.f};
            if (srccol0 >= 0) v[i] = *(const f32x4*)(src + (size_t)(k0 + kk + 32 * i) * ldsrc + srccol0 + 4 * c4);
        }
#pragma unroll
        for (int i = 0; i < 8; ++i) { float* tp = tile + (kk + 32 * i) * 65 + 4 * c4; tp[0] = v[i][0]; tp[1] = v[i][1]; tp[2] = v[i][2]; tp[3] = v[i][3]; }
    }
    __syncthreads();
    {
        const int n = tid >> 3, k8 = tid & 7;
#pragma unroll
        for (int jb = 0; jb < 4; ++jb) {
            float r[8];
#pragma unroll
            for (int j = 0; j < 8; ++j) { r[j] = tile[(64 * jb + 8 * k8 + j) * 65 + n]; if (scale) r[j] *= scale[k0 + 64 * jb + 8 * k8 + j]; }
            *(u32x4*)(dst + (size_t)(n0 + n) * K + k0 + 64 * jb + 8 * k8) = pack8f(r);
        }
    }
    __syncthreads();
}

__device__ __forceinline__ void phase_prep(const int TID, const int BID, const Params& p, unsigned char* ws, unsigned char* shm) {
    const int tid = TID;
    {
        float* cosT = (float*)(ws + WS_COS); float* sinT = (float*)(ws + WS_SIN);
        for (int idx = BID * 512 + tid; idx < SEQ * 32; idx += gridDim.x * 512) {
            const int pos = idx >> 5, i = idx & 31;
            double f = 1.0; for (int q = 0; q < i; ++q) f *= 0.7498942093324559;
            const float invf = (float)f;
            const float ang = (float)pos * invf;
            const double ad = (double)ang;
            const double n = rint(ad * 0.15915494309189535);
            const double r = ad - n * 6.283185307179586;
            const double r2 = r * r;
            double s = 1.0, c = 1.0;
#pragma unroll 1
            for (int k = 14; k >= 1; --k) { s = 1.0 - s * r2 / (double)((2 * k) * (2 * k + 1)); c = 1.0 - c * r2 / (double)((2 * k - 1) * (2 * k)); }
            cosT[idx] = (float)c; sinT[idx] = (float)(r * s);
        }
    }
    if (BID < 224) {
        float* sc = (float*)shm;
        float* red = (float*)(shm + 32768);
        const float* cin = p.in[I_C];
        for (int i = tid; i < 4 * 2048; i += 512) sc[i] = silu_f(cin[i]);
        __syncthreads();
        const int item = BID;
        const float* W; const float* bias; float* out; int ldw, cb;
        if (item < 192) { const int l = item / 48; cb = item % 48; W = p.in[I_ADA_W] + (size_t)l * 2048 * 6144; ldw = 6144; bias = p.in[I_ADA_B] + l * 6144; out = (float*)(ws + WS_MOD) + (size_t)l * 4 * 6144; }
        else { cb = item - 192; W = p.in[I_KV_ADA_W]; ldw = 4096; bias = p.in[I_KV_ADA_B]; out = (float*)(ws + WS_KVMOD); }
        const int cgp = tid & 31, kg = tid >> 5;
        const float* wp = W + (size_t)(kg * 128) * ldw + cb * 128 + cgp * 4;
        f32x4 a0 = {0.f, 0.f, 0.f, 0.f}, a1 = a0, a2 = a0, a3 = a0;
#pragma unroll 8
        for (int k = 0; k < 128; ++k) {
            const f32x4 w = *(const f32x4*)(wp + (size_t)k * ldw);
            const int kk = kg * 128 + k;
            a0 += w * sc[kk]; a1 += w * sc[2048 + kk]; a2 += w * sc[4096 + kk]; a3 += w * sc[6144 + kk];
        }
        float* rp = red + ((size_t)kg * 128 + cgp * 4) * 4;
#pragma unroll
        for (int e = 0; e < 4; ++e) { rp[e * 4 + 0] = a0[e]; rp[e * 4 + 1] = a1[e]; rp[e * 4 + 2] = a2[e]; rp[e * 4 + 3] = a3[e]; }
        __syncthreads();
        {
            const int col = tid >> 2, b = tid & 3;
            float s = 0.f;
#pragma unroll
            for (int g = 0; g < 16; ++g) s += red[((size_t)g * 128 + col) * 4 + b];
            out[(size_t)b * ldw + cb * 128 + col] = s + bias[cb * 128 + col];
        }
        __syncthreads();
    }
    {
        const float* wsrc = p.in[I_A_W_S]; bf16_t* wdst = (bf16_t*)(ws + WS_WS16);
        for (int idx = BID * 512 + TID; idx < 2 * 16 * 128 * 128 / 4; idx += gridDim.x * 512) {
            const int e = idx * 4, s4 = e & 127, t = (e >> 7) & 127;
            f32x4 w = *(const f32x4*)(wsrc + e);
#pragma unroll
            for (int q = 0; q < 4; ++q) if (s4 + q > t) w[q] = 0.f;
            u32x2 o = {cvt_pk_bf16(w[0], w[1]), cvt_pk_bf16(w[2], w[3])};
            *(u32x2*)(wdst + e) = o;
        }
    }
    {
        constexpr int NJ = 13;
        const int ntile[NJ] = {1536, 1536, 512, 512, 96, 64, 64, 320, 320, 96, 96, 256, 256};
        int total = 0;
#pragma unroll
        for (int j = 0; j < NJ; ++j) total += ntile[j];
        for (int tix = BID; tix < total; tix += gridDim.x) {
            int j = 0, rem = tix;
#pragma unroll
            for (int q = 0; q < NJ; ++q) { if (j == q && rem >= ntile[q]) { rem -= ntile[q]; j = q + 1; } }
            const float* src; int ldsrc, K; bf16_t* dst; const float* scale = nullptr; int srccol0, n0, k0;
            if (j < 2) {
                K = 2048; ldsrc = 12288; src = p.in[I_A_W_IN] + (size_t)j * 2048 * 12288; dst = (bf16_t*)(ws + WS_WINA) + (size_t)j * 12288 * 2048;
                const int nt_ = rem / 8; k0 = (rem % 8) * 256; n0 = nt_ * 64;
                const int pn = n0 >> 8, jj = n0 & 255;
                srccol0 = pn < 32 ? (jj < 128 ? 128 * pn + jj : 8192 + 128 * pn + (jj - 128)) : 4096 + 256 * (pn - 32) + jj;
            } else if (j < 4) {
                const int l = j - 2; K = 4096; ldsrc = 2048; src = p.in[I_A_W_OUT] + (size_t)l * 4096 * 2048; dst = (bf16_t*)(ws + WS_WOUTA) + (size_t)l * 2048 * 4096;
                const int nt_ = rem / 16; k0 = (rem % 16) * 256; n0 = nt_ * 64; srccol0 = n0;
            } else if (j == 4) {
                K = 2048; ldsrc = 576; src = p.in[I_KV_W_DKV]; dst = (bf16_t*)(ws + WS_WDKV);
                const int nt_ = rem / 8; k0 = (rem % 8) * 256; n0 = nt_ * 64; srccol0 = n0 < 576 ? n0 : -1;
            } else if (j < 7) {
                K = 512; ldsrc = 4096; src = p.in[I_KV_W_UKV]; dst = (bf16_t*)(ws + (j == 5 ? WS_WKN : WS_WV)); scale = p.in[I_KV_G_KVA];
                const int nt_ = rem / 2; k0 = (rem % 2) * 256; n0 = nt_ * 64;
                srccol0 = (n0 >> 7) * 256 + (j == 6 ? 128 : 0) + (n0 & 127);
            } else if (j < 9) {
                const int l = j - 7; K = 2048; ldsrc = 2560; src = p.in[I_B_W_IN] + (size_t)l * 2048 * 2560; dst = (bf16_t*)(ws + WS_WINB) + (size_t)l * 2560 * 2048;
                const int nt_ = rem / 8; k0 = (rem % 8) * 256; n0 = nt_ * 64; srccol0 = n0;
            } else if (j < 11) {
                const int l = j - 9; K = 512; ldsrc = 3072; src = p.in[I_B_W_UQ] + (size_t)l * 512 * 3072; dst = (bf16_t*)(ws + WS_WUQ) + (size_t)l * 3072 * 512; scale = p.in[I_B_G_QA] + l * 512;
                const int nt_ = rem / 2; k0 = (rem % 2) * 256; n0 = nt_ * 64; srccol0 = n0;
            } else {
                const int l = j - 11; K = 2048; ldsrc = 2048; src = p.in[I_B_W_OUT] + (size_t)l * 2048 * 2048; dst = (bf16_t*)(ws + WS_WOUTB) + (size_t)l * 2048 * 2048;
                const int nt_ = rem / 8; k0 = (rem % 8) * 256; n0 = nt_ * 64; srccol0 = n0;
            }
            conv_tile(TID, shm, src, ldsrc, srccol0, K, k0, dst, n0, scale);
        }
    }
}

__device__ __forceinline__ void phase_norm(const int TID, const int BID, const float* x, const float* g1, const float* sh1, const float* sc1, int ld1, bf16_t* h1,
                           const float* g2, const float* sh2, const float* sc2, int ld2, bf16_t* h2) {
    const int lane = TID & 63, wid = TID >> 6;
    for (int row = BID * 8 + wid; row < T; row += gridDim.x * 8) {
        const int b = row >> 13;
        const f32x4* xr = (const f32x4*)(x + (size_t)row * DM);
        f32x4 v[8]; float ss = 0.f;
#pragma unroll
        for (int i = 0; i < 8; ++i) { v[i] = xr[lane + 64 * i]; ss += v[i][0] * v[i][0] + v[i][1] * v[i][1] + v[i][2] * v[i][2] + v[i][3] * v[i][3]; }
#pragma unroll
        for (int o = 32; o >= 1; o >>= 1) ss += __shfl_xor(ss, o);
        const float rs = rsqrtf((ss + EPS * 2048.0f) * (1.0f / 2048.0f));
#pragma unroll
        for (int i = 0; i < 8; ++i) {
            const int k = 4 * (lane + 64 * i);
            const f32x4 gg = *(const f32x4*)(g1 + k), sc = *(const f32x4*)(sc1 + (size_t)b * ld1 + k), sh = *(const f32x4*)(sh1 + (size_t)b * ld1 + k);
            const f32x4 o = (v[i] * rs) * gg * (sc + 1.0f) + sh;
            u32x2 w = {cvt_pk_bf16(o[0], o[1]), cvt_pk_bf16(o[2], o[3])};
            *(u32x2*)(h1 + (size_t)row * DM + k) = w;
        }
        if (h2) {
#pragma unroll
            for (int i = 0; i < 8; ++i) {
                const int k = 4 * (lane + 64 * i);
                const f32x4 gg = *(const f32x4*)(g2 + k), sc = *(const f32x4*)(sc2 + (size_t)b * ld2 + k), sh = *(const f32x4*)(sh2 + (size_t)b * ld2 + k);
                const f32x4 o = (v[i] * rs) * gg * (sc + 1.0f) + sh;
                u32x2 w = {cvt_pk_bf16(o[0], o[1]), cvt_pk_bf16(o[2], o[3])};
                *(u32x2*)(h2 + (size_t)row * DM + k) = w;
            }
        }
    }
}

__device__ __forceinline__ void phase_mix(const int TID, const int BID, unsigned char* shm, bf16_t* P, const bf16_t* GVT, const float* stats, const bf16_t* ws16, const float* b_s, const float* ln_g, const float* ln_b, const bool ident) {
    constexpr int LD = 136;
    bf16_t* VTl = (bf16_t*)shm;
    bf16_t* WsL = (bf16_t*)(shm + 256 * LD * 2);
    float* st = (float*)(shm + 256 * LD * 2 + 128 * LD * 2);
    const int tid = TID, lane = tid & 63, wid = tid >> 6, l15 = lane & 15, l4 = lane >> 4;
    for (int chunk = BID; chunk < T / 128; chunk += gridDim.x) {
        const int t0 = chunk * 128;
        __syncthreads();
        if (tid < 128) {
            const f32x4* sp = (const f32x4*)(stats + (size_t)(t0 + tid) * 64);
            float s = 0.f, ss = 0.f;
#pragma unroll
            for (int i = 0; i < 16; ++i) { const f32x4 v = sp[i]; s += v[0] + v[2]; ss += v[1] + v[3]; }
            const float mean = s * (1.0f / 4096.0f);
            const float var = ss * (1.0f / 4096.0f) - mean * mean;
            st[2 * tid] = mean; st[2 * tid + 1] = rsqrtf(fmaxf(var, 0.f) + EPS);
        }
        __syncthreads();
        for (int g = 0; g < 16; ++g) {
#pragma unroll
            for (int i = 0; i < 4; ++i) {
                const int id = tid + 512 * i, t = id >> 4, s8 = (id & 15) * 8;
                *(u32x4*)(WsL + t * LD + s8) = *(const u32x4*)(ws16 + ((size_t)g * 128 + t) * 128 + s8);
            }
#pragma unroll
            for (int i = 0; i < 8; ++i) {
                const int id = tid + 512 * i, c = id >> 4, s8 = (id & 15) * 8;
                const u32x4 raw = *(const u32x4*)(GVT + (size_t)(g * 256 + c) * T + t0 + s8);
                const float gg = ln_g[g * 256 + c], bb = ln_b[g * 256 + c];
                float r[8];
#pragma unroll
                for (int q = 0; q < 4; ++q) { r[2 * q] = bflo(raw[q]); r[2 * q + 1] = bfhi(raw[q]); }
#pragma unroll
                for (int q = 0; q < 4; ++q) {
                    const f32x4 mr = *(const f32x4*)(st + 2 * (s8 + 2 * q));
                    r[2 * q] = (r[2 * q] - mr[0]) * mr[1] * gg + bb;
                    r[2 * q + 1] = (r[2 * q + 1] - mr[2]) * mr[3] * gg + bb;
                }
                *(u32x4*)(VTl + c * LD + s8) = pack8f(r);
            }
            __syncthreads();
            f32x4 acc[2][8];
#pragma unroll
            for (int cb = 0; cb < 2; ++cb)
#pragma unroll
                for (int tb = 0; tb < 8; ++tb) acc[cb][tb] = (f32x4){0.f, 0.f, 0.f, 0.f};
#pragma unroll
            for (int ks = 0; ks < 4; ++ks) {
                bf16x8 vf[2];
#pragma unroll
                for (int cb = 0; cb < 2; ++cb) vf[cb] = *(const bf16x8*)(VTl + (wid * 32 + cb * 16 + l15) * LD + ks * 32 + l4 * 8);
#pragma unroll
                for (int tb = 0; tb < 8; ++tb) {
                    if (tb >= 2 * ks) {
                        const bf16x8 wf = *(const bf16x8*)(WsL + (tb * 16 + l15) * LD + ks * 32 + l4 * 8);
#pragma unroll
                        for (int cb = 0; cb < 2; ++cb) acc[cb][tb] = __builtin_amdgcn_mfma_f32_16x16x32_bf16(vf[cb], wf, acc[cb][tb], 0, 0, 0);
                    }
                }
            }
            __syncthreads();
            {
                bf16_t* OutL = (bf16_t*)shm;
#pragma unroll
                for (int tb = 0; tb < 8; ++tb) {
                    const int t = tb * 16 + l15;
                    const float bs = b_s[g * 128 + t];
#pragma unroll
                    for (int cb = 0; cb < 2; ++cb) {
                        const f32x4 a = acc[cb][tb];
                        u32x2 o = {cvt_pk_bf16(a[0] + bs, a[1] + bs), cvt_pk_bf16(a[2] + bs, a[3] + bs)};
                        *(u32x2*)(OutL + t * 264 + wid * 32 + cb * 16 + l4 * 4) = o;
                    }
                }
                __syncthreads();
#pragma unroll
                for (int i = 0; i < 8; ++i) {
                    const int id = tid + 512 * i, blk = id >> 10, t = (id >> 3) & 127, c8 = (id & 7) * 8;
                    bf16_t* pp = P + ((size_t)(g * 4 + blk) * T + t0 + t) * 64 + c8;
                    const u32x4 pv = *(const u32x4*)pp;
                    const u32x4 mv = *(const u32x4*)(OutL + t * 264 + blk * 64 + c8);
                    u32x4 o;
#pragma unroll
                    for (int q = 0; q < 4; ++q) o[q] = ident ? (pv[q] | (mv[q] & 0u)) : cvt_pk_bf16(bflo(pv[q]) * bflo(mv[q]), bfhi(pv[q]) * bfhi(mv[q]));
                    *(u32x4*)pp = o;
                }
            }
            __syncthreads();
        }
    }
}

__device__ __forceinline__ void phase_kpost(const int TID, const int BID, bf16_t* KN, const float* KRAW, bf16_t* KROPE, const float* g_kn, const float* g_kr, const float* cosT, const float* sinT, const bool ident) {
    const int lane = TID & 63, wid = TID >> 6;
    const int gw = BID * 8 + wid, nw = gridDim.x * 8;
    {
        const int sub = lane >> 4, l16 = lane & 15;
        const f32x4 ga = *(const f32x4*)(g_kn + l16 * 8), gb = *(const f32x4*)(g_kn + l16 * 8 + 4);
        const size_t nrows = (size_t)T * 16;
        for (size_t r0 = (size_t)gw * 4 + sub; r0 < nrows; r0 += (size_t)nw * 16) {
            u32x4 raw[4];
#pragma unroll
            for (int u = 0; u < 4; ++u) { const size_t r = r0 + (size_t)u * nw * 4; if (r < nrows) raw[u] = *(const u32x4*)(KN + r * 128 + l16 * 8); }
#pragma unroll
            for (int u = 0; u < 4; ++u) {
                const size_t r = r0 + (size_t)u * nw * 4;
                float v[8]; float ss = 0.f;
#pragma unroll
                for (int q = 0; q < 4; ++q) { v[2 * q] = bflo(raw[u][q]); v[2 * q + 1] = bfhi(raw[u][q]); ss += v[2 * q] * v[2 * q] + v[2 * q + 1] * v[2 * q + 1]; }
                ss += __shfl_xor(ss, 1); ss += __shfl_xor(ss, 2); ss += __shfl_xor(ss, 4); ss += __shfl_xor(ss, 8);
                const float rs = rsqrtf((ss + EPS * 128.0f) * (1.0f / 128.0f));
#pragma unroll
                for (int e = 0; e < 8; ++e) v[e] = v[e] * rs * (e < 4 ? ga[e & 3] : gb[e & 3]);
                if (r < nrows) *(u32x4*)(KN + r * 128 + l16 * 8) = ident ? raw[u] : pack8f(v);
            }
        }
    }
    {
        const float gk = g_kr[lane];
        for (int t0 = gw; t0 < T; t0 += nw * 4) {
            float xs[4];
#pragma unroll
            for (int u = 0; u < 4; ++u) { const int t = t0 + u * nw; xs[u] = t < T ? KRAW[(size_t)t * 64 + lane] : 0.f; }
#pragma unroll
            for (int u = 0; u < 4; ++u) {
                const int t = t0 + u * nw;
                const float x = xs[u];
                float ss = x * x;
#pragma unroll
                for (int o = 32; o >= 1; o >>= 1) ss += __shfl_xor(ss, o);
                const float y = x * rsqrtf((ss + EPS * 64.0f) * (1.0f / 64.0f)) * gk;
                const float other = __shfl_xor(y, 32);
                const int pos = t & (SEQ - 1), i = lane & 31;
                if (t < T) {
                    const float c = cosT[pos * 32 + i], s = sinT[pos * 32 + i];
                    const float o = lane < 32 ? (y * c - other * s) : (y * c + other * s);
                    KROPE[(size_t)t * 64 + lane] = (bf16_t)(cvt_pk_bf16(o, 0.f) & 0xffffu);
                }
            }
        }
    }
}

__device__ __forceinline__ void phase_attn(const int TID, const int BID, unsigned char* shm, const bf16_t* Q, const bf16_t* KN, const bf16_t* KR, const bf16_t* VT, const bf16_t* Zs, bf16_t* Y,
                                           const float* g_qn, const float* g_qr, const float* cosT, const float* sinT) {
    constexpr int KBYTES = 64 * 384, VBYTES = 128 * 128, VBASE = 3 * KBYTES;
    const int tid = TID, wid = __builtin_amdgcn_readfirstlane(tid >> 6), lane = tid & 63, lq = lane & 31, hi = lane >> 5;
    unsigned ksrc[3]; bool krope[3]; unsigned vsrc[2];
#pragma unroll
    for (int i = 0; i < 3; ++i) {
        const int p = (wid * 3 + i) * 64 + lane, r = p / 24, cs = p - r * 24;
        const int c = (cs & ~7) | ((cs & 7) ^ ((r >> 1) & 7));
        krope[i] = c >= 16;
        ksrc[i] = krope[i] ? (unsigned)(r * 64 + (c - 16) * 8) : (unsigned)(r * 2048 + c * 8);
    }
#pragma unroll
    for (int i = 0; i < 2; ++i) {
        const int p = (wid * 2 + i) * 64 + lane, r = p >> 3, cs = p & 7;
        const int c = cs ^ ((r >> 1) & 7);
        vsrc[i] = (unsigned)r * T + c * 8;
    }
    int kfr[4], vfr[4];
    {
        const int x = (lq >> 1) & 7;
#pragma unroll
        for (int j = 0; j < 4; ++j) { kfr[j] = lq * 384 + 16 * ((2 * j + hi) ^ x); vfr[j] = lq * 128 + 16 * ((2 * j + hi) ^ x); }
    }
    LAS unsigned char* ldsb = (LAS unsigned char*)shm;
    for (int item = BID; item < 1024; item += gridDim.x) {
        const int bh = item >> 4, pr = item & 15, b = bh >> 4, h = bh & 15;
        const int tokb = b * SEQ;
        for (int half = 0; half < 2; ++half) {
            const int qb = half == 0 ? (31 - pr) : pr;
            const int q0 = qb * 256, nt = 4 * (qb + 1);
            int lqo = lq, hio = hi; asm volatile("" : "+v"(lqo), "+v"(hio));
            const int qrow = q0 + wid * 32 + lq;
            const int qrow_o = q0 + wid * 32 + lqo;
            bf16x8 qf[12];
            {
                const bf16_t* qp = Q + (size_t)(tokb + qrow_o) * 3072 + h * 192 + hio * 8;
#pragma unroll
                for (int ks = 0; ks < 12; ++ks) qf[ks] = *(const bf16x8*)(qp + ks * 16);
                float ssn = 0.f, ssr = 0.f;
#pragma unroll
                for (int ks = 0; ks < 12; ++ks)
#pragma unroll
                    for (int j = 0; j < 8; ++j) { const float v = bf2f((unsigned short)qf[ks][j]); if (ks < 8) ssn += v * v; else ssr += v * v; }
                ssn = x32_sum(ssn); ssr = x32_sum(ssr);
                const float rn = rsqrtf((ssn + EPS * 128.0f) * (1.0f / 128.0f)) * QSCALE;
                const float rr = rsqrtf((ssr + EPS * 64.0f) * (1.0f / 64.0f));
#pragma unroll
                for (int ks = 0; ks < 8; ++ks) {
                    const f32x4 ga = *(const f32x4*)(g_qn + ks * 16 + hio * 8), gb = *(const f32x4*)(g_qn + ks * 16 + hio * 8 + 4);
                    float r[8];
#pragma unroll
                    for (int j = 0; j < 8; ++j) r[j] = bf2f((unsigned short)qf[ks][j]) * rn * (j < 4 ? ga[j & 3] : gb[j & 3]);
                    const u32x4 o = pack8f(r);
                    qf[ks] = *(const bf16x8*)&o;
                }
#pragma unroll
                for (int kk = 0; kk < 2; ++kk) {
                    const int i0 = 16 * kk + 8 * hio;
                    float r1[8], r2[8];
#pragma unroll
                    for (int j = 0; j < 8; ++j) {
                        const float x1 = bf2f((unsigned short)qf[8 + kk][j]) * rr * g_qr[i0 + j];
                        const float x2 = bf2f((unsigned short)qf[10 + kk][j]) * rr * g_qr[32 + i0 + j];
                        const float c = cosT[qrow_o * 32 + i0 + j], s = sinT[qrow_o * 32 + i0 + j];
                        r1[j] = (x1 * c - x2 * s) * QSCALE; r2[j] = (x2 * c + x1 * s) * QSCALE;
                    }
                    const u32x4 o1 = pack8f(r1), o2 = pack8f(r2);
                    qf[8 + kk] = *(const bf16x8*)&o1; qf[10 + kk] = *(const bf16x8*)&o2;
                }
            }
            f32x16 O[4];
#pragma unroll
            for (int d = 0; d < 4; ++d)
#pragma unroll
                for (int r = 0; r < 16; ++r) O[d][r] = 0.f;
            float m_run = 0.f, l_run = 0.f; bool mz = true;
#define ATT_DMA(t_, buf_) do { const size_t tok0 = (size_t)tokb + (size_t)(t_) * 64; \
                const bf16_t* knb = uniform_ptr(KN + tok0 * 2048 + h * 128); const bf16_t* krb = uniform_ptr(KR + tok0 * 64); const bf16_t* vtb = uniform_ptr(VT + (size_t)(h * 128) * T + tok0); \
                _Pragma("unroll") for (int i_ = 0; i_ < 3; ++i_) { const bf16_t* g_ = (krope[i_] ? krb : knb) + ksrc[i_]; \
                    __builtin_amdgcn_global_load_lds((const unsigned*)g_, (LAS unsigned*)(ldsb + (buf_) * KBYTES + (wid * 3 + i_) * 1024), 16, 0, 0); } \
                _Pragma("unroll") for (int i_ = 0; i_ < 2; ++i_) { const bf16_t* g_ = vtb + vsrc[i_]; \
                    __builtin_amdgcn_global_load_lds((const unsigned*)g_, (LAS unsigned*)(ldsb + VBASE + (buf_) * VBYTES + (wid * 2 + i_) * 1024), 16, 0, 0); } } while (0)
#define SB_() __builtin_amdgcn_sched_barrier(0)
#define LDKG_(ks_) do { f[0] = *(const bf16x8*)(kpn + kfr[(ks_) & 3] + ((ks_) / 4) * 128); f[1] = *(const bf16x8*)(kpn + kfr[(ks_) & 3] + 12288 + ((ks_) / 4) * 128); } while (0)
#define MMKG_(Sa_, Sb_, ks_) do { Sa_ = __builtin_amdgcn_mfma_f32_32x32x16_bf16(f[0], qf[ks_], Sa_, 0, 0, 0); Sb_ = __builtin_amdgcn_mfma_f32_32x32x16_bf16(f[1], qf[ks_], Sb_, 0, 0, 0); } while (0)
#define LDVK_(dst, kk_) do { _Pragma("unroll") for (int j_ = 0; j_ < 4; ++j_) dst[j_] = *(const bf16x8*)(vp + vfr[kk_] + j_ * 4096); } while (0)
#define MMVK_(src, kk_) do { _Pragma("unroll") for (int j_ = 0; j_ < 4; ++j_) O[j_] = __builtin_amdgcn_mfma_f32_32x32x16_bf16(src[j_], pf[kk_], O[j_], 0, 0, 0); } while (0)
#define LDV2_(dst, kk_, dp_) do { dst[0] = *(const bf16x8*)(vp + vfr[kk_] + (2 * (dp_)) * 4096); dst[1] = *(const bf16x8*)(vp + vfr[kk_] + (2 * (dp_) + 1) * 4096); } while (0)
#define MMV2_(src, kk_, dp_) do { O[2 * (dp_)] = __builtin_amdgcn_mfma_f32_32x32x16_bf16(src[0], pf[kk_], O[2 * (dp_)], 0, 0, 0); O[2 * (dp_) + 1] = __builtin_amdgcn_mfma_f32_32x32x16_bf16(src[1], pf[kk_], O[2 * (dp_) + 1], 0, 0, 0); } while (0)
#define EXPR_(S_, r0_, r1_) do { _Pragma("unroll") for (int r_ = (r0_); r_ < (r1_); ++r_) { S_[r_] = __builtin_amdgcn_exp2f(S_[r_]); ps += S_[r_]; } } while (0)
#define ATT_STEP(Sc0_, Sc1_, Sn0_, Sn1_) do { \
                const int rel = t - (nt - 4); \
                if (t + 2 < nt) ATT_DMA(t + 2, kb2); \
                if (rel <= (wid >> 1)) { \
                    const unsigned char* kpn = shm + kb1 * KBYTES; const unsigned char* vp = shm + VBASE + kb0 * VBYTES; \
                    bf16x8 f[2]; float ps = 0.f; \
                    _Pragma("unroll") for (int r_ = 0; r_ < 16; ++r_) { Sn0_[r_] = 0.f; Sn1_[r_] = 0.f; } \
                    LDKG_(0); SB_(); \
                    MMKG_(Sn0_, Sn1_, 0); LDKG_(1); \
                    if (rel >= 0) { const int dq = qrow - t * 64 - 4 * hi; float ninf_; asm volatile("v_mov_b32 %0, 0xff800000" : "=v"(ninf_)); \
                        _Pragma("unroll") for (int r_ = 0; r_ < 16; ++r_) { const int c_ = (r_ & 3) + 8 * (r_ >> 2); if (c_ > dq) Sc0_[r_] = ninf_; if (c_ + 32 > dq) Sc1_[r_] = ninf_; } } \
                    SB_(); \
                    MMKG_(Sn0_, Sn1_, 1); LDKG_(2); \
                    float mx = fmaxf(Sc0_[0], Sc1_[0]); \
                    _Pragma("unroll") for (int r_ = 1; r_ < 16; ++r_) mx = fmaxf(mx, fmaxf(Sc0_[r_], Sc1_[r_])); \
                    SB_(); \
                    MMKG_(Sn0_, Sn1_, 2); LDKG_(3); \
                    mx = x32_max(mx); \
                    const bool fast = mz && (__builtin_amdgcn_ballot_w64((mx > 12.0f) || (t == 0 && mx < -64.0f)) == 0ull); \
                    if (!fast) { \
                        mz = false; \
                        const float mn = (t == 0) ? mx : fmaxf(m_run, mx); \
                        const float alpha = (t == 0) ? 1.0f : __builtin_amdgcn_exp2f(m_run - mn); \
                        m_run = mn; l_run *= alpha; \
                        _Pragma("unroll") for (int r_ = 0; r_ < 16; ++r_) { Sc0_[r_] -= mn; Sc1_[r_] -= mn; } \
                        _Pragma("unroll") for (int d_ = 0; d_ < 4; ++d_) _Pragma("unroll") for (int r_ = 0; r_ < 16; ++r_) O[d_][r_] *= alpha; \
                    } \
                    SB_(); \
                    MMKG_(Sn0_, Sn1_, 3); LDKG_(4); EXPR_(Sc0_, 0, 4); SB_(); \
                    MMKG_(Sn0_, Sn1_, 4); LDKG_(5); EXPR_(Sc0_, 4, 8); SB_(); \
                    MMKG_(Sn0_, Sn1_, 5); LDKG_(6); EXPR_(Sc0_, 8, 12); SB_(); \
                    MMKG_(Sn0_, Sn1_, 6); LDKG_(7); EXPR_(Sc0_, 12, 16); SB_(); \
                    MMKG_(Sn0_, Sn1_, 7); LDKG_(8); EXPR_(Sc1_, 0, 4); SB_(); \
                    MMKG_(Sn0_, Sn1_, 8); LDKG_(9); EXPR_(Sc1_, 4, 8); SB_(); \
                    MMKG_(Sn0_, Sn1_, 9); LDKG_(10); EXPR_(Sc1_, 8, 12); SB_(); \
                    MMKG_(Sn0_, Sn1_, 10); LDKG_(11); EXPR_(Sc1_, 12, 16); SB_(); \
                    bf16x8 pf[4]; \
                    MMKG_(Sn0_, Sn1_, 11); \
                    { u32x4 a_ = {cvt_pk_bf16(Sc0_[0], Sc0_[1]), cvt_pk_bf16(Sc0_[2], Sc0_[3]), cvt_pk_bf16(Sc0_[4], Sc0_[5]), cvt_pk_bf16(Sc0_[6], Sc0_[7])}; \
                      u32x4 b_ = {cvt_pk_bf16(Sc0_[8], Sc0_[9]), cvt_pk_bf16(Sc0_[10], Sc0_[11]), cvt_pk_bf16(Sc0_[12], Sc0_[13]), cvt_pk_bf16(Sc0_[14], Sc0_[15])}; \
                      u32x4 c_ = {cvt_pk_bf16(Sc1_[0], Sc1_[1]), cvt_pk_bf16(Sc1_[2], Sc1_[3]), cvt_pk_bf16(Sc1_[4], Sc1_[5]), cvt_pk_bf16(Sc1_[6], Sc1_[7])}; \
                      u32x4 d_ = {cvt_pk_bf16(Sc1_[8], Sc1_[9]), cvt_pk_bf16(Sc1_[10], Sc1_[11]), cvt_pk_bf16(Sc1_[12], Sc1_[13]), cvt_pk_bf16(Sc1_[14], Sc1_[15])}; \
                      pf[0] = *(const bf16x8*)&a_; pf[1] = *(const bf16x8*)&b_; pf[2] = *(const bf16x8*)&c_; pf[3] = *(const bf16x8*)&d_; } \
                    l_run += ps; \
                    SB_(); \
                    bf16x8 va[2], vb[2]; \
                    LDV2_(va, 0, 0); SB_(); \
                    LDV2_(vb, 0, 1); SB_(); MMV2_(va, 0, 0); SB_(); \
                    LDV2_(va, 1, 0); SB_(); MMV2_(vb, 0, 1); SB_(); \
                    LDV2_(vb, 1, 1); SB_(); MMV2_(va, 1, 0); SB_(); \
                    LDV2_(va, 2, 0); SB_(); MMV2_(vb, 1, 1); SB_(); \
                    LDV2_(vb, 2, 1); SB_(); MMV2_(va, 2, 0); SB_(); \
                    LDV2_(va, 3, 0); SB_(); MMV2_(vb, 2, 1); SB_(); \
                    LDV2_(vb, 3, 1); SB_(); MMV2_(va, 3, 0); SB_(); \
                    MMV2_(vb, 3, 1); SB_(); \
                } \
                asm volatile("s_waitcnt vmcnt(0)" ::: "memory"); \
                __syncthreads(); \
                { const int k_ = kb0; kb0 = kb1; kb1 = kb2; kb2 = k_; } \
                ++t; } while (0)
            __syncthreads();
            ATT_DMA(0, 0); ATT_DMA(1, 1);
            asm volatile("s_waitcnt vmcnt(0)" ::: "memory");
            __syncthreads();
            f32x16 SA0, SA1, SB0, SB1;
            int kb0 = 0, kb1 = 1, kb2 = 2, t = 0;
            {
                const unsigned char* kpn = shm;
                bf16x8 f[2];
#pragma unroll
                for (int r = 0; r < 16; ++r) { SA0[r] = 0.f; SA1[r] = 0.f; }
#pragma unroll
                for (int ks = 0; ks < 12; ++ks) { LDKG_(ks); MMKG_(SA0, SA1, ks); }
            }
            while (t < nt) {
                ATT_STEP(SA0, SA1, SB0, SB1);
                ATT_STEP(SB0, SB1, SA0, SA1);
            }
#undef ATT_STEP
#undef SB_
#undef LDKG_
#undef MMKG_
#undef LDVK_
#undef MMVK_
#undef LDV2_
#undef MMV2_
#undef EXPR_
#undef ATT_DMA
            const float lt = x32_sum(l_run);
            const float inv = 1.0f / lt;
            int lqe = lq, hie = hi; asm volatile("" : "+v"(lqe), "+v"(hie));
            float* stg = (float*)(shm + wid * 16896);
#pragma unroll
            for (int db = 0; db < 4; ++db)
#pragma unroll
                for (int g4 = 0; g4 < 4; ++g4) {
                    f32x4 v = {O[db][4 * g4 + 0] * inv, O[db][4 * g4 + 1] * inv, O[db][4 * g4 + 2] * inv, O[db][4 * g4 + 3] * inv};
                    *(f32x4*)(stg + lqe * 132 + db * 32 + g4 * 8 + 4 * hie) = v;
                }
            const size_t ybase = (size_t)(tokb + q0 + wid * 32) * 2048 + h * 128;
#pragma unroll 4
            for (int i = 0; i < 8; ++i) {
                const int id = lane + 64 * i, row = id >> 4, ch = id & 15;
                const size_t off = ybase + (size_t)row * 2048 + ch * 8;
                const u32x4 zv = *(const u32x4*)(Zs + off);
                const f32x4 a = *(const f32x4*)(stg + row * 132 + ch * 8), c = *(const f32x4*)(stg + row * 132 + ch * 8 + 4);
                u32x4 o = {cvt_pk_bf16(a[0] * bflo(zv[0]), a[1] * bfhi(zv[0])), cvt_pk_bf16(a[2] * bflo(zv[1]), a[3] * bfhi(zv[1])),
                           cvt_pk_bf16(c[0] * bflo(zv[2]), c[1] * bfhi(zv[2])), cvt_pk_bf16(c[2] * bflo(zv[3]), c[3] * bfhi(zv[3]))};
                *(u32x4*)(Y + off) = o;
            }
        }
    }
}

enum { PH_PREP = 0, PH_NORM_A0, PH_AIN0, PH_MIX0, PH_AOUT0, PH_NORM_A1, PH_AIN1, PH_MIX1, PH_AOUT1, PH_NORM_KV, PH_DKV_BIN0, PH_UKV_UQ0, PH_KPOST, PH_ATTN0, PH_BOUT0,
       PH_NORM_B1, PH_BIN1, PH_UQ1, PH_ATTN1, PH_BOUT1, NPH };
#if REP_GEMM == 2
#define RG_(x) x, x,
#else
#define RG_(x) x,
#endif
#if REP_AIN == 2
#define RI_(x) x, x,
#else
#define RI_(x) x,
#endif
#if REP_MIX == 2
#define RM_(x) x, (x) | 0x80,
#else
#define RM_(x) x,
#endif
#if REP_ATTN == 2
#define RA_(x) x, x,
#else
#define RA_(x) x,
#endif
#if REP_LIGHT == 2
#define RL_(x) x, x,
#else
#define RL_(x) x,
#endif
__device__ const int g_seq[] = { RL_(PH_PREP) RL_(PH_NORM_A0) RI_(PH_AIN0) RM_(PH_MIX0) RG_(PH_AOUT0) RL_(PH_NORM_A1) RI_(PH_AIN1) RM_(PH_MIX1) PH_AOUT1, RL_(PH_NORM_KV) RG_(PH_DKV_BIN0) RG_(PH_UKV_UQ0)
                                           RM_(PH_KPOST) RA_(PH_ATTN0) PH_BOUT0, RL_(PH_NORM_B1) RG_(PH_BIN1) RG_(PH_UQ1) RA_(PH_ATTN1) PH_BOUT1 };
constexpr int NSEQ = (int)(sizeof(g_seq) / sizeof(int));

__global__ void __launch_bounds__(512, 2) mega(Params p) {
    extern __shared__ __attribute__((aligned(16))) unsigned char shm[];
    LAS unsigned char* lds = (LAS unsigned char*)shm;
    const int wid_s = __builtin_amdgcn_readfirstlane((int)(threadIdx.x >> 6));
    for (int pi = p.ph_lo; pi < p.ph_hi; ++pi) {
        const int phv = g_seq[pi]; const int ph = phv & 0x7f; const bool ident = (phv & 0x80) != 0;
        int lane_; asm volatile("v_mbcnt_lo_u32_b32 %0, -1, 0\n\tv_mbcnt_hi_u32_b32 %0, -1, %0" : "=v"(lane_));
        int TID = wid_s * 64 + lane_, BID = blockIdx.x; unsigned long long zoff_ = 0; asm volatile("" : "+s"(zoff_)); unsigned char* ws = p.ws + zoff_;
        asm volatile("" : "+v"(TID), "+s"(BID));
        const float* mod = (const float*)(ws + WS_MOD);
        const float* kvmod = (const float*)(ws + WS_KVMOD);
        const float* cosT = (const float*)(ws + WS_COS);
        const float* sinT = (const float*)(ws + WS_SIN);
        switch (ph) {
#if PHSEL & 1
        case PH_PREP: phase_prep(TID, BID, p, ws, shm); break;
#endif
#if PHSEL & 2
        case PH_NORM_A0: case PH_NORM_A1: case PH_NORM_B1: {
            const int l = ph == PH_NORM_A0 ? 0 : (ph == PH_NORM_A1 ? 1 : 3);
            const float* x = l == 0 ? p.in[I_X] : p.out;
            const float* m = mod + (size_t)l * 4 * 6144;
            phase_norm(TID, BID, x, p.in[I_NORM_G] + l * DM, m, m + 2048, 6144, (bf16_t*)(ws + WA_H), nullptr, nullptr, nullptr, 0, nullptr);
        } break;
#endif
#if PHSEL & 4
        case PH_NORM_KV: {
            const float* m = mod + (size_t)2 * 4 * 6144;
            phase_norm(TID, BID, p.out, p.in[I_NORM_G] + 2 * DM, m, m + 2048, 6144, (bf16_t*)(ws + WB_H), p.in[I_KV_NORM_G], kvmod, kvmod + 2048, 4096, (bf16_t*)(ws + WB_HKV));
        } break;
#endif
#if PHSEL & 8
        case PH_AIN0: case PH_AIN1: {
            const int l = ph == PH_AIN0 ? 0 : 1;
            const bf16_t* W = (const bf16_t*)(ws + WS_WINA) + (size_t)l * 12288 * 2048;
            EpiUZ E{(bf16_t*)(ws + WA_P)};
            run_gemm(TID, BID, lds, (const bf16_t*)(ws + WA_H), W, T, 8192, 2048, E);
            EpiGVT E2{(bf16_t*)(ws + WA_GVT), (float*)(ws + WA_STATS)};
            run_gemm(TID, BID, lds, W + (size_t)8192 * 2048, (const bf16_t*)(ws + WA_H), 4096, T, 2048, E2);
        } break;
#endif
#if PHSEL & 16
        case PH_MIX0: case PH_MIX1: {
            const int l = ph == PH_MIX0 ? 0 : 1;
            phase_mix(TID, BID, shm, (bf16_t*)(ws + WA_P), (const bf16_t*)(ws + WA_GVT), (const float*)(ws + WA_STATS), (const bf16_t*)(ws + WS_WS16) + (size_t)l * 16 * 128 * 128, p.in[I_A_B_S] + l * 16 * 128,
                      p.in[I_A_LN_G] + l * GMW, p.in[I_A_LN_B] + l * GMW, ident);
        } break;
#endif
#if PHSEL & 32
        case PH_AOUT0: case PH_AOUT1: case PH_BOUT0: case PH_BOUT1: {
            const int l = ph == PH_AOUT0 ? 0 : (ph == PH_AOUT1 ? 1 : (ph == PH_BOUT0 ? 2 : 3));
            const float* xin = l == 0 ? p.in[I_X] : p.out;
            EpiRes E{xin, p.out, mod + (size_t)l * 4 * 6144 + 4096, 6144};
            const bf16_t* A = l < 2 ? (const bf16_t*)(ws + WA_P) : (const bf16_t*)(ws + WB_Y);
            const bf16_t* Bt = l < 2 ? (const bf16_t*)(ws + WS_WOUTA) + (size_t)l * 2048 * 4096 : (const bf16_t*)(ws + WS_WOUTB) + (size_t)(l - 2) * 2048 * 2048;
            run_gemm(TID, BID, lds, A, Bt, T, 2048, l < 2 ? 4096 : 2048, E, l < 2);
        } break;
#endif
#if PHSEL & 64
        case PH_DKV_BIN0: case PH_BIN1: {
            if (ph == PH_DKV_BIN0) {
                EpiLat<0> E{(bf16_t*)(ws + WB_CKV), (float*)(ws + WB_SSQKV), (float*)(ws + WB_KRAW), nullptr};
                run_gemm(TID, BID, lds, (const bf16_t*)(ws + WB_HKV), (const bf16_t*)(ws + WS_WDKV), T, 768, 2048, E);
            }
            const int j = ph == PH_DKV_BIN0 ? 0 : 1;
            EpiLat<1> E{(bf16_t*)(ws + WB_CQ), (float*)(ws + WB_SSQQ), nullptr, (bf16_t*)(ws + WB_Z)};
            run_gemm(TID, BID, lds, (const bf16_t*)(ws + WB_H), (const bf16_t*)(ws + WS_WINB) + (size_t)j * 2560 * 2048, T, 2560, 2048, E);
        } break;
#endif
#if PHSEL & 128
        case PH_UKV_UQ0: case PH_UQ1: {
            if (ph == PH_UKV_UQ0) {
                EpiScaled E{(bf16_t*)(ws + WB_KN), 2048, (const float*)(ws + WB_SSQKV)};
                run_gemm(TID, BID, lds, (const bf16_t*)(ws + WB_CKV), (const bf16_t*)(ws + WS_WKN), T, 2048, 512, E);
                EpiVT E2{(bf16_t*)(ws + WB_VT), (const float*)(ws + WB_SSQKV)};
                run_gemm(TID, BID, lds, (const bf16_t*)(ws + WS_WV), (const bf16_t*)(ws + WB_CKV), 2048, T, 512, E2);
            }
            const int j = ph == PH_UKV_UQ0 ? 0 : 1;
            EpiScaled E{(bf16_t*)(ws + WB_Q), 3072, (const float*)(ws + WB_SSQQ)};
            run_gemm(TID, BID, lds, (const bf16_t*)(ws + WB_CQ), (const bf16_t*)(ws + WS_WUQ) + (size_t)j * 3072 * 512, T, 3072, 512, E);
        } break;
#endif
#if PHSEL & 256
        case PH_KPOST:
            phase_kpost(TID, BID, (bf16_t*)(ws + WB_KN), (const float*)(ws + WB_KRAW), (bf16_t*)(ws + WB_KROPE), p.in[I_KV_G_KN], p.in[I_KV_G_KR], cosT, sinT, ident);
            break;
#endif
#if PHSEL & 512
        case PH_ATTN0: case PH_ATTN1: {
            const int j = ph == PH_ATTN0 ? 0 : 1;
            phase_attn(TID, BID, shm, (const bf16_t*)(ws + WB_Q), (const bf16_t*)(ws + WB_KN), (const bf16_t*)(ws + WB_KROPE), (const bf16_t*)(ws + WB_VT), (const bf16_t*)(ws + WB_Z), (bf16_t*)(ws + WB_Y),
                       p.in[I_B_G_QN] + j * 128, p.in[I_B_G_QR] + j * 64, cosT, sinT);
        } break;
#endif
        default: break;
        }
        if (pi + 1 < p.ph_hi) {
            if (pi == p.ph_lo) cg::this_grid().sync();
            else grid_bar((unsigned*)(p.ws + WS_BAR), (unsigned)(pi - p.ph_lo), TID, BID);
        }
    }
}

extern "C" void kernel_launch(void* const* d_in, const int* in_sizes, int n_in, void* d_out, int out_size, void* d_ws, size_t ws_size, hipStream_t stream) {
    static int grid = 0;
    if (grid == 0) {
        if (n_in != 25 || ws_size < WS_NEED) { fprintf(stderr, "kernel_launch: unexpected n_in %d / ws %zu (need %zu)\n", n_in, ws_size, (size_t)WS_NEED); grid = -1; return; }
        int dev = 0, cus = 0, per_cu = 0;
        hipGetDevice(&dev);
        hipDeviceGetAttribute(&cus, hipDeviceAttributeMultiprocessorCount, dev);
        if (hipFuncSetAttribute((const void*)mega, hipFuncAttributeMaxDynamicSharedMemorySize, LDS_BYTES) != hipSuccess) { fprintf(stderr, "kernel_launch: hipFuncSetAttribute failed\n"); grid = -1; return; }
        if (hipOccupancyMaxActiveBlocksPerMultiprocessor(&per_cu, (const void*)mega, 512, LDS_BYTES) != hipSuccess || per_cu < 1) { fprintf(stderr, "kernel_launch: occupancy query gave %d\n", per_cu); per_cu = 1; }
        (void)hipGetLastError();
        grid = cus * per_cu;
    }
    if (grid < 0) return;
    Params p{};
    for (int i = 0; i < 25; ++i) p.in[i] = (const float*)d_in[i];
    p.out = (float*)d_out; p.ws = (unsigned char*)d_ws;
#if MK_SINGLE
    p.ph_lo = 0; p.ph_hi = NSEQ;
    if (hipMemsetAsync((char*)d_ws + WS_BAR, 0, 4096, stream) != hipSuccess) { fprintf(stderr, "kernel_launch: memset of the barrier words failed\n"); return; }
    void* args[] = {&p};
    hipError_t e = hipLaunchCooperativeKernel((const void*)mega, dim3(grid), dim3(512), args, LDS_BYTES, stream);
    if (e != hipSuccess) fprintf(stderr, "cooperative launch failed: %s (grid %d)\n", hipGetErrorString(e), grid);
#else
    for (int ph = 0; ph < NSEQ; ++ph) {
        p.ph_lo = ph; p.ph_hi = ph + 1;
        hipLaunchKernelGGL(mega, dim3(grid), dim3(512), LDS_BYTES, stream, p);
    }
#endif
}
```
